# Optimizing an MI355X kernel written in HIP

```python
import jax, jax.numpy as jnp
from jax import lax
import numpy as np

D_MODEL = 4096
BATCH = 4
SEQ = 2048
DEPTH = 1
DEC_BATCH = 128
DEC_SEQ = 1
PAST_LEN = 16384
PAGE_SIZE = 128

E_A = D_MODEL // 2
CHUNK_A = 128
A_GROUPS = 16
A_GROUP_DIM = E_A // A_GROUPS
E_B = D_MODEL // 2
B_HEAD_DIM = 128
B_HEADS = E_B // B_HEAD_DIM
CHUNK_B = 64
COL_U = 0
COL_V = COL_U + E_A
COL_ZA = COL_V + E_A
COL_Q = COL_ZA + E_A
COL_F = COL_Q + E_B
COL_I = COL_F + E_B
COL_ZB = COL_I + E_B
COL_GA = COL_ZB + E_B
COL_GB = COL_GA + D_MODEL
N_COLS = COL_GB + D_MODEL
EPS = 1e-6

kernel_name = 'hybrid_gmlp_hgrn2_step'


def _rmsnorm(x, g):
    xf = x.astype(jnp.float32)
    y = xf * lax.rsqrt(jnp.mean(xf * xf, axis=-1, keepdims=True) + EPS)
    return (y * g.astype(jnp.float32)).astype(x.dtype)


def _layernorm(x, g, b):
    xf = x.astype(jnp.float32)
    mu = jnp.mean(xf, axis=-1, keepdims=True)
    xc = xf - mu
    y = xc * lax.rsqrt(jnp.mean(xc * xc, axis=-1, keepdims=True) + EPS)
    return (y * g.astype(jnp.float32) + b.astype(jnp.float32)).astype(x.dtype)


def _chunk_spatial_gate(v, w_s, b_s):
    bn, t, _ = v.shape
    pad = (-t) % CHUNK_A
    vp = jnp.pad(v, ((0, 0), (0, pad), (0, 0)))
    n = (t + pad) // CHUNK_A
    vc = vp.reshape(bn, n, CHUNK_A, A_GROUPS, A_GROUP_DIM)
    mask = jnp.tril(jnp.ones((CHUNK_A, CHUNK_A), dtype=bool))
    wm = jnp.where(mask[None], w_s, jnp.zeros((), w_s.dtype))
    mixed = jnp.einsum('gts,bnsgc->bntgc', wm, vc) + b_s.T[None, None, :, :, None]
    return mixed.reshape(bn, n * CHUNK_A, E_A)[:, :t]


def _hgrn2(q, log_f, k, i, s0):
    bn, t, h, _ = q.shape
    c = CHUNK_B if t >= CHUNK_B else t
    pad = (-t) % c
    if pad:
        pw = ((0, 0), (0, pad), (0, 0), (0, 0))
        q, log_f, k, i = [jnp.pad(a, pw) for a in (q, log_f, k, i)]
    n = (t + pad) // c

    def to_chunks(a):
        return a.reshape(bn, n, c, h, a.shape[-1]).transpose(1, 0, 2, 3, 4)

    mask = jnp.tril(jnp.ones((c, c), dtype=bool))[None, :, :, None, None]

    def step(s, inp):
        qc, lfc, kc, ic = inp
        b = jnp.cumsum(lfc, axis=1)
        o_inter = jnp.einsum('bthd,bhde->bthe', qc * jnp.exp(b), s)
        dec = jnp.exp(jnp.where(mask, b[:, :, None] - b[:, None, :], -jnp.inf))
        att = jnp.einsum('bthd,bshd,btshd->bhts', qc, kc, dec)
        o_intra = jnp.einsum('bhts,bshe->bthe', att, ic)
        b_last = b[:, -1]
        s_new = jnp.exp(b_last)[..., None] * s + jnp.einsum(
            'bshd,bshe->bhde', kc * jnp.exp(b_last[:, None] - b), ic)
        return s_new, o_inter + o_intra

    s_t, o = lax.scan(step, s0, (to_chunks(q), to_chunks(log_f), to_chunks(k), to_chunks(i)))
    o = o.transpose(1, 0, 2, 3, 4).reshape(bn, n * c, h, i.shape[-1])[:, :t]
    return o, s_t


def _layer(x, s0, layer_idx, lb_logits, g_pre, w_in, ln_g, ln_b, w_s, b_s,
           g_onorm, w_pa, w_pb, w_o, g_post):
    bn, t, _ = x.shape
    xn = _rmsnorm(x, g_pre)
    hcat = xn @ w_in
    hu = hcat[..., COL_U:COL_V]
    hv = hcat[..., COL_V:COL_ZA]
    za = hcat[..., COL_ZA:COL_Q]
    hq = hcat[..., COL_Q:COL_F]
    hf = hcat[..., COL_F:COL_I]
    hi = hcat[..., COL_I:COL_ZB]
    zb = hcat[..., COL_ZB:COL_GA]
    hga = hcat[..., COL_GA:COL_GB]
    hgb = hcat[..., COL_GB:N_COLS]

    u = jax.nn.gelu(hu)
    vn = _layernorm(jax.nn.gelu(hv), ln_g, ln_b)
    y_a = u * _chunk_spatial_gate(vn, w_s, b_s) * jax.nn.silu(za)

    lb = jnp.cumsum(jax.nn.softmax(lb_logits.astype(jnp.float32), axis=0), axis=0)[layer_idx]
    zf = hf.astype(jnp.float32)
    log_f = jnp.log(lb + (1.0 - lb) * jax.nn.sigmoid(zf))
    k = (1.0 - lb) * jax.nn.sigmoid(-zf)
    q = jax.nn.silu(hq.astype(jnp.float32))

    def heads(a):
        return a.reshape(bn, t, B_HEADS, B_HEAD_DIM)

    o, s_t = _hgrn2(heads(q), heads(log_f), heads(k), heads(hi.astype(jnp.float32)),
                    s0.astype(jnp.float32))
    o = o * lax.rsqrt(jnp.mean(o * o, axis=-1, keepdims=True) + EPS)
    o = o.reshape(bn, t, E_B) * g_onorm.astype(jnp.float32)
    y_b = o.astype(x.dtype) * jax.nn.silu(zb)

    merged = jax.nn.sigmoid(hga) * (y_a @ w_pa) + jax.nn.sigmoid(hgb) * (y_b @ w_pb)
    out = x + _rmsnorm(merged @ w_o, g_post)
    n_last = (t - 1) % CHUNK_A + 1
    return out, s_t.astype(x.dtype), vn[:, t - n_last:]


def setup_inputs(seed: int = 0) -> dict:
    key = jax.random.key(seed)
    ks = jax.random.split(key, 20)
    f32 = jnp.float32
    nrm = lambda k, shape, s: jax.random.normal(k, shape, f32) * s
    return {
        'x_prompt': nrm(ks[0], (BATCH, SEQ, D_MODEL), 1.0),
        'x_sample': nrm(ks[1], (DEC_BATCH, DEC_SEQ, D_MODEL), 1.0),
        'state_hgrn': nrm(ks[2], (DEPTH, DEC_BATCH, B_HEADS, B_HEAD_DIM, B_HEAD_DIM), 0.5),
        'lb_logits': nrm(ks[3], (DEPTH + 1, E_B), 1.0),
        'g_pre': 1.0 + nrm(ks[4], (DEPTH, D_MODEL), 0.05),
        'w_in': nrm(ks[5], (DEPTH, D_MODEL, N_COLS), D_MODEL ** -0.5),
        'ln_g': 1.0 + nrm(ks[6], (DEPTH, E_A), 0.05),
        'ln_b': nrm(ks[7], (DEPTH, E_A), 0.02),
        'w_s': nrm(ks[8], (DEPTH, A_GROUPS, CHUNK_A, CHUNK_A), CHUNK_A ** -0.5),
        'b_s': 1.0 + nrm(ks[9], (DEPTH, A_GROUPS, CHUNK_A), 0.1),
        'g_onorm': 1.0 + nrm(ks[10], (DEPTH, E_B), 0.05),
        'w_pa': nrm(ks[11], (DEPTH, E_A, D_MODEL), E_A ** -0.5),
        'w_pb': nrm(ks[12], (DEPTH, E_B, D_MODEL), E_B ** -0.5),
        'w_o': nrm(ks[13], (DEPTH, D_MODEL, D_MODEL), D_MODEL ** -0.5),
        'g_post': 1.0 + nrm(ks[14], (DEPTH, D_MODEL), 0.05),
    }


def reference(x_prompt, x_sample, state_hgrn, lb_logits, g_pre, w_in, ln_g, ln_b, w_s, b_s,
              g_onorm, w_pa, w_pb, w_o, g_post):
    yp, ys = x_prompt, x_sample
    sp_list, ss_list, vp_list, vs_list = [], [], [], []
    s0_prompt = jnp.zeros((x_prompt.shape[0], B_HEADS, B_HEAD_DIM, B_HEAD_DIM), x_prompt.dtype)
    for l in range(DEPTH):
        params = (g_pre[l], w_in[l], ln_g[l], ln_b[l], w_s[l], b_s[l],
                  g_onorm[l], w_pa[l], w_pb[l], w_o[l], g_post[l])
        yp, sp, vp = _layer(yp, s0_prompt, l, lb_logits, *params)
        ys, ss, vs = _layer(ys, state_hgrn[l], l, lb_logits, *params)
        sp_list.append(sp)
        ss_list.append(ss)
        vp_list.append(vp)
        vs_list.append(vs)
    state_hgrn_prompt = jnp.stack(sp_list)
    state_hgrn_sample = jnp.stack(ss_list)
    vrows_prompt = jnp.stack(vp_list)
    vrows_sample = jnp.stack(vs_list)
    return (yp, ys, state_hgrn_prompt, state_hgrn_sample, vrows_prompt, vrows_sample)
```

```cpp
#include <hip/hip_runtime.h>
#include <hip/hip_cooperative_groups.h>
#include <cstdio>
#include <cstdint>
namespace cg = cooperative_groups;

#ifndef MK_MULTI
#define MK_MULTI 0
#endif

#ifndef G1ORDER
#define G1ORDER StaticOrder
#endif
#ifndef MK_DELAY_US
#define MK_DELAY_US 0
#endif
#ifndef MK_DUMP
#define MK_DUMP 0
#endif

constexpr int DM = 4096, NC = 22528, TP = 8192, TS = 128, MT = TP + TS, MP = 8448, EA = 2048;
constexpr int COL_U = 0, COL_V = 2048, COL_ZA = 4096, COL_Q = 6144, COL_F = 8192, COL_I = 10240, COL_ZB = 12288, COL_GA = 14336, COL_GB = 18432;
constexpr float EPS = 1e-6f;
constexpr size_t WS_WTIN = 4096;
constexpr size_t WS_WTAB = WS_WTIN + (size_t)NC * DM * 2;
constexpr size_t WS_WTO  = WS_WTAB + (size_t)DM * DM * 2;
constexpr size_t WS_XN   = WS_WTO + (size_t)DM * DM * 2;
constexpr size_t WS_H    = WS_XN + (size_t)MP * DM * 2;
constexpr size_t WS_YAB  = WS_H + (size_t)MP * NC * 2;
constexpr size_t WS_MRG  = WS_YAB + (size_t)MP * DM * 2;
constexpr size_t WS_Z    = WS_MRG + (size_t)MP * DM * 2;
constexpr size_t WS_LNP  = WS_Z + (size_t)MP * DM * 2;
constexpr size_t WS_SSP  = WS_LNP + (size_t)MP * 64 * 4;
constexpr size_t WS_WSM  = WS_SSP + (size_t)MP * 64 * 4;
constexpr size_t WS_QT0  = WS_WSM + (size_t)16 * 128 * 128 * 2;
constexpr size_t WS_KTT  = WS_QT0 + (size_t)TP * EA * 2;
constexpr size_t WS_ITT  = WS_KTT + (size_t)TP * EA * 2;
constexpr size_t WS_OIN  = WS_ITT + (size_t)TP * EA * 2;
constexpr size_t WS_DEC  = WS_OIN + (size_t)TP * EA * 4;
constexpr size_t WS_END  = WS_DEC + (size_t)2048 * 128 * 4;
constexpr size_t O_YP = 0, O_YS = O_YP + (size_t)TP * DM, O_SP = O_YS + (size_t)TS * DM, O_SS = O_SP + (size_t)4 * 16 * 128 * 128,
                 O_VP = O_SS + (size_t)128 * 16 * 128 * 128, O_VS = O_VP + (size_t)4 * 128 * EA, O_END = O_VS + (size_t)128 * EA;
constexpr int LDS_BYTES = 128 * 1024;

#define LAS __attribute__((address_space(3)))
namespace pg8 {
#define PG8_LAS __attribute__((address_space(3)))
typedef unsigned short bf16_t;
typedef short bf16x8 __attribute__((ext_vector_type(8)));
typedef float f32x4 __attribute__((ext_vector_type(4)));
typedef unsigned u32x4 __attribute__((ext_vector_type(4)));
constexpr int BM = 256, BK = 64, HALF = 128, HTB = HALF * BK * 2  , STAGE_BYTES = 8 * HTB, NXCD = 8, WGM = 8;

__host__ __device__ __forceinline__ int lds_byte(int r, int c) { const int st = (r >> 4) * 2 + (c >> 5), rr = r & 15, cc = c & 31, ob = rr * 64 + cc * 2; return st * 1024 + (ob ^ (((ob >> 9) & 1) << 5)); }
__host__ __device__ __forceinline__ void stage_rc(int b, int& R, int& C) { const int st = b / 1024, sb = b % 1024, swz = sb ^ (((sb >> 9) & 1) << 5); R = (st >> 1) * 16 + swz / 64; C = (st & 1) * 32 + (swz % 64) / 2; }
__host__ __device__ __forceinline__ int perm32(int rho) { const int n = rho >> 4, i = rho & 15; return 8 * (i >> 2) + 4 * n + (i & 3); }

struct Unit { int pm, pn, kh; };
struct Gemm { const bf16_t* A; const bf16_t* Bt; int M, N, K, nt; size_t khoff; };

struct StaticOrder {
    int nM, nN, nwg, G, c;
    __host__ __device__ void init(int M, int N, int G_, int c_) { nM = M / BM; nN = N / BM; nwg = nM * nN; G = G_; c = c_; }
    __host__ __device__ bool next(int i, Unit& u) const {
        const long L = (long)i * G + c; if (L >= nwg) return false;
        int wgid = (int)L; { const int q = nwg / NXCD, r = nwg % NXCD, xcd = wgid % NXCD, off = wgid / NXCD; wgid = (xcd < r ? xcd * (q + 1) : r * (q + 1) + (xcd - r) * q) + off; }
        const int nig = WGM * nN, gid = wgid / nig, fm = gid * WGM, gsz = (nM - fm) < WGM ? (nM - fm) : WGM;
        u.pm = fm + ((wgid % nig) % gsz); u.pn = (wgid % nig) / gsz; u.kh = 0; return true;
    }
    __device__ __forceinline__ void a_ready(const Unit&) const {}
    __device__ __forceinline__ void done(const Unit&) const {}
};

typedef float f32x2 __attribute__((ext_vector_type(2)));
typedef __bf16 bf16x2_t __attribute__((ext_vector_type(2)));
__device__ __forceinline__ unsigned cvt_pk_bf16(float lo, float hi) { const f32x2 v = {lo, hi}; return __builtin_bit_cast(unsigned, __builtin_convertvector(v, bf16x2_t)); }
__device__ __forceinline__ float bf2f(unsigned short b) { return __builtin_bit_cast(float, (unsigned)b << 16); }
__device__ __forceinline__ float f_lo(unsigned w) { return __builtin_bit_cast(float, w << 16); }
__device__ __forceinline__ float f_hi(unsigned w) { return __builtin_bit_cast(float, w & 0xffff0000u); }
__device__ __forceinline__ float fsigmoid(float x) { return __builtin_amdgcn_rcpf(1.0f + __expf(-x)); }
__device__ __forceinline__ float fsilu(float x) { return x * fsigmoid(x); }
__device__ __forceinline__ float fgelu(float x) { return x * fsigmoid(1.5957691216057308f * (x + 0.044715f * x * x * x)); }

struct EpiAct {
    static constexpr bool PERM = true, AFTER_DRAIN = false, CARRY = false;
    bf16_t* H; const float* lbl; float* lnp;
    template <int ACT> __device__ __forceinline__ void run(const f32x4 (&acc)[2][2][4][2], const Unit& u, int wr, int wc, int fr, int fq) const {
        const int row0 = u.pm * BM + wr * 64 + fr, col0 = u.pn * BM + wc * 32 + 8 * fq;
        float lb[2][8];
        if (ACT == 3) {
#pragma unroll
            for (int bj = 0; bj < 2; ++bj) { const float* l0 = lbl + (col0 + bj * HALF - 8192); const f32x4 a0 = *(const f32x4*)l0, a1 = *(const f32x4*)(l0 + 4), b0 = *(const f32x4*)(l0 + 2048), b1 = *(const f32x4*)(l0 + 2052);
#pragma unroll
                for (int k = 0; k < 4; ++k) { lb[bj][k] = __builtin_amdgcn_rcpf(1.0f + __expf(b0[k] - a0[k])); lb[bj][4 + k] = __builtin_amdgcn_rcpf(1.0f + __expf(b1[k] - a1[k])); } }
        }
#pragma unroll
        for (int ai = 0; ai < 2; ++ai)
#pragma unroll
            for (int m = 0; m < 4; ++m) { const int row = row0 + ai * HALF + m * 16; bf16_t* rowp = H + (size_t)row * 22528 + col0; float s1 = 0.f, s2 = 0.f;
#pragma unroll
                for (int bj = 0; bj < 2; ++bj) { float v[8];
#pragma unroll
                    for (int k = 0; k < 4; ++k) { v[k] = acc[ai][bj][m][0][k]; v[4 + k] = acc[ai][bj][m][1][k]; }
#pragma unroll
                    for (int k = 0; k < 8; ++k) {
                        if (ACT == 0 || ACT == 1) v[k] = fgelu(v[k]);
                        if (ACT == 2) v[k] = fsilu(v[k]);
                        if (ACT == 3) v[k] = __logf(lb[bj][k] + (1.0f - lb[bj][k]) * fsigmoid(v[k]));
                        if (ACT == 5) v[k] = fsigmoid(v[k]);
                        if (ACT == 1) { s1 += v[k]; s2 += v[k] * v[k]; }
                    }
                    u32x4 w; w.x = cvt_pk_bf16(v[0], v[1]); w.y = cvt_pk_bf16(v[2], v[3]); w.z = cvt_pk_bf16(v[4], v[5]); w.w = cvt_pk_bf16(v[6], v[7]);
                    *(u32x4*)(rowp + bj * HALF) = w; }
                if (ACT == 1) { s1 += __shfl_xor(s1, 16); s1 += __shfl_xor(s1, 32); s2 += __shfl_xor(s2, 16); s2 += __shfl_xor(s2, 32);
                    if (fq == 0) { f32x2 o; o.x = s1; o.y = s2; *(f32x2*)(lnp + (size_t)row * 64 + ((u.pn - 8) * 4 + wc) * 2) = o; } }
            }
    }
    __device__ __forceinline__ void operator()(const f32x4 (&acc)[2][2][4][2], const Unit& u, int wr, int wc, int fr, int fq) const {
        const int pn = u.pn;
        if (pn < 8) run<0>(acc, u, wr, wc, fr, fq);
        else if (pn < 16) run<1>(acc, u, wr, wc, fr, fq);
        else if (pn < 32) run<2>(acc, u, wr, wc, fr, fq);
        else if (pn < 40) run<3>(acc, u, wr, wc, fr, fq);
        else if (pn < 48) run<4>(acc, u, wr, wc, fr, fq);
        else if (pn < 56) run<2>(acc, u, wr, wc, fr, fq);
        else run<5>(acc, u, wr, wc, fr, fq);
    }
};

struct EpiMerge {
    static constexpr bool PERM = true, AFTER_DRAIN = false, CARRY = true;
    const bf16_t* H; bf16_t* O;
    __device__ __forceinline__ void mid(f32x4 (&acc)[2][2][4][2], const Unit& u, int wr, int wc, int fr, int fq) const {
        const int row0 = u.pm * BM + wr * 64 + fr, col0 = u.pn * BM + wc * 32 + 8 * fq;
#pragma unroll
        for (int ai = 0; ai < 2; ++ai)
#pragma unroll
            for (int m = 0; m < 4; ++m) { const bf16_t* gp = H + (size_t)(row0 + ai * HALF + m * 16) * 22528 + 14336 + col0;
#pragma unroll
                for (int bj = 0; bj < 2; ++bj) { const u32x4 a = *(const u32x4*)(gp + bj * HALF), b = *(const u32x4*)(gp + 4096 + bj * HALF);
                    f32x4 r0, r1;
                    r0[0] = f_lo(a.x) * __builtin_amdgcn_rcpf(f_lo(b.x)); r0[1] = f_hi(a.x) * __builtin_amdgcn_rcpf(f_hi(b.x)); r0[2] = f_lo(a.y) * __builtin_amdgcn_rcpf(f_lo(b.y)); r0[3] = f_hi(a.y) * __builtin_amdgcn_rcpf(f_hi(b.y));
                    r1[0] = f_lo(a.z) * __builtin_amdgcn_rcpf(f_lo(b.z)); r1[1] = f_hi(a.z) * __builtin_amdgcn_rcpf(f_hi(b.z)); r1[2] = f_lo(a.w) * __builtin_amdgcn_rcpf(f_lo(b.w)); r1[3] = f_hi(a.w) * __builtin_amdgcn_rcpf(f_hi(b.w));
                    acc[ai][bj][m][0] *= r0; acc[ai][bj][m][1] *= r1; }
                asm volatile("" ::: "memory"); }
    }
    __device__ __forceinline__ void operator()(f32x4 (&acc)[2][2][4][2], const Unit& u, int wr, int wc, int fr, int fq) const {
        if (u.kh == 0) { mid(acc, u, wr, wc, fr, fq); return; }
        const int row0 = u.pm * BM + wr * 64 + fr, col0 = u.pn * BM + wc * 32 + 8 * fq;
#pragma unroll
        for (int ai = 0; ai < 2; ++ai)
#pragma unroll
            for (int m = 0; m < 4; ++m) { const int row = row0 + ai * HALF + m * 16; const bf16_t* gp = H + (size_t)row * 22528 + 18432 + col0; bf16_t* rowp = O + (size_t)row * 4096 + col0;
#pragma unroll
                for (int bj = 0; bj < 2; ++bj) { const u32x4 b = *(const u32x4*)(gp + bj * HALF); const f32x4 v0 = acc[ai][bj][m][0], v1 = acc[ai][bj][m][1];
                    u32x4 w; w.x = cvt_pk_bf16(v0[0] * f_lo(b.x), v0[1] * f_hi(b.x)); w.y = cvt_pk_bf16(v0[2] * f_lo(b.y), v0[3] * f_hi(b.y));
                    w.z = cvt_pk_bf16(v1[0] * f_lo(b.z), v1[1] * f_hi(b.z)); w.w = cvt_pk_bf16(v1[2] * f_lo(b.w), v1[3] * f_hi(b.w));
                    *(u32x4*)(rowp + bj * HALF) = w; }
                asm volatile("" ::: "memory"); }
    }
};

struct EpiZ {
    static constexpr bool PERM = true, AFTER_DRAIN = false, CARRY = false;
    bf16_t* Z; float* ssp;
    __device__ __forceinline__ void operator()(const f32x4 (&acc)[2][2][4][2], const Unit& u, int wr, int wc, int fr, int fq) const {
        const int row0 = u.pm * BM + wr * 64 + fr, col0 = u.pn * BM + wc * 32 + 8 * fq;
#pragma unroll
        for (int ai = 0; ai < 2; ++ai)
#pragma unroll
            for (int m = 0; m < 4; ++m) { const int row = row0 + ai * HALF + m * 16; bf16_t* rowp = Z + (size_t)row * 4096 + col0; float ss = 0.f;
#pragma unroll
                for (int bj = 0; bj < 2; ++bj) { const f32x4 v0 = acc[ai][bj][m][0], v1 = acc[ai][bj][m][1];
                    ss += (v0[0] * v0[0] + v0[1] * v0[1]) + (v0[2] * v0[2] + v0[3] * v0[3]) + (v1[0] * v1[0] + v1[1] * v1[1]) + (v1[2] * v1[2] + v1[3] * v1[3]);
                    u32x4 w; w.x = cvt_pk_bf16(v0[0], v0[1]); w.y = cvt_pk_bf16(v0[2], v0[3]); w.z = cvt_pk_bf16(v1[0], v1[1]); w.w = cvt_pk_bf16(v1[2], v1[3]);
                    *(u32x4*)(rowp + bj * HALF) = w; }
                ss += __shfl_xor(ss, 16); ss += __shfl_xor(ss, 32);
                if (fq == 0) ssp[(size_t)row * 64 + u.pn * 4 + wc] = ss; }
    }
};

struct PairOrder : StaticOrder {
    __device__ bool next(int i, Unit& u) const { if (!StaticOrder::next(i >> 1, u)) return false; u.kh = i & 1; return true; }
};

struct RevOrder : StaticOrder {
    __device__ bool next(int i, Unit& u) const { if (!StaticOrder::next(i, u)) return false; u.pn = nN - 1 - u.pn; return true; }
};

template <class Epi, class Sched, bool ALIGN_EPI = false, bool SP2 = false>
__device__ __forceinline__ void gemm_phase(PG8_LAS unsigned char* lds, const Gemm g, const Sched& S, const Epi& E) {
    const int tid = threadIdx.x, wid = __builtin_amdgcn_readfirstlane(tid >> 6), lane = tid & 63, wr = wid >> 2, wc = wid & 3, fr = lane & 15, fq = lane >> 4;
    const int K = g.K, nt = g.nt;
    unsigned voffA[2], voffB[2];
#pragma unroll
    for (int i = 0; i < 2; ++i) { int R, C; stage_rc(tid * 16 + i * 8192, R, C); const int Rb = Epi::PERM ? ((R & ~31) + perm32(R & 31)) : R;
        voffA[i] = (unsigned)(R * K + C) * 2u; voffB[i] = (unsigned)(Rb * K + C) * 2u; }
    const size_t kstep = (size_t)(BK * 2);
    const size_t hstep = (size_t)HALF * K * 2;
    const size_t tstep = 2 * hstep;
    const unsigned ldsw = (unsigned)wid * 1024u;
    const int aoff = lds_byte(wr * 64 + fr, fq * 8), boff = lds_byte(wc * 32 + fr, fq * 8);
#define PG8_SA(b, h) (((b) * 2 + (h)) * HTB)
#define PG8_SB(b, h) ((4 + (b) * 2 + (h)) * HTB)
#define PG8_STAGE(bufoff, gbase, voff) do { _Pragma("unroll") for (int _i = 0; _i < 2; ++_i) \
        __builtin_amdgcn_global_load_lds((const unsigned*)((const char*)(gbase) + (voff)[_i]), (PG8_LAS unsigned*)(lds + (bufoff) + ldsw + _i * 8192), 16, 0, 0); } while (0)
#define PG8_LDA(dst, b, h) do { _Pragma("unroll") for (int m = 0; m < 4; ++m) _Pragma("unroll") for (int k = 0; k < 2; ++k) dst[m][k] = *(const PG8_LAS bf16x8*)(lds + PG8_SA(b, h) + aoff + m * 2048 + k * 1024); } while (0)
#define PG8_LDB(dst, b, h) do { _Pragma("unroll") for (int n = 0; n < 2; ++n) _Pragma("unroll") for (int k = 0; k < 2; ++k) dst[n][k] = *(const PG8_LAS bf16x8*)(lds + PG8_SB(b, h) + boff + n * 2048 + k * 1024); } while (0)
#define PG8_MMA(ai, bj, At, Bt) do { __builtin_amdgcn_s_setprio(1); _Pragma("unroll") for (int m = 0; m < 4; ++m) _Pragma("unroll") for (int n = 0; n < 2; ++n) _Pragma("unroll") for (int k = 0; k < 2; ++k) \
        acc[ai][bj][m][n] = __builtin_amdgcn_mfma_f32_16x16x32_bf16(Bt[n][k], At[m][k], acc[ai][bj][m][n], 0, 0, 0); __builtin_amdgcn_s_setprio(0); } while (0)
#define PG8_WAIT_V(n) asm volatile("s_waitcnt vmcnt(" #n ")" ::: "memory")
#define PG8_WAIT_L(n) asm volatile("s_waitcnt lgkmcnt(" #n ")" ::: "memory")
#define PG8_BAR __builtin_amdgcn_s_barrier()
#define PG8_SCHED __builtin_amdgcn_sched_barrier(0)
    Unit cur, nxt; int ui = 0;
    if (!S.next(0, cur)) return;
    f32x4 acc[2][2][4][2];
#pragma unroll
    for (int a = 0; a < 2; ++a)
#pragma unroll
        for (int b = 0; b < 2; ++b)
#pragma unroll
            for (int m = 0; m < 4; ++m)
#pragma unroll
                for (int n = 0; n < 2; ++n) acc[a][b][m][n] = (f32x4){0.f, 0.f, 0.f, 0.f};
    bf16x8 At[4][2], B0[2][2], B1[2][2];
    const char* cA = (const char*)g.A + (size_t)cur.pm * tstep + (size_t)cur.kh * g.khoff; const char* cB = (const char*)g.Bt + (size_t)cur.pn * tstep + (size_t)cur.kh * g.khoff;
    S.a_ready(cur);
    if constexpr (SP2) {
        PG8_STAGE(PG8_SB(0, 0), cB, voffB); PG8_STAGE(PG8_SB(0, 1), cB + hstep, voffB); PG8_STAGE(PG8_SA(0, 0), cA, voffA); PG8_STAGE(PG8_SA(0, 1), cA + hstep, voffA);
        if (wr == 1) PG8_BAR;
        PG8_WAIT_V(2); PG8_BAR;
        PG8_STAGE(PG8_SB(1, 0), cB + kstep, voffB); PG8_STAGE(PG8_SA(1, 0), cA + kstep, voffA); PG8_STAGE(PG8_SB(1, 1), cB + hstep + kstep, voffB);
        PG8_WAIT_V(6); PG8_BAR;
    } else {
        PG8_STAGE(PG8_SB(0, 0), cB, voffB); PG8_STAGE(PG8_SA(0, 0), cA, voffA); PG8_STAGE(PG8_SB(0, 1), cB + hstep, voffB); PG8_STAGE(PG8_SA(0, 1), cA + hstep, voffA);
        if (wr == 1) PG8_BAR;
        PG8_WAIT_V(4); PG8_BAR;
        PG8_STAGE(PG8_SB(1, 0), cB + kstep, voffB); PG8_STAGE(PG8_SA(1, 0), cA + kstep, voffA); PG8_STAGE(PG8_SB(1, 1), cB + hstep + kstep, voffB);
        PG8_WAIT_V(6); PG8_BAR;
    }
    for (;;) {
        const bool has_next = S.next(ui + 1, nxt);
        const char* nA = has_next ? (const char*)g.A + (size_t)nxt.pm * tstep + (size_t)nxt.kh * g.khoff : cA; const char* nB = has_next ? (const char*)g.Bt + (size_t)nxt.pn * tstep + (size_t)nxt.kh * g.khoff : cB;
        for (int t = 0; t < nt; t += 2) {
            const bool last = (t == nt - 2);
            const char* a1 = cA + (size_t)(t + 1) * kstep;
            const char* a2 = last ? nA : cA + (size_t)(t + 2) * kstep; const char* b2 = last ? nB : cB + (size_t)(t + 2) * kstep;
            const char* a3 = a2 + kstep; const char* b3 = b2 + kstep;
            if (last && has_next) S.a_ready(nxt);
            if constexpr (SP2) {
            PG8_LDB(B0, 0, 0); PG8_LDB(B1, 0, 1); PG8_SCHED; PG8_LDA(At, 0, 0); PG8_STAGE(PG8_SA(1, 1), a1 + hstep, voffA);
            PG8_WAIT_V(8); PG8_WAIT_L(0); PG8_BAR; PG8_MMA(0, 0, At, B0); PG8_MMA(0, 1, At, B1); PG8_BAR; PG8_SCHED;
            PG8_LDA(At, 0, 1); PG8_STAGE(PG8_SB(0, 0), b2, voffB); PG8_STAGE(PG8_SB(0, 1), b2 + hstep, voffB); PG8_STAGE(PG8_SA(0, 0), a2, voffA);
            PG8_WAIT_V(8); PG8_WAIT_L(0); PG8_BAR; PG8_MMA(1, 0, At, B0); PG8_MMA(1, 1, At, B1); PG8_BAR; PG8_SCHED;
            PG8_LDB(B0, 1, 0); PG8_LDB(B1, 1, 1); PG8_SCHED; PG8_LDA(At, 1, 0); PG8_STAGE(PG8_SA(0, 1), a2 + hstep, voffA);
            PG8_WAIT_V(8); PG8_WAIT_L(0); PG8_BAR; PG8_MMA(0, 0, At, B0); PG8_MMA(0, 1, At, B1); PG8_BAR; PG8_SCHED;
            PG8_LDA(At, 1, 1); PG8_STAGE(PG8_SB(1, 0), b3, voffB); PG8_STAGE(PG8_SB(1, 1), b3 + hstep, voffB); PG8_STAGE(PG8_SA(1, 0), a3, voffA);
            PG8_WAIT_V(8); PG8_WAIT_L(0); PG8_BAR; PG8_MMA(1, 0, At, B0); PG8_MMA(1, 1, At, B1); PG8_BAR; PG8_SCHED;
            } else {
            PG8_LDB(B0, 0, 0); PG8_SCHED; PG8_LDA(At, 0, 0); PG8_STAGE(PG8_SA(1, 1), a1 + hstep, voffA);
            PG8_WAIT_L(8); PG8_BAR; PG8_WAIT_L(0); PG8_MMA(0, 0, At, B0); PG8_BAR; PG8_SCHED;
            PG8_LDB(B1, 0, 1); PG8_STAGE(PG8_SB(0, 0), b2, voffB);
            PG8_BAR; PG8_WAIT_L(0); PG8_MMA(0, 1, At, B1); PG8_BAR;
            PG8_LDA(At, 0, 1); PG8_STAGE(PG8_SA(0, 0), a2, voffA);
            PG8_BAR; PG8_WAIT_L(0); PG8_MMA(1, 0, At, B0); PG8_BAR; PG8_SCHED;
            PG8_STAGE(PG8_SB(0, 1), b2 + hstep, voffB);
            PG8_WAIT_V(6); PG8_BAR; PG8_MMA(1, 1, At, B1); PG8_BAR;
            PG8_LDB(B0, 1, 0); PG8_SCHED; PG8_LDA(At, 1, 0); PG8_STAGE(PG8_SA(0, 1), a2 + hstep, voffA);
            PG8_WAIT_L(8); PG8_BAR; PG8_WAIT_L(0); PG8_MMA(0, 0, At, B0); PG8_BAR; PG8_SCHED;
            PG8_LDB(B1, 1, 1); PG8_STAGE(PG8_SB(1, 0), b3, voffB);
            PG8_BAR; PG8_WAIT_L(0); PG8_MMA(0, 1, At, B1); PG8_BAR;
            PG8_LDA(At, 1, 1); PG8_STAGE(PG8_SA(1, 0), a3, voffA);
            PG8_BAR; PG8_WAIT_L(0); PG8_MMA(1, 0, At, B0); PG8_BAR; PG8_SCHED;
            PG8_STAGE(PG8_SB(1, 1), b3 + hstep, voffB);
            PG8_WAIT_V(6); PG8_BAR; PG8_MMA(1, 1, At, B1); PG8_BAR;
            }
        }
        if constexpr (ALIGN_EPI) { if (wr == 0) PG8_BAR; }
        if constexpr (!Epi::AFTER_DRAIN) { E(acc, cur, wr, wc, fr, fq); S.done(cur); }
        if (!has_next) break;
        if (!(Epi::CARRY && cur.kh == 0)) {
#pragma unroll
        for (int a = 0; a < 2; ++a)
#pragma unroll
            for (int b = 0; b < 2; ++b)
#pragma unroll
                for (int m = 0; m < 4; ++m)
#pragma unroll
                    for (int n = 0; n < 2; ++n) acc[a][b][m][n] = (f32x4){0.f, 0.f, 0.f, 0.f};
        }
        cur = nxt; cA = nA; cB = nB; ++ui;
        if constexpr (ALIGN_EPI) { if (wr == 1) PG8_BAR; }
    }
    PG8_WAIT_V(0);
    if constexpr (!ALIGN_EPI) { if (wr == 0) PG8_BAR; }
    PG8_BAR;
    if constexpr (Epi::AFTER_DRAIN) { E.fused(acc, cur, wr, wc, fr, fq, lds, wid, lane); S.done(cur); }
#undef PG8_SA
#undef PG8_SB
#undef PG8_STAGE
#undef PG8_LDA
#undef PG8_LDB
#undef PG8_MMA
#undef PG8_WAIT_V
#undef PG8_WAIT_L
#undef PG8_BAR
#undef PG8_SCHED
}
}

using pg8::bf16_t; using pg8::bf16x8; using pg8::f32x4; using pg8::u32x4; using pg8::f32x2; using pg8::cvt_pk_bf16; using pg8::bf2f; using pg8::f_lo; using pg8::f_hi;
typedef unsigned u32x2 __attribute__((ext_vector_type(2)));
#define LDS_WAIT() asm volatile("s_waitcnt lgkmcnt(0)" ::: "memory")
#define MFMA16(X, Y, C) __builtin_amdgcn_mfma_f32_16x16x32_bf16((X), (Y), (C), 0, 0, 0)

struct Params {
    const float *xp, *xs, *st0, *lbl, *gpre, *win, *lng, *lnb, *wsp, *bsp, *gon, *wpa, *wpb, *wo, *gpost;
    float* out; unsigned char* ws; int lo, hi;
};

__device__ __forceinline__ float wave_sum(float v) {
#pragma unroll
    for (int o = 1; o < 64; o <<= 1) v += __shfl_xor(v, o);
    return v;
}

__device__ __forceinline__ void p0_transpose_item(const float* W, int N, bf16_t* WT, int ldd, int koff, LAS float* scr, int kb, int nb, int lane) {
    const int k0 = 64 * kb, n0 = 32 * nb;
#pragma unroll 8
    for (int i = 0; i < 32; ++i) { const int kk = 2 * i + (lane >> 5); scr[kk * 33 + (lane & 31)] = W[(size_t)(k0 + kk) * N + n0 + (lane & 31)]; }
    LDS_WAIT(); asm volatile("" ::: "memory");
    const int c = lane & 7;
#pragma unroll
    for (int j = 0; j < 4; ++j) { const int n = (lane >> 3) + 8 * j; const LAS float* s = scr + (8 * c) * 33 + n;
        u32x4 o; o.x = cvt_pk_bf16(s[0 * 33], s[1 * 33]); o.y = cvt_pk_bf16(s[2 * 33], s[3 * 33]); o.z = cvt_pk_bf16(s[4 * 33], s[5 * 33]); o.w = cvt_pk_bf16(s[6 * 33], s[7 * 33]);
        *(u32x4*)(WT + (size_t)(n0 + n) * ldd + koff + k0 + 8 * c) = o; }
    LDS_WAIT(); asm volatile("" ::: "memory");
}

__device__ __forceinline__ void phase0(const Params& p, LAS unsigned char* lds) {
    const int tid = threadIdx.x, lane = tid & 63, wid = tid >> 6;
    const int gw = blockIdx.x * 8 + wid, NGW = gridDim.x * 8;
    unsigned char* ws = p.ws;
    bf16_t* WTIN = (bf16_t*)(ws + WS_WTIN); bf16_t* WTAB = (bf16_t*)(ws + WS_WTAB); bf16_t* WTO = (bf16_t*)(ws + WS_WTO);
    bf16_t* XN = (bf16_t*)(ws + WS_XN); bf16_t* YAB = (bf16_t*)(ws + WS_YAB); bf16_t* WSM = (bf16_t*)(ws + WS_WSM);
    LAS float* scr = (LAS float*)(lds + wid * 8448);
    constexpr int I_IN = 64 * 704, I_PA = 32 * 128, I_O = 64 * 128, NIT = I_IN + 2 * I_PA + I_O;
    for (int it = gw; it < NIT; it += NGW) {
        int r = it;
        if (r < I_IN) { p0_transpose_item(p.win, NC, WTIN, DM, 0, scr, r / 704, r % 704, lane); continue; } r -= I_IN;
        if (r < I_PA) { p0_transpose_item(p.wpa, DM, WTAB, DM, 0, scr, r / 128, r % 128, lane); continue; } r -= I_PA;
        if (r < I_PA) { p0_transpose_item(p.wpb, DM, WTAB, DM, 2048, scr, r / 128, r % 128, lane); continue; } r -= I_PA;
        p0_transpose_item(p.wo, DM, WTO, DM, 0, scr, r / 128, r % 128, lane);
    }
    for (int m = gw; m < MP; m += NGW) {
        u32x2* o8 = (u32x2*)(XN + (size_t)m * DM) + lane;
        if (m < MT) {
            const float* xr = (m < TP) ? p.xp + (size_t)m * DM : p.xs + (size_t)(m - TP) * DM;
            const f32x4* x4 = (const f32x4*)xr + lane; const f32x4* g4 = (const f32x4*)p.gpre + lane;
            f32x4 v[16]; float s = 0.f;
#pragma unroll
            for (int j = 0; j < 16; ++j) { v[j] = x4[64 * j]; s += (v[j][0] * v[j][0] + v[j][1] * v[j][1]) + (v[j][2] * v[j][2] + v[j][3] * v[j][3]); }
            const float rs = __builtin_amdgcn_rsqf(wave_sum(s) * (1.0f / DM) + EPS);
#pragma unroll
            for (int j = 0; j < 16; ++j) { const f32x4 g = g4[64 * j]; u32x2 w; w.x = cvt_pk_bf16(v[j][0] * rs * g[0], v[j][1] * rs * g[1]); w.y = cvt_pk_bf16(v[j][2] * rs * g[2], v[j][3] * rs * g[3]); o8[64 * j] = w; }
        } else {
            u32x2* y8 = (u32x2*)(YAB + (size_t)m * DM) + lane; u32x2 z; z.x = 0u; z.y = 0u;
#pragma unroll
            for (int j = 0; j < 16; ++j) { o8[64 * j] = z; y8[64 * j] = z; }
        }
    }
    for (int i = blockIdx.x * 512 + tid; i < 16 * 128 * 128; i += gridDim.x * 512) { const int s = i & 127, t = (i >> 7) & 127; WSM[i] = (s <= t) ? (bf16_t)(cvt_pk_bf16(p.wsp[i], 0.f) & 0xffffu) : (bf16_t)0; }
}

__device__ __forceinline__ void hgrn_prep_item(const Params& p, LAS unsigned char* lds, int item) {
    const int tid = threadIdx.x, lane = tid & 63, w = tid >> 6, fr = lane & 15, fq = lane >> 4;
    const int h = item & 15, n = (item >> 4) & 31, b = item >> 9;
    const int t0 = b * 2048 + n * 64, d = tid & 127, tq = tid >> 7;
    unsigned char* ws = p.ws;
    const bf16_t* H = (const bf16_t*)(ws + WS_H);
    bf16_t* QT0 = (bf16_t*)(ws + WS_QT0); bf16_t* KTT = (bf16_t*)(ws + WS_KTT); bf16_t* ITT = (bf16_t*)(ws + WS_ITT); float* OIN = (float*)(ws + WS_OIN); float* DEC = (float*)(ws + WS_DEC);
    LAS bf16_t* Qm = (LAS bf16_t*)lds;
    LAS bf16_t* Km = Qm + 64 * 136;
    LAS bf16_t* ITs = Km + 64 * 136;
    LAS bf16_t* Att = ITs + 128 * 72;
    LAS float* tot = (LAS float*)(Att + 64 * 72);
    const bf16_t* hp = H + (size_t)(t0 + tq * 16) * NC + COL_Q + h * 128 + d;
    float lf[16], qv[16]; unsigned iv[16];
#pragma unroll
    for (int j = 0; j < 16; ++j) { qv[j] = bf2f(hp[(size_t)j * NC]); lf[j] = bf2f(hp[(size_t)j * NC + (COL_F - COL_Q)]); iv[j] = hp[(size_t)j * NC + (COL_I - COL_Q)]; }
    float run = 0.f, cs[16];
#pragma unroll
    for (int j = 0; j < 16; ++j) { run += lf[j]; cs[j] = run; }
    tot[tq * 128 + d] = run;
    __syncthreads();
    const float t0v = tot[d], t1v = tot[128 + d], t2v = tot[256 + d], t3v = tot[384 + d];
    const float off = (tq > 0 ? t0v : 0.f) + (tq > 1 ? t1v : 0.f) + (tq > 2 ? t2v : 0.f);
    const float bmid = t0v + t1v, blast = (t0v + t1v) + (t2v + t3v);
    unsigned kl[8], ip[8];
#pragma unroll
    for (int j = 0; j < 16; j += 2) {
        float q0[2], klv[2];
#pragma unroll
        for (int jj = 0; jj < 2; ++jj) { const int J = j + jj; const float bj = off + cs[J]; const float f = __expf(lf[J]); const float k = 1.0f - f;
            q0[jj] = qv[J] * __expf(bj); klv[jj] = k * __expf(blast - bj);
            const float qm = qv[J] * __expf(bj - bmid), km = k * __expf(bmid - bj);
            const unsigned pk = cvt_pk_bf16(qm, km);
            Qm[(tq * 16 + J) * 136 + d] = (bf16_t)(pk & 0xffffu); Km[(tq * 16 + J) * 136 + d] = (bf16_t)(pk >> 16);
            QT0[(size_t)(t0 + tq * 16 + J) * EA + h * 128 + d] = (bf16_t)(cvt_pk_bf16(q0[jj], 0.f) & 0xffffu); }
        kl[j >> 1] = cvt_pk_bf16(klv[0], klv[1]); ip[j >> 1] = iv[j] | (iv[j + 1] << 16);
    }
    { u32x4 a, c2; a.x = kl[0]; a.y = kl[1]; a.z = kl[2]; a.w = kl[3]; c2.x = kl[4]; c2.y = kl[5]; c2.z = kl[6]; c2.w = kl[7];
      u32x4* kp = (u32x4*)(KTT + ((size_t)item * 128 + d) * 64 + tq * 16); kp[0] = a; kp[1] = c2;
      u32x4 e, f2; e.x = ip[0]; e.y = ip[1]; e.z = ip[2]; e.w = ip[3]; f2.x = ip[4]; f2.y = ip[5]; f2.z = ip[6]; f2.w = ip[7];
      u32x4* ipp = (u32x4*)(ITT + ((size_t)item * 128 + d) * 64 + tq * 16); ipp[0] = e; ipp[1] = f2;
      LAS u32x4* il = (LAS u32x4*)(ITs + d * 72 + tq * 16); il[0] = e; il[1] = f2; }
    if (tq == 0) DEC[(size_t)item * 128 + d] = __expf(blast);
    __syncthreads();
    {
        const int tb = w >> 1;
#pragma unroll
        for (int x = 0; x < 2; ++x) { const int sb = (w & 1) * 2 + x; f32x4 acc = {0.f, 0.f, 0.f, 0.f};
            if (sb <= tb) {
#pragma unroll
                for (int ks = 0; ks < 4; ++ks) { const bf16x8 X = *(const LAS bf16x8*)(Km + (sb * 16 + fr) * 136 + ks * 32 + fq * 8), Y = *(const LAS bf16x8*)(Qm + (tb * 16 + fr) * 136 + ks * 32 + fq * 8); acc = MFMA16(X, Y, acc); }
                const int t = tb * 16 + fr, s0 = sb * 16 + fq * 4;
#pragma unroll
                for (int j = 0; j < 4; ++j) acc[j] = (s0 + j <= t) ? acc[j] : 0.f;
            }
            u32x2 o; o.x = cvt_pk_bf16(acc[0], acc[1]); o.y = cvt_pk_bf16(acc[2], acc[3]);
            *(LAS u32x2*)(Att + (tb * 16 + fr) * 72 + sb * 16 + fq * 4) = o; }
    }
    __syncthreads();
    {
        const int eb = w;
#pragma unroll
        for (int tb = 0; tb < 4; ++tb) { f32x4 acc = {0.f, 0.f, 0.f, 0.f};
#pragma unroll
            for (int ks = 0; ks < 2; ++ks) { if (ks * 32 <= tb * 16 + 15) { const bf16x8 X = *(const LAS bf16x8*)(ITs + (eb * 16 + fr) * 72 + ks * 32 + fq * 8), Y = *(const LAS bf16x8*)(Att + (tb * 16 + fr) * 72 + ks * 32 + fq * 8); acc = MFMA16(X, Y, acc); } }
            *(f32x4*)(OIN + (size_t)(t0 + tb * 16 + fr) * EA + h * 128 + eb * 16 + fq * 4) = acc; }
    }
    __syncthreads();
}

__device__ __forceinline__ void hgrn_scan_item(const Params& p, LAS unsigned char* lds, int bh) {
    const int tid = threadIdx.x, lane = tid & 63, w = tid >> 6, fr = lane & 15, fq = lane >> 4;
    const int b = bh >> 4, h = bh & 15;
    unsigned char* ws = p.ws;
    const bf16_t* H = (const bf16_t*)(ws + WS_H); bf16_t* YAB = (bf16_t*)(ws + WS_YAB);
    const bf16_t* QT0 = (const bf16_t*)(ws + WS_QT0); const bf16_t* KTT = (const bf16_t*)(ws + WS_KTT); const bf16_t* ITT = (const bf16_t*)(ws + WS_ITT);
    const float* OIN = (const float*)(ws + WS_OIN); const float* DEC = (const float*)(ws + WS_DEC);
    LAS bf16_t* ST = (LAS bf16_t*)lds;
    LAS float* ssq = (LAS float*)(lds + 128 * 136 * 2);
    f32x4 S[8];
#pragma unroll
    for (int eb = 0; eb < 8; ++eb) S[eb] = (f32x4){0.f, 0.f, 0.f, 0.f};
    const int tb = w & 3, eh = w >> 2;
    const f32x4 gon[4] = { *(const f32x4*)(p.gon + h * 128 + (eh * 4 + 0) * 16 + fq * 4), *(const f32x4*)(p.gon + h * 128 + (eh * 4 + 1) * 16 + fq * 4),
                           *(const f32x4*)(p.gon + h * 128 + (eh * 4 + 2) * 16 + fq * 4), *(const f32x4*)(p.gon + h * 128 + (eh * 4 + 3) * 16 + fq * 4) };
    for (int n = 0; n < 32; ++n) {
        const int itn = (b * 32 + n) * 16 + h, t = b * 2048 + n * 64 + tb * 16 + fr;
#pragma unroll
        for (int eb = 0; eb < 8; ++eb) { u32x2 o; o.x = cvt_pk_bf16(S[eb][0], S[eb][1]); o.y = cvt_pk_bf16(S[eb][2], S[eb][3]); *(LAS u32x2*)(ST + (eb * 16 + fr) * 136 + w * 16 + fq * 4) = o; }
        __syncthreads();
        bf16x8 Yq[4];
#pragma unroll
        for (int ks = 0; ks < 4; ++ks) Yq[ks] = *(const bf16x8*)(QT0 + (size_t)t * EA + h * 128 + ks * 32 + fq * 8);
        f32x4 o[4]; float ss = 0.f;
#pragma unroll
        for (int el = 0; el < 4; ++el) { f32x4 acc = *(const f32x4*)(OIN + (size_t)t * EA + h * 128 + (eh * 4 + el) * 16 + fq * 4);
#pragma unroll
            for (int ks = 0; ks < 4; ++ks) { const bf16x8 X = *(const LAS bf16x8*)(ST + ((eh * 4 + el) * 16 + fr) * 136 + ks * 32 + fq * 8); acc = MFMA16(X, Yq[ks], acc); }
            o[el] = acc; ss += (acc[0] * acc[0] + acc[1] * acc[1]) + (acc[2] * acc[2] + acc[3] * acc[3]); }
        ss += __shfl_xor(ss, 16); ss += __shfl_xor(ss, 32);
        if (fq == 0) ssq[eh * 64 + tb * 16 + fr] = ss;
        __syncthreads();
        const float rs = __builtin_amdgcn_rsqf((ssq[tb * 16 + fr] + ssq[64 + tb * 16 + fr]) * (1.0f / 128.0f) + EPS);
#pragma unroll
        for (int el = 0; el < 4; ++el) { const int col = h * 128 + (eh * 4 + el) * 16 + fq * 4; const u32x2 zb = *(const u32x2*)(H + (size_t)t * NC + COL_ZB + col);
            u32x2 y; y.x = cvt_pk_bf16(o[el][0] * rs * gon[el][0] * f_lo(zb.x), o[el][1] * rs * gon[el][1] * f_hi(zb.x)); y.y = cvt_pk_bf16(o[el][2] * rs * gon[el][2] * f_lo(zb.y), o[el][3] * rs * gon[el][3] * f_hi(zb.y));
            *(u32x2*)(YAB + (size_t)t * DM + 2048 + col) = y; }
        const f32x4 dec = *(const f32x4*)(DEC + (size_t)itn * 128 + w * 16 + fq * 4);
        const bf16x8 Xk0 = *(const bf16x8*)(KTT + ((size_t)itn * 128 + w * 16 + fr) * 64 + fq * 8), Xk1 = *(const bf16x8*)(KTT + ((size_t)itn * 128 + w * 16 + fr) * 64 + 32 + fq * 8);
#pragma unroll
        for (int eb = 0; eb < 8; ++eb) { const bf16_t* ip = ITT + ((size_t)itn * 128 + eb * 16 + fr) * 64 + fq * 8; const bf16x8 Y0 = *(const bf16x8*)ip, Y1 = *(const bf16x8*)(ip + 32);
            f32x4 a = S[eb] * dec; a = MFMA16(Xk0, Y0, a); a = MFMA16(Xk1, Y1, a); S[eb] = a; }
    }
    float* sp = p.out + O_SP + (size_t)bh * 128 * 128;
#pragma unroll
    for (int eb = 0; eb < 8; ++eb)
#pragma unroll
        for (int j = 0; j < 4; ++j) sp[(size_t)(w * 16 + fq * 4 + j) * 128 + eb * 16 + fr] = S[eb][j];
    __syncthreads();
}

__device__ __forceinline__ void amix_item(const Params& p, LAS unsigned char* lds, int item) {
    const int tid = threadIdx.x, lane = tid & 63, w = tid >> 6, fr = lane & 15, fq = lane >> 4;
    const int g = item & 15, n = (item >> 4) & 15, b = item >> 8, t0 = b * 2048 + n * 128;
    unsigned char* ws = p.ws;
    const bf16_t* H = (const bf16_t*)(ws + WS_H); bf16_t* YAB = (bf16_t*)(ws + WS_YAB); const bf16_t* WSM = (const bf16_t*)(ws + WS_WSM); const float* LNP = (const float*)(ws + WS_LNP);
    LAS bf16_t* VT = (LAS bf16_t*)lds;
    LAS float* stats = (LAS float*)(lds + 128 * 136 * 2);
    if (tid < 128) { const f32x4* lp = (const f32x4*)(LNP + (size_t)(t0 + tid) * 64); float s1 = 0.f, s2 = 0.f;
#pragma unroll
        for (int i = 0; i < 16; ++i) { const f32x4 v = lp[i]; s1 += v[0] + v[2]; s2 += v[1] + v[3]; }
        const float mean = s1 * (1.0f / 2048.0f), var = s2 * (1.0f / 2048.0f) - mean * mean;
        stats[tid * 2] = mean; stats[tid * 2 + 1] = __builtin_amdgcn_rsqf(var + EPS); }
    __syncthreads();
#pragma unroll
    for (int i = 0; i < 4; ++i) { const int id = tid + 512 * i, r = id & 127, cc = id >> 7;
        const u32x4 v = *(const u32x4*)(H + (size_t)(t0 + r) * NC + COL_V + g * 128 + cc * 8);
        const float mean = stats[r * 2], rstd = stats[r * 2 + 1];
        const f32x4 g0 = *(const f32x4*)(p.lng + g * 128 + cc * 8), g1 = *(const f32x4*)(p.lng + g * 128 + cc * 8 + 4), b0 = *(const f32x4*)(p.lnb + g * 128 + cc * 8), b1 = *(const f32x4*)(p.lnb + g * 128 + cc * 8 + 4);
        float vn[8];
        vn[0] = (f_lo(v.x) - mean) * rstd * g0[0] + b0[0]; vn[1] = (f_hi(v.x) - mean) * rstd * g0[1] + b0[1]; vn[2] = (f_lo(v.y) - mean) * rstd * g0[2] + b0[2]; vn[3] = (f_hi(v.y) - mean) * rstd * g0[3] + b0[3];
        vn[4] = (f_lo(v.z) - mean) * rstd * g1[0] + b1[0]; vn[5] = (f_hi(v.z) - mean) * rstd * g1[1] + b1[1]; vn[6] = (f_lo(v.w) - mean) * rstd * g1[2] + b1[2]; vn[7] = (f_hi(v.w) - mean) * rstd * g1[3] + b1[3];
        if (n == 15) { float* vp = p.out + O_VP + ((size_t)(b * 128 + r)) * EA + g * 128 + cc * 8; *(f32x4*)vp = (f32x4){vn[0], vn[1], vn[2], vn[3]}; *(f32x4*)(vp + 4) = (f32x4){vn[4], vn[5], vn[6], vn[7]}; }
#pragma unroll
        for (int k = 0; k < 8; k += 2) { const unsigned pk = cvt_pk_bf16(vn[k], vn[k + 1]); VT[(cc * 8 + k) * 136 + r] = (bf16_t)(pk & 0xffffu); VT[(cc * 8 + k + 1) * 136 + r] = (bf16_t)(pk >> 16); }
    }
    __syncthreads();
    {
        const int tb = w, nks = (tb >> 1) + 1, t = t0 + tb * 16 + fr;
        bf16x8 Yw[4];
#pragma unroll
        for (int ks = 0; ks < 4; ++ks) { if (ks < nks) Yw[ks] = *(const bf16x8*)(WSM + ((size_t)(g * 128 + tb * 16 + fr)) * 128 + ks * 32 + fq * 8); else Yw[ks] = (bf16x8){0, 0, 0, 0, 0, 0, 0, 0}; }
        const float bs = p.bsp[g * 128 + tb * 16 + fr];
#pragma unroll
        for (int cb = 0; cb < 8; ++cb) { f32x4 acc = {0.f, 0.f, 0.f, 0.f};
#pragma unroll
            for (int ks = 0; ks < 4; ++ks) { if (ks < nks) { const bf16x8 X = *(const LAS bf16x8*)(VT + (cb * 16 + fr) * 136 + ks * 32 + fq * 8); acc = MFMA16(X, Yw[ks], acc); } }
            const int col = g * 128 + cb * 16 + fq * 4;
            const u32x2 u = *(const u32x2*)(H + (size_t)t * NC + COL_U + col), za = *(const u32x2*)(H + (size_t)t * NC + COL_ZA + col);
            u32x2 y; y.x = cvt_pk_bf16(f_lo(u.x) * (acc[0] + bs) * f_lo(za.x), f_hi(u.x) * (acc[1] + bs) * f_hi(za.x)); y.y = cvt_pk_bf16(f_lo(u.y) * (acc[2] + bs) * f_lo(za.y), f_hi(u.y) * (acc[3] + bs) * f_hi(za.y));
            *(u32x2*)(YAB + (size_t)t * DM + col) = y; }
    }
    __syncthreads();
}

__device__ __forceinline__ void hgrn_sample_item(const Params& p, LAS unsigned char* lds, int item) {
    const int tid = threadIdx.x, lane = tid & 63, w = tid >> 6;
    const int bs = item >> 4, h = item & 15, row = TP + bs, e4 = tid & 31, dg = tid >> 5;
    unsigned char* ws = p.ws;
    const bf16_t* H = (const bf16_t*)(ws + WS_H); bf16_t* YAB = (bf16_t*)(ws + WS_YAB);
    LAS float* red = (LAS float*)lds;
    LAS float* ssw = red + 16 * 128;
    const bf16_t* hr = H + (size_t)row * NC + h * 128;
    const u32x2 ii = *(const u32x2*)(hr + COL_I + e4 * 4);
    const f32x4 i4 = {f_lo(ii.x), f_hi(ii.x), f_lo(ii.y), f_hi(ii.y)};
    const u32x4 q8 = *(const u32x4*)(hr + COL_Q + dg * 8), l8 = *(const u32x4*)(hr + COL_F + dg * 8);
    const float qv[8] = {f_lo(q8.x), f_hi(q8.x), f_lo(q8.y), f_hi(q8.y), f_lo(q8.z), f_hi(q8.z), f_lo(q8.w), f_hi(q8.w)};
    const float lv[8] = {f_lo(l8.x), f_hi(l8.x), f_lo(l8.y), f_hi(l8.y), f_lo(l8.z), f_hi(l8.z), f_lo(l8.w), f_hi(l8.w)};
    const size_t sbase = ((size_t)item * 128 + dg * 8) * 128 + e4 * 4;
    const f32x4* s0 = (const f32x4*)(p.st0 + sbase); f32x4* s1 = (f32x4*)(p.out + O_SS + sbase);
    f32x4 po = {0.f, 0.f, 0.f, 0.f};
#pragma unroll
    for (int j = 0; j < 8; ++j) { const float f = __expf(lv[j]), k = 1.0f - f; const f32x4 sn = s0[j * 32] * f + i4 * k; s1[j * 32] = sn; po += sn * qv[j]; }
    *(LAS f32x4*)(red + dg * 128 + e4 * 4) = po;
    __syncthreads();
    float o = 0.f;
    if (tid < 128) {
#pragma unroll
        for (int k = 0; k < 16; ++k) o += red[k * 128 + tid];
        const float s = wave_sum(o * o);
        if (lane == 0) ssw[w] = s;
    }
    __syncthreads();
    if (tid < 128) { const float rs = __builtin_amdgcn_rsqf((ssw[0] + ssw[1]) * (1.0f / 128.0f) + EPS);
        const float y = o * rs * p.gon[h * 128 + tid] * bf2f(hr[COL_ZB + tid]);
        YAB[(size_t)row * DM + 2048 + h * 128 + tid] = (bf16_t)(cvt_pk_bf16(y, 0.f) & 0xffffu); }
    __syncthreads();
}

__device__ __forceinline__ void amix_sample_item(const Params& p, int bs) {
    const int tid = threadIdx.x, row = TP + bs, c0 = tid * 4, g = c0 >> 7;
    unsigned char* ws = p.ws;
    const bf16_t* H = (const bf16_t*)(ws + WS_H); bf16_t* YAB = (bf16_t*)(ws + WS_YAB); const float* LNP = (const float*)(ws + WS_LNP);
    const f32x4* lp = (const f32x4*)(LNP + (size_t)row * 64); float s1 = 0.f, s2 = 0.f;
#pragma unroll
    for (int i = 0; i < 16; ++i) { const f32x4 v = lp[i]; s1 += v[0] + v[2]; s2 += v[1] + v[3]; }
    const float mean = s1 * (1.0f / 2048.0f), rstd = __builtin_amdgcn_rsqf(s2 * (1.0f / 2048.0f) - mean * mean + EPS);
    const bf16_t* hr = H + (size_t)row * NC + c0;
    const u32x2 v = *(const u32x2*)(hr + COL_V), u = *(const u32x2*)(hr + COL_U), za = *(const u32x2*)(hr + COL_ZA);
    const f32x4 lg = *(const f32x4*)(p.lng + c0), lb = *(const f32x4*)(p.lnb + c0);
    f32x4 vn; vn[0] = (f_lo(v.x) - mean) * rstd * lg[0] + lb[0]; vn[1] = (f_hi(v.x) - mean) * rstd * lg[1] + lb[1]; vn[2] = (f_lo(v.y) - mean) * rstd * lg[2] + lb[2]; vn[3] = (f_hi(v.y) - mean) * rstd * lg[3] + lb[3];
    *(f32x4*)(p.out + O_VS + (size_t)bs * EA + c0) = vn;
    const float w00 = p.wsp[(size_t)g * 128 * 128], b0 = p.bsp[g * 128];
    u32x2 y; y.x = cvt_pk_bf16(f_lo(u.x) * (w00 * vn[0] + b0) * f_lo(za.x), f_hi(u.x) * (w00 * vn[1] + b0) * f_hi(za.x)); y.y = cvt_pk_bf16(f_lo(u.y) * (w00 * vn[2] + b0) * f_lo(za.y), f_hi(u.y) * (w00 * vn[3] + b0) * f_hi(za.y));
    *(u32x2*)(YAB + (size_t)row * DM + c0) = y;
}

__device__ __forceinline__ void phase_final(const Params& p) {
    const int tid = threadIdx.x, lane = tid & 63, wid = tid >> 6;
    const int gw = blockIdx.x * 8 + wid, NGW = gridDim.x * 8;
    const bf16_t* Z = (const bf16_t*)(p.ws + WS_Z); const float* SSP = (const float*)(p.ws + WS_SSP);
    for (int m = gw; m < MT; m += NGW) {
        const float rs = __builtin_amdgcn_rsqf(wave_sum(SSP[(size_t)m * 64 + lane]) * (1.0f / DM) + EPS);
        const float* xr = (m < TP) ? p.xp + (size_t)m * DM : p.xs + (size_t)(m - TP) * DM;
        float* yr = p.out + (size_t)m * DM;
        const f32x4* x4 = (const f32x4*)xr + lane; const f32x4* g4 = (const f32x4*)p.gpost + lane; const u32x2* z8 = (const u32x2*)(Z + (size_t)m * DM) + lane; f32x4* y4 = (f32x4*)yr + lane;
#pragma unroll
        for (int j = 0; j < 16; ++j) { const f32x4 x = x4[64 * j], g = g4[64 * j]; const u32x2 z = z8[64 * j];
            f32x4 y; y[0] = x[0] + f_lo(z.x) * rs * g[0]; y[1] = x[1] + f_hi(z.x) * rs * g[1]; y[2] = x[2] + f_lo(z.y) * rs * g[2]; y[3] = x[3] + f_hi(z.y) * rs * g[3]; y4[64 * j] = y; }
    }
}

__global__ void __launch_bounds__(512, 2) mega(Params p) {
    extern __shared__ __attribute__((aligned(16))) unsigned char lds_raw[];
    LAS unsigned char* lds = (LAS unsigned char*)lds_raw;
    cg::grid_group grid = cg::this_grid();
    const int lo = p.lo, hi = p.hi, G = gridDim.x, bid = blockIdx.x;
    unsigned char* ws = p.ws;
#define IN(k) (lo <= (k) && (k) < hi)
#define SEAM(k) do { if (IN(k) && IN((k) + 1)) { __threadfence(); grid.sync(); __threadfence(); } } while (0)
#if MK_DELAY_US > 0
    if (lo == 0) { const unsigned long long t0 = __builtin_amdgcn_s_memrealtime(); while (__builtin_amdgcn_s_memrealtime() - t0 < (unsigned long long)MK_DELAY_US * 100ull) __builtin_amdgcn_s_sleep(32); }
#endif
    if (IN(0)) phase0(p, lds);
    SEAM(0);
    if (IN(1)) {
        pg8::Gemm g{(const bf16_t*)(ws + WS_XN), (const bf16_t*)(ws + WS_WTIN), MP, NC, DM, DM / 64, 0}; pg8::G1ORDER S; S.init(MP, NC, G, bid);
        pg8::EpiAct E{(bf16_t*)(ws + WS_H), p.lbl, (float*)(ws + WS_LNP)};
        pg8::gemm_phase<pg8::EpiAct, pg8::G1ORDER, true, true>(lds, g, S, E);
    }
    SEAM(1);
#if MK_DUMP == 1
    { const bf16_t* Y = (const bf16_t*)(ws + WS_H); for (size_t i = (size_t)bid * 512 + threadIdx.x; i < O_END; i += (size_t)G * 512) { const size_t r = i >> 13, cc = i & 8191; p.out[i] = (r < (size_t)MP) ? bf2f(Y[r * NC + 14336 + cc]) : 0.f; } return; }
#endif
    if (IN(2)) { for (int it = bid; it < 2048; it += G) hgrn_prep_item(p, lds, it); }
    SEAM(2);
    if (IN(3)) {
        constexpr int N_AM = 1024, N_HS = 2048, N_AS = 128, N_OTHER = N_AM + N_HS + N_AS;
        const int nscan = (G > 64) ? 64 : 0;
        if (bid < nscan) hgrn_scan_item(p, lds, bid);
        else {
            if (nscan == 0) for (int it = bid; it < 64; it += G) hgrn_scan_item(p, lds, it);
            for (int it = bid - nscan; it < N_OTHER; it += G - nscan) {
                if (it < N_HS) hgrn_sample_item(p, lds, it);
                else if (it < N_HS + N_AM) amix_item(p, lds, it - N_HS);
                else amix_sample_item(p, it - N_HS - N_AM);
            }
        }
    }
    SEAM(3);
#if MK_DUMP == 3
    { const bf16_t* Y = (const bf16_t*)(ws + WS_YAB); for (size_t i = (size_t)bid * 512 + threadIdx.x; i < O_END; i += (size_t)G * 512) p.out[i] = (i < (size_t)MP * DM) ? bf2f(Y[i]) : 0.f; return; }
#endif
    if (IN(4)) {
        pg8::Gemm g{(const bf16_t*)(ws + WS_YAB), (const bf16_t*)(ws + WS_WTAB), MP, DM, DM, 32, (size_t)2048 * 2}; pg8::PairOrder S; S.init(MP, DM, G, bid);
        pg8::EpiMerge E{(const bf16_t*)(ws + WS_H), (bf16_t*)(ws + WS_MRG)};
        pg8::gemm_phase<pg8::EpiMerge, pg8::PairOrder, true, true>(lds, g, S, E);
    }
    SEAM(4);
#if MK_DUMP == 4
    { const bf16_t* Y = (const bf16_t*)(ws + WS_MRG); for (size_t i = (size_t)bid * 512 + threadIdx.x; i < O_END; i += (size_t)G * 512) p.out[i] = (i < (size_t)MP * DM) ? bf2f(Y[i]) : 0.f; return; }
#endif
    if (IN(5)) {
        pg8::Gemm g{(const bf16_t*)(ws + WS_MRG), (const bf16_t*)(ws + WS_WTO), MP, DM, DM, DM / 64, 0}; pg8::StaticOrder S; S.init(MP, DM, G, bid);
        pg8::EpiZ E{(bf16_t*)(ws + WS_Z), (float*)(ws + WS_SSP)};
        pg8::gemm_phase<pg8::EpiZ, pg8::StaticOrder, true, true>(lds, g, S, E);
    }
    SEAM(5);
    if (IN(6)) phase_final(p);
#undef IN
#undef SEAM
}

extern "C" void kernel_launch(void* const* d_in, const int* in_sizes, int n_in, void* d_out, int out_size, void* d_ws, size_t ws_size, hipStream_t stream) {
    static int grid = 0;
    if (grid == 0) {
        if (n_in != 15 || (size_t)out_size != O_END || ws_size < WS_END) { fprintf(stderr, "kernel_launch: unexpected shapes: n_in %d out %d ws %zu (need %zu)\n", n_in, out_size, ws_size, (size_t)WS_END); grid = -1; return; }
        int dev = 0, cus = 0, per_cu = 0;
        if (hipGetDevice(&dev) != hipSuccess || hipDeviceGetAttribute(&cus, hipDeviceAttributeMultiprocessorCount, dev) != hipSuccess) { fprintf(stderr, "kernel_launch: device query failed\n"); grid = -1; return; }
        if (hipFuncSetAttribute((const void*)mega, hipFuncAttributeMaxDynamicSharedMemorySize, LDS_BYTES) != hipSuccess) { fprintf(stderr, "kernel_launch: hipFuncSetAttribute failed\n"); grid = -1; return; }
        if (hipOccupancyMaxActiveBlocksPerMultiprocessor(&per_cu, (const void*)mega, 512, LDS_BYTES) != hipSuccess || per_cu < 1) { fprintf(stderr, "kernel_launch: occupancy query says %d\n", per_cu); per_cu = 1; }
        (void)hipGetLastError();
        grid = cus * per_cu;
        fprintf(stderr, "kernel_launch: grid %d (cus %d x %d)\n", grid, cus, per_cu);
    }
    if (grid < 0) return;
    Params p{};
    p.xp = (const float*)d_in[0]; p.xs = (const float*)d_in[1]; p.st0 = (const float*)d_in[2]; p.lbl = (const float*)d_in[3]; p.gpre = (const float*)d_in[4]; p.win = (const float*)d_in[5];
    p.lng = (const float*)d_in[6]; p.lnb = (const float*)d_in[7]; p.wsp = (const float*)d_in[8]; p.bsp = (const float*)d_in[9]; p.gon = (const float*)d_in[10]; p.wpa = (const float*)d_in[11];
    p.wpb = (const float*)d_in[12]; p.wo = (const float*)d_in[13]; p.gpost = (const float*)d_in[14];
    p.out = (float*)d_out; p.ws = (unsigned char*)d_ws;
#if MK_MULTI
    for (int ph = 0; ph < 7; ++ph) { p.lo = ph; p.hi = ph + 1; hipLaunchKernelGGL(mega, dim3(grid), dim3(512), LDS_BYTES, stream, p); }
#else
    p.lo = 0; p.hi = 7;
    void* args[] = {&p};
    hipError_t e = hipLaunchCooperativeKernel((const void*)mega, dim3(grid), dim3(512), args, LDS_BYTES, stream);
    if (e != hipSuccess) fprintf(stderr, "kernel_launch: cooperative launch failed: %s (grid %d)\n", hipGetErrorString(e), grid);
#endif
}
```

```cpp
#include <hip/hip_runtime.h>
#include <hip/hip_cooperative_groups.h>
#include <cstdio>
#include <cstdint>
namespace cg = cooperative_groups;

#ifndef MK_MULTI
#define MK_MULTI 0
#endif

#ifndef G1ORDER
#define G1ORDER StaticOrder
#endif
#ifndef MK_DELAY_US
#define MK_DELAY_US 0
#endif
#ifndef MK_REP
#define MK_REP 0
#endif
#ifndef MK_SUB
#define MK_SUB 0
#endif
#ifndef MK_XSYNC
#define MK_XSYNC 0
#endif
#ifndef MK_DUMP
#define MK_DUMP 0
#endif

constexpr int DM = 4096, NC = 22528, TP = 8192, TS = 128, MT = TP + TS, MP = 8448, EA = 2048;
constexpr int COL_U = 0, COL_V = 2048, COL_ZA = 4096, COL_Q = 6144, COL_F = 8192, COL_I = 10240, COL_ZB = 12288, COL_GA = 14336, COL_GB = 18432;
constexpr float EPS = 1e-6f;
constexpr size_t WS_CTLB = 65536;
constexpr size_t WS_WTIN = WS_CTLB;
constexpr size_t WS_WTAB = WS_WTIN + (size_t)NC * DM * 2;
constexpr size_t WS_WTO  = WS_WTAB + (size_t)DM * DM * 2;
constexpr size_t WS_XN   = WS_WTO + (size_t)DM * DM * 2;
constexpr size_t WS_H    = WS_XN + (size_t)MP * DM * 2;
constexpr size_t WS_YAB  = WS_H + (size_t)MP * NC * 2;
constexpr size_t WS_MRG  = WS_YAB + (size_t)MP * DM * 2;
constexpr size_t WS_SN   = WS_MRG;
constexpr size_t WS_Z    = WS_MRG + (size_t)MP * DM * 2;
constexpr size_t WS_LNP  = WS_Z + (size_t)MP * DM * 2;
constexpr size_t WS_SSP  = WS_LNP + (size_t)MP * 64 * 4;
constexpr size_t WS_WSM  = WS_SSP + (size_t)MP * 64 * 4;
constexpr size_t WS_QT0  = WS_WSM + (size_t)16 * 128 * 128 * 2;
constexpr size_t WS_KTT  = WS_QT0 + (size_t)TP * EA * 2;
constexpr size_t WS_ITT  = WS_KTT + (size_t)TP * EA * 2;
constexpr size_t WS_OIN  = WS_ITT + (size_t)TP * EA * 2;
constexpr size_t WS_DEC  = WS_OIN + (size_t)TP * EA * 4;
constexpr size_t WS_END  = WS_DEC + (size_t)2048 * 128 * 4;
constexpr size_t O_YP = 0, O_YS = O_YP + (size_t)TP * DM, O_SP = O_YS + (size_t)TS * DM, O_SS = O_SP + (size_t)4 * 16 * 128 * 128,
                 O_VP = O_SS + (size_t)128 * 16 * 128 * 128, O_VS = O_VP + (size_t)4 * 128 * EA, O_END = O_VS + (size_t)128 * EA;
constexpr int LDS_STAGE = 128 * 1024, LDS_BYTES = LDS_STAGE + 256;

#define LAS __attribute__((address_space(3)))
#define XB_TMO      128
#define XB_XCNT(j)  (256  + 64 * (j))
#define XB_XSUB(j)  (1280 + 64 * (j))
#define XB_XGEN(j)  (2304 + 64 * (j))
#define XB_TOP      3328
#define XB_TOPGEN   3392
#define XCD_BAR_WORDS 3456
#define XB_SPIN_CAP (1u << 18)

__device__ __forceinline__ unsigned xb_ld(unsigned* p)              { return __hip_atomic_load(p, __ATOMIC_RELAXED, __HIP_MEMORY_SCOPE_AGENT); }
__device__ __forceinline__ unsigned xb_add(unsigned* p, unsigned v) { return __hip_atomic_fetch_add(p, v, __ATOMIC_RELAXED, __HIP_MEMORY_SCOPE_AGENT); }
__device__ __forceinline__ unsigned xb_xcc_id() { return (unsigned)__builtin_amdgcn_s_getreg((3 << 11) | 20) & 0xFu; }
#define XB_SPIN(cond, bar) do { unsigned _sp = 0; while (cond) { __builtin_amdgcn_s_sleep(1); \
    if ((++_sp & 255u) == 0u) { if (xb_ld(&(bar)[XB_TMO])) break; if (_sp > XB_SPIN_CAP) { atomicAdd(&(bar)[XB_TMO], 1u); break; } } } } while (0)

struct XcdBarrier {
    unsigned* bar; unsigned x;
    volatile LAS unsigned* st;
};

__device__ __forceinline__ XcdBarrier xcd_barrier_post(unsigned* bar, volatile LAS unsigned* st) {
    XcdBarrier b; b.bar = bar; b.x = xb_xcc_id(); b.st = st;
    if (threadIdx.x == 0) (void)xb_add(&bar[XB_XCNT(b.x)], 1u);
    return b;
}
__device__ __forceinline__ void xcd_barrier_complete(unsigned* bar, unsigned x, unsigned& nloc, unsigned& nx) {
    const unsigned G = gridDim.x * gridDim.y * gridDim.z;
    unsigned sum, cnt, mine, sp = 0u;
    for (;;) {
        sum = 0u; cnt = 0u; mine = 0u;
#pragma unroll
        for (unsigned j = 0; j < 16; ++j) { const unsigned c = xb_ld(&bar[XB_XCNT(j)]); sum += c; cnt += (c > 0u) ? 1u : 0u; mine = (j == x) ? c : mine; }
        if (sum == G) break;
        __builtin_amdgcn_s_sleep(1);
        if ((++sp & 255u) == 0u) { if (xb_ld(&bar[XB_TMO])) break; if (sp > XB_SPIN_CAP) { atomicAdd(&bar[XB_TMO], 1u); break; } }
    }
    nloc = mine > 0u ? mine : 1u; nx = cnt > 0u ? cnt : 1u;
}

__device__ __forceinline__ void xcd_barrier(const XcdBarrier& b) {
    asm volatile("s_waitcnt vmcnt(0)" ::: "memory");
    __syncthreads();
    if (threadIdx.x == 0) {
        unsigned* bar = b.bar;
        __builtin_amdgcn_s_waitcnt(0);
        unsigned nloc = b.st[0], nx = b.st[1];
        if (nloc == 0u) { xcd_barrier_complete(bar, b.x, nloc, nx); b.st[0] = nloc; b.st[1] = nx; }
        const unsigned old = xb_add(&bar[XB_XSUB(b.x)], 1u);
        const unsigned gen = old / nloc;
        if (old + 1u == (gen + 1u) * nloc) {
            __builtin_amdgcn_fence(__ATOMIC_RELEASE, "agent");
            asm volatile("s_waitcnt vmcnt(0)" ::: "memory");
            const unsigned og = xb_add(&bar[XB_TOP], 1u);
            const unsigned tg = og / nx;
            if (og + 1u == (tg + 1u) * nx) xb_add(&bar[XB_TOPGEN], 1u);
            else XB_SPIN(xb_ld(&bar[XB_TOPGEN]) == tg, bar);
            __builtin_amdgcn_fence(__ATOMIC_ACQUIRE, "agent");
            xb_add(&bar[XB_XGEN(b.x)], 1u);
            asm volatile("s_waitcnt vmcnt(0)" ::: "memory");
        } else {
            XB_SPIN(xb_ld(&bar[XB_XGEN(b.x)]) == gen, bar);
            __builtin_amdgcn_fence(__ATOMIC_ACQUIRE, "agent");
            asm volatile("s_waitcnt vmcnt(0)" ::: "memory");
        }
    }
    __syncthreads();
}

namespace pg8 {
#define PG8_LAS __attribute__((address_space(3)))
typedef unsigned short bf16_t;
typedef short bf16x8 __attribute__((ext_vector_type(8)));
typedef float f32x4 __attribute__((ext_vector_type(4)));
typedef unsigned u32x4 __attribute__((ext_vector_type(4)));
constexpr int BM = 256, BK = 64, HALF = 128, HTB = HALF * BK * 2  , STAGE_BYTES = 8 * HTB, NXCD = 8, WGM = 8;

__host__ __device__ __forceinline__ int lds_byte(int r, int c) { const int st = (r >> 4) * 2 + (c >> 5), rr = r & 15, cc = c & 31, ob = rr * 64 + cc * 2; return st * 1024 + (ob ^ (((ob >> 9) & 1) << 5)); }
__host__ __device__ __forceinline__ void stage_rc(int b, int& R, int& C) { const int st = b / 1024, sb = b % 1024, swz = sb ^ (((sb >> 9) & 1) << 5); R = (st >> 1) * 16 + swz / 64; C = (st & 1) * 32 + (swz % 64) / 2; }
__host__ __device__ __forceinline__ int perm32(int rho) { const int n = rho >> 4, i = rho & 15; return 8 * (i >> 2) + 4 * n + (i & 3); }

struct Unit { int pm, pn, kh; };
struct Gemm { const bf16_t* A; const bf16_t* Bt; int M, N, K, nt; size_t khoff; };

struct StaticOrder {
    int nM, nN, nwg, G, c;
    __host__ __device__ void init(int M, int N, int G_, int c_) { nM = M / BM; nN = N / BM; nwg = nM * nN; G = G_; c = c_; }
    __host__ __device__ bool next(int i, Unit& u) const {
        const long L = (long)i * G + c; if (L >= nwg) return false;
        int wgid = (int)L; { const int q = nwg / NXCD, r = nwg % NXCD, xcd = wgid % NXCD, off = wgid / NXCD; wgid = (xcd < r ? xcd * (q + 1) : r * (q + 1) + (xcd - r) * q) + off; }
        const int nig = WGM * nN, gid = wgid / nig, fm = gid * WGM, gsz = (nM - fm) < WGM ? (nM - fm) : WGM;
        u.pm = fm + ((wgid % nig) % gsz); u.pn = (wgid % nig) / gsz; u.kh = 0; return true;
    }
    __device__ __forceinline__ void a_ready(const Unit&) const {}
    __device__ __forceinline__ void done(const Unit&) const {}
};

typedef float f32x2 __attribute__((ext_vector_type(2)));
typedef __bf16 bf16x2_t __attribute__((ext_vector_type(2)));
__device__ __forceinline__ unsigned cvt_pk_bf16(float lo, float hi) { const f32x2 v = {lo, hi}; return __builtin_bit_cast(unsigned, __builtin_convertvector(v, bf16x2_t)); }
__device__ __forceinline__ float bf2f(unsigned short b) { return __builtin_bit_cast(float, (unsigned)b << 16); }
__device__ __forceinline__ float f_lo(unsigned w) { return __builtin_bit_cast(float, w << 16); }
__device__ __forceinline__ float f_hi(unsigned w) { return __builtin_bit_cast(float, w & 0xffff0000u); }
__device__ __forceinline__ float fsigmoid(float x) { return __builtin_amdgcn_rcpf(1.0f + __expf(-x)); }
__device__ __forceinline__ float fsilu(float x) { return x * fsigmoid(x); }
__device__ __forceinline__ float fgelu(float x) { return x * fsigmoid(1.5957691216057308f * (x + 0.044715f * x * x * x)); }

struct EpiAct {
    static constexpr bool PERM = true, AFTER_DRAIN = false, CARRY = false;
    bf16_t* H; const float* lbl; float* lnp;
    template <int ACT> __device__ __forceinline__ void run(const f32x4 (&acc)[2][2][4][2], const Unit& u, int wr, int wc, int fr, int fq) const {
        const int row0 = u.pm * BM + wr * 64 + fr, col0 = u.pn * BM + wc * 32 + 8 * fq;
        float lb[2][8];
        if (ACT == 3) {
#pragma unroll
            for (int bj = 0; bj < 2; ++bj) { const float* l0 = lbl + (col0 + bj * HALF - 8192); const f32x4 a0 = *(const f32x4*)l0, a1 = *(const f32x4*)(l0 + 4), b0 = *(const f32x4*)(l0 + 2048), b1 = *(const f32x4*)(l0 + 2052);
#pragma unroll
                for (int k = 0; k < 4; ++k) { lb[bj][k] = __builtin_amdgcn_rcpf(1.0f + __expf(b0[k] - a0[k])); lb[bj][4 + k] = __builtin_amdgcn_rcpf(1.0f + __expf(b1[k] - a1[k])); } }
        }
#pragma unroll
        for (int ai = 0; ai < 2; ++ai)
#pragma unroll
            for (int m = 0; m < 4; ++m) { const int row = row0 + ai * HALF + m * 16; bf16_t* rowp = H + (size_t)row * 22528 + col0; float s1 = 0.f, s2 = 0.f;
#pragma unroll
                for (int bj = 0; bj < 2; ++bj) { float v[8];
#pragma unroll
                    for (int k = 0; k < 4; ++k) { v[k] = acc[ai][bj][m][0][k]; v[4 + k] = acc[ai][bj][m][1][k]; }
#pragma unroll
                    for (int k = 0; k < 8; ++k) {
                        if (ACT == 0 || ACT == 1) v[k] = fgelu(v[k]);
                        if (ACT == 2) v[k] = fsilu(v[k]);
                        if (ACT == 3) v[k] = __logf(lb[bj][k] + (1.0f - lb[bj][k]) * fsigmoid(v[k]));
                        if (ACT == 5) v[k] = fsigmoid(v[k]);
                        if (ACT == 1) { s1 += v[k]; s2 += v[k] * v[k]; }
                    }
                    u32x4 w; w.x = cvt_pk_bf16(v[0], v[1]); w.y = cvt_pk_bf16(v[2], v[3]); w.z = cvt_pk_bf16(v[4], v[5]); w.w = cvt_pk_bf16(v[6], v[7]);
                    *(u32x4*)(rowp + bj * HALF) = w; }
                if (ACT == 1) { s1 += __shfl_xor(s1, 16); s1 += __shfl_xor(s1, 32); s2 += __shfl_xor(s2, 16); s2 += __shfl_xor(s2, 32);
                    if (fq == 0) { f32x2 o; o.x = s1; o.y = s2; *(f32x2*)(lnp + (size_t)row * 64 + ((u.pn - 8) * 4 + wc) * 2) = o; } }
            }
    }
    __device__ __forceinline__ void operator()(const f32x4 (&acc)[2][2][4][2], const Unit& u, int wr, int wc, int fr, int fq) const {
        const int pn = u.pn;
        if (pn < 8) run<0>(acc, u, wr, wc, fr, fq);
        else if (pn < 16) run<1>(acc, u, wr, wc, fr, fq);
        else if (pn < 32) run<2>(acc, u, wr, wc, fr, fq);
        else if (pn < 40) run<3>(acc, u, wr, wc, fr, fq);
        else if (pn < 48) run<4>(acc, u, wr, wc, fr, fq);
        else if (pn < 56) run<2>(acc, u, wr, wc, fr, fq);
        else run<5>(acc, u, wr, wc, fr, fq);
    }
};

struct EpiMerge {
    static constexpr bool PERM = true, AFTER_DRAIN = false, CARRY = true;
    const bf16_t* H; bf16_t* O;
    __device__ __forceinline__ void mid(f32x4 (&acc)[2][2][4][2], const Unit& u, int wr, int wc, int fr, int fq) const {
        const int row0 = u.pm * BM + wr * 64 + fr, col0 = u.pn * BM + wc * 32 + 8 * fq;
#pragma unroll
        for (int ai = 0; ai < 2; ++ai)
#pragma unroll
            for (int m = 0; m < 4; ++m) { const bf16_t* gp = H + (size_t)(row0 + ai * HALF + m * 16) * 22528 + 14336 + col0;
#pragma unroll
                for (int bj = 0; bj < 2; ++bj) { const u32x4 a = *(const u32x4*)(gp + bj * HALF), b = *(const u32x4*)(gp + 4096 + bj * HALF);
                    f32x4 r0, r1;
                    r0[0] = f_lo(a.x) * __builtin_amdgcn_rcpf(f_lo(b.x)); r0[1] = f_hi(a.x) * __builtin_amdgcn_rcpf(f_hi(b.x)); r0[2] = f_lo(a.y) * __builtin_amdgcn_rcpf(f_lo(b.y)); r0[3] = f_hi(a.y) * __builtin_amdgcn_rcpf(f_hi(b.y));
                    r1[0] = f_lo(a.z) * __builtin_amdgcn_rcpf(f_lo(b.z)); r1[1] = f_hi(a.z) * __builtin_amdgcn_rcpf(f_hi(b.z)); r1[2] = f_lo(a.w) * __builtin_amdgcn_rcpf(f_lo(b.w)); r1[3] = f_hi(a.w) * __builtin_amdgcn_rcpf(f_hi(b.w));
                    acc[ai][bj][m][0] *= r0; acc[ai][bj][m][1] *= r1; }
                asm volatile("" ::: "memory"); }
    }
    __device__ __forceinline__ void operator()(f32x4 (&acc)[2][2][4][2], const Unit& u, int wr, int wc, int fr, int fq) const {
        if (u.kh == 0) { mid(acc, u, wr, wc, fr, fq); return; }
        const int row0 = u.pm * BM + wr * 64 + fr, col0 = u.pn * BM + wc * 32 + 8 * fq;
#pragma unroll
        for (int ai = 0; ai < 2; ++ai)
#pragma unroll
            for (int m = 0; m < 4; ++m) { const int row = row0 + ai * HALF + m * 16; const bf16_t* gp = H + (size_t)row * 22528 + 18432 + col0; bf16_t* rowp = O + (size_t)row * 4096 + col0;
#pragma unroll
                for (int bj = 0; bj < 2; ++bj) { const u32x4 b = *(const u32x4*)(gp + bj * HALF); const f32x4 v0 = acc[ai][bj][m][0], v1 = acc[ai][bj][m][1];
                    u32x4 w; w.x = cvt_pk_bf16(v0[0] * f_lo(b.x), v0[1] * f_hi(b.x)); w.y = cvt_pk_bf16(v0[2] * f_lo(b.y), v0[3] * f_hi(b.y));
                    w.z = cvt_pk_bf16(v1[0] * f_lo(b.z), v1[1] * f_hi(b.z)); w.w = cvt_pk_bf16(v1[2] * f_lo(b.w), v1[3] * f_hi(b.w));
                    *(u32x4*)(rowp + bj * HALF) = w; }
                asm volatile("" ::: "memory"); }
    }
};

struct EpiZ {
    static constexpr bool PERM = true, AFTER_DRAIN = false, CARRY = false;
    bf16_t* Z; float* ssp;
    __device__ __forceinline__ void operator()(const f32x4 (&acc)[2][2][4][2], const Unit& u, int wr, int wc, int fr, int fq) const {
        const int row0 = u.pm * BM + wr * 64 + fr, col0 = u.pn * BM + wc * 32 + 8 * fq;
#pragma unroll
        for (int ai = 0; ai < 2; ++ai)
#pragma unroll
            for (int m = 0; m < 4; ++m) { const int row = row0 + ai * HALF + m * 16; bf16_t* rowp = Z + (size_t)row * 4096 + col0; float ss = 0.f;
#pragma unroll
                for (int bj = 0; bj < 2; ++bj) { const f32x4 v0 = acc[ai][bj][m][0], v1 = acc[ai][bj][m][1];
                    ss += (v0[0] * v0[0] + v0[1] * v0[1]) + (v0[2] * v0[2] + v0[3] * v0[3]) + (v1[0] * v1[0] + v1[1] * v1[1]) + (v1[2] * v1[2] + v1[3] * v1[3]);
                    u32x4 w; w.x = cvt_pk_bf16(v0[0], v0[1]); w.y = cvt_pk_bf16(v0[2], v0[3]); w.z = cvt_pk_bf16(v1[0], v1[1]); w.w = cvt_pk_bf16(v1[2], v1[3]);
                    *(u32x4*)(rowp + bj * HALF) = w; }
                ss += __shfl_xor(ss, 16); ss += __shfl_xor(ss, 32);
                if (fq == 0) ssp[(size_t)row * 64 + u.pn * 4 + wc] = ss; }
    }
};

struct PairOrder : StaticOrder {
    __device__ bool next(int i, Unit& u) const { if (!StaticOrder::next(i >> 1, u)) return false; u.kh = i & 1; return true; }
};

struct RevOrder : StaticOrder {
    __device__ bool next(int i, Unit& u) const { if (!StaticOrder::next(i, u)) return false; u.pn = nN - 1 - u.pn; return true; }
};

template <class Epi, class Sched, bool ALIGN_EPI = false, bool SP2 = false>
__device__ __forceinline__ void gemm_phase(PG8_LAS unsigned char* lds, const Gemm g, const Sched& S, const Epi& E) {
    const int tid = threadIdx.x, wid = __builtin_amdgcn_readfirstlane(tid >> 6), lane = tid & 63, wr = wid >> 2, wc = wid & 3, fr = lane & 15, fq = lane >> 4;
    const int K = g.K, nt = g.nt;
    unsigned voffA[2], voffB[2];
#pragma unroll
    for (int i = 0; i < 2; ++i) { int R, C; stage_rc(tid * 16 + i * 8192, R, C); const int Rb = Epi::PERM ? ((R & ~31) + perm32(R & 31)) : R;
        voffA[i] = (unsigned)(R * K + C) * 2u; voffB[i] = (unsigned)(Rb * K + C) * 2u; }
    const size_t kstep = (size_t)(BK * 2);
    const size_t hstep = (size_t)HALF * K * 2;
    const size_t tstep = 2 * hstep;
    const unsigned ldsw = (unsigned)wid * 1024u;
    const int aoff = lds_byte(wr * 64 + fr, fq * 8), boff = lds_byte(wc * 32 + fr, fq * 8);
#define PG8_SA(b, h) (((b) * 2 + (h)) * HTB)
#define PG8_SB(b, h) ((4 + (b) * 2 + (h)) * HTB)
#define PG8_STAGE(bufoff, gbase, voff) do { _Pragma("unroll") for (int _i = 0; _i < 2; ++_i) \
        __builtin_amdgcn_global_load_lds((const unsigned*)((const char*)(gbase) + (voff)[_i]), (PG8_LAS unsigned*)(lds + (bufoff) + ldsw + _i * 8192), 16, 0, 0); } while (0)
#define PG8_LDA(dst, b, h) do { _Pragma("unroll") for (int m = 0; m < 4; ++m) _Pragma("unroll") for (int k = 0; k < 2; ++k) dst[m][k] = *(const PG8_LAS bf16x8*)(lds + PG8_SA(b, h) + aoff + m * 2048 + k * 1024); } while (0)
#define PG8_LDB(dst, b, h) do { _Pragma("unroll") for (int n = 0; n < 2; ++n) _Pragma("unroll") for (int k = 0; k < 2; ++k) dst[n][k] = *(const PG8_LAS bf16x8*)(lds + PG8_SB(b, h) + boff + n * 2048 + k * 1024); } while (0)
#define PG8_MMA(ai, bj, At, Bt) do { __builtin_amdgcn_s_setprio(1); _Pragma("unroll") for (int m = 0; m < 4; ++m) _Pragma("unroll") for (int n = 0; n < 2; ++n) _Pragma("unroll") for (int k = 0; k < 2; ++k) \
        acc[ai][bj][m][n] = __builtin_amdgcn_mfma_f32_16x16x32_bf16(Bt[n][k], At[m][k], acc[ai][bj][m][n], 0, 0, 0); __builtin_amdgcn_s_setprio(0); } while (0)
#define PG8_WAIT_V(n) asm volatile("s_waitcnt vmcnt(" #n ")" ::: "memory")
#define PG8_WAIT_L(n) asm volatile("s_waitcnt lgkmcnt(" #n ")" ::: "memory")
#define PG8_BAR __builtin_amdgcn_s_barrier()
#define PG8_SCHED __builtin_amdgcn_sched_barrier(0)
    Unit cur, nxt; int ui = 0;
    if (!S.next(0, cur)) return;
    f32x4 acc[2][2][4][2];
#pragma unroll
    for (int a = 0; a < 2; ++a)
#pragma unroll
        for (int b = 0; b < 2; ++b)
#pragma unroll
            for (int m = 0; m < 4; ++m)
#pragma unroll
                for (int n = 0; n < 2; ++n) acc[a][b][m][n] = (f32x4){0.f, 0.f, 0.f, 0.f};
    bf16x8 At[4][2], B0[2][2], B1[2][2];
    const char* cA = (const char*)g.A + (size_t)cur.pm * tstep + (size_t)cur.kh * g.khoff; const char* cB = (const char*)g.Bt + (size_t)cur.pn * tstep + (size_t)cur.kh * g.khoff;
    S.a_ready(cur);
    if constexpr (SP2) {
        PG8_STAGE(PG8_SB(0, 0), cB, voffB); PG8_STAGE(PG8_SB(0, 1), cB + hstep, voffB); PG8_STAGE(PG8_SA(0, 0), cA, voffA); PG8_STAGE(PG8_SA(0, 1), cA + hstep, voffA);
        if (wr == 1) PG8_BAR;
        PG8_WAIT_V(2); PG8_BAR;
        PG8_STAGE(PG8_SB(1, 0), cB + kstep, voffB); PG8_STAGE(PG8_SA(1, 0), cA + kstep, voffA); PG8_STAGE(PG8_SB(1, 1), cB + hstep + kstep, voffB);
        PG8_WAIT_V(6); PG8_BAR;
    } else {
        PG8_STAGE(PG8_SB(0, 0), cB, voffB); PG8_STAGE(PG8_SA(0, 0), cA, voffA); PG8_STAGE(PG8_SB(0, 1), cB + hstep, voffB); PG8_STAGE(PG8_SA(0, 1), cA + hstep, voffA);
        if (wr == 1) PG8_BAR;
        PG8_WAIT_V(4); PG8_BAR;
        PG8_STAGE(PG8_SB(1, 0), cB + kstep, voffB); PG8_STAGE(PG8_SA(1, 0), cA + kstep, voffA); PG8_STAGE(PG8_SB(1, 1), cB + hstep + kstep, voffB);
        PG8_WAIT_V(6); PG8_BAR;
    }
    for (;;) {
        const bool has_next = S.next(ui + 1, nxt);
        const char* nA = has_next ? (const char*)g.A + (size_t)nxt.pm * tstep + (size_t)nxt.kh * g.khoff : cA; const char* nB = has_next ? (const char*)g.Bt + (size_t)nxt.pn * tstep + (size_t)nxt.kh * g.khoff : cB;
        for (int t = 0; t < nt; t += 2) {
            const bool last = (t == nt - 2);
            const char* a1 = cA + (size_t)(t + 1) * kstep;
            const char* a2 = last ? nA : cA + (size_t)(t + 2) * kstep; const char* b2 = last ? nB : cB + (size_t)(t + 2) * kstep;
            const char* a3 = a2 + kstep; const char* b3 = b2 + kstep;
            if (last && has_next) S.a_ready(nxt);
            if constexpr (SP2) {
            PG8_LDB(B0, 0, 0); PG8_LDB(B1, 0, 1); PG8_SCHED; PG8_LDA(At, 0, 0); PG8_STAGE(PG8_SA(1, 1), a1 + hstep, voffA);
            PG8_WAIT_V(8); PG8_WAIT_L(0); PG8_BAR; PG8_MMA(0, 0, At, B0); PG8_MMA(0, 1, At, B1); PG8_BAR; PG8_SCHED;
            PG8_LDA(At, 0, 1); PG8_STAGE(PG8_SB(0, 0), b2, voffB); PG8_STAGE(PG8_SB(0, 1), b2 + hstep, voffB); PG8_STAGE(PG8_SA(0, 0), a2, voffA);
            PG8_WAIT_V(8); PG8_WAIT_L(0); PG8_BAR; PG8_MMA(1, 0, At, B0); PG8_MMA(1, 1, At, B1); PG8_BAR; PG8_SCHED;
            PG8_LDB(B0, 1, 0); PG8_LDB(B1, 1, 1); PG8_SCHED; PG8_LDA(At, 1, 0); PG8_STAGE(PG8_SA(0, 1), a2 + hstep, voffA);
            PG8_WAIT_V(8); PG8_WAIT_L(0); PG8_BAR; PG8_MMA(0, 0, At, B0); PG8_MMA(0, 1, At, B1); PG8_BAR; PG8_SCHED;
            PG8_LDA(At, 1, 1); PG8_STAGE(PG8_SB(1, 0), b3, voffB); PG8_STAGE(PG8_SB(1, 1), b3 + hstep, voffB); PG8_STAGE(PG8_SA(1, 0), a3, voffA);
            PG8_WAIT_V(8); PG8_WAIT_L(0); PG8_BAR; PG8_MMA(1, 0, At, B0); PG8_MMA(1, 1, At, B1); PG8_BAR; PG8_SCHED;
            } else {
            PG8_LDB(B0, 0, 0); PG8_SCHED; PG8_LDA(At, 0, 0); PG8_STAGE(PG8_SA(1, 1), a1 + hstep, voffA);
            PG8_WAIT_L(8); PG8_BAR; PG8_WAIT_L(0); PG8_MMA(0, 0, At, B0); PG8_BAR; PG8_SCHED;
            PG8_LDB(B1, 0, 1); PG8_STAGE(PG8_SB(0, 0), b2, voffB);
            PG8_BAR; PG8_WAIT_L(0); PG8_MMA(0, 1, At, B1); PG8_BAR;
            PG8_LDA(At, 0, 1); PG8_STAGE(PG8_SA(0, 0), a2, voffA);
            PG8_BAR; PG8_WAIT_L(0); PG8_MMA(1, 0, At, B0); PG8_BAR; PG8_SCHED;
            PG8_STAGE(PG8_SB(0, 1), b2 + hstep, voffB);
            PG8_WAIT_V(6); PG8_BAR; PG8_MMA(1, 1, At, B1); PG8_BAR;
            PG8_LDB(B0, 1, 0); PG8_SCHED; PG8_LDA(At, 1, 0); PG8_STAGE(PG8_SA(0, 1), a2 + hstep, voffA);
            PG8_WAIT_L(8); PG8_BAR; PG8_WAIT_L(0); PG8_MMA(0, 0, At, B0); PG8_BAR; PG8_SCHED;
            PG8_LDB(B1, 1, 1); PG8_STAGE(PG8_SB(1, 0), b3, voffB);
            PG8_BAR; PG8_WAIT_L(0); PG8_MMA(0, 1, At, B1); PG8_BAR;
            PG8_LDA(At, 1, 1); PG8_STAGE(PG8_SA(1, 0), a3, voffA);
            PG8_BAR; PG8_WAIT_L(0); PG8_MMA(1, 0, At, B0); PG8_BAR; PG8_SCHED;
            PG8_STAGE(PG8_SB(1, 1), b3 + hstep, voffB);
            PG8_WAIT_V(6); PG8_BAR; PG8_MMA(1, 1, At, B1); PG8_BAR;
            }
        }
        if constexpr (ALIGN_EPI) { if (wr == 0) PG8_BAR; }
        if constexpr (!Epi::AFTER_DRAIN) { E(acc, cur, wr, wc, fr, fq); S.done(cur); }
        if (!has_next) break;
        if (!(Epi::CARRY && cur.kh == 0)) {
#pragma unroll
        for (int a = 0; a < 2; ++a)
#pragma unroll
            for (int b = 0; b < 2; ++b)
#pragma unroll
                for (int m = 0; m < 4; ++m)
#pragma unroll
                    for (int n = 0; n < 2; ++n) acc[a][b][m][n] = (f32x4){0.f, 0.f, 0.f, 0.f};
        }
        cur = nxt; cA = nA; cB = nB; ++ui;
        if constexpr (ALIGN_EPI) { if (wr == 1) PG8_BAR; }
    }
    PG8_WAIT_V(0);
    if constexpr (!ALIGN_EPI) { if (wr == 0) PG8_BAR; }
    PG8_BAR;
    if constexpr (Epi::AFTER_DRAIN) { E.fused(acc, cur, wr, wc, fr, fq, lds, wid, lane); S.done(cur); }
#undef PG8_SA
#undef PG8_SB
#undef PG8_STAGE
#undef PG8_LDA
#undef PG8_LDB
#undef PG8_MMA
#undef PG8_WAIT_V
#undef PG8_WAIT_L
#undef PG8_BAR
#undef PG8_SCHED
}
}

using pg8::bf16_t; using pg8::bf16x8; using pg8::f32x4; using pg8::u32x4; using pg8::f32x2; using pg8::cvt_pk_bf16; using pg8::bf2f; using pg8::f_lo; using pg8::f_hi;
typedef unsigned u32x2 __attribute__((ext_vector_type(2)));
#define LDS_WAIT() asm volatile("s_waitcnt lgkmcnt(0)" ::: "memory")
#define MFMA16(X, Y, C) __builtin_amdgcn_mfma_f32_16x16x32_bf16((X), (Y), (C), 0, 0, 0)

struct Params {
    const float *xp, *xs, *st0, *lbl, *gpre, *win, *lng, *lnb, *wsp, *bsp, *gon, *wpa, *wpb, *wo, *gpost;
    float* out; unsigned char* ws; int lo, hi;
};

__device__ __forceinline__ float wave_sum(float v) {
#pragma unroll
    for (int o = 1; o < 64; o <<= 1) v += __shfl_xor(v, o);
    return v;
}

__device__ __forceinline__ void p0_transpose_item(const float* W, int N, bf16_t* WT, int ldd, int koff, LAS float* scr, int kb, int nb, int lane) {
    const int k0 = 64 * kb, n0 = 32 * nb;
#pragma unroll 8
    for (int i = 0; i < 32; ++i) { const int kk = 2 * i + (lane >> 5); scr[kk * 33 + (lane & 31)] = W[(size_t)(k0 + kk) * N + n0 + (lane & 31)]; }
    LDS_WAIT(); asm volatile("" ::: "memory");
    const int c = lane & 7;
#pragma unroll
    for (int j = 0; j < 4; ++j) { const int n = (lane >> 3) + 8 * j; const LAS float* s = scr + (8 * c) * 33 + n;
        u32x4 o; o.x = cvt_pk_bf16(s[0 * 33], s[1 * 33]); o.y = cvt_pk_bf16(s[2 * 33], s[3 * 33]); o.z = cvt_pk_bf16(s[4 * 33], s[5 * 33]); o.w = cvt_pk_bf16(s[6 * 33], s[7 * 33]);
        *(u32x4*)(WT + (size_t)(n0 + n) * ldd + koff + k0 + 8 * c) = o; }
    LDS_WAIT(); asm volatile("" ::: "memory");
}

__device__ __forceinline__ void phase0(const Params& p, LAS unsigned char* lds) {
    const int tid = threadIdx.x, lane = tid & 63, wid = tid >> 6;
    const int gw = blockIdx.x * 8 + wid, NGW = gridDim.x * 8;
    unsigned char* ws = p.ws;
    bf16_t* WTIN = (bf16_t*)(ws + WS_WTIN); bf16_t* WTAB = (bf16_t*)(ws + WS_WTAB); bf16_t* WTO = (bf16_t*)(ws + WS_WTO);
    bf16_t* XN = (bf16_t*)(ws + WS_XN); bf16_t* YAB = (bf16_t*)(ws + WS_YAB); bf16_t* WSM = (bf16_t*)(ws + WS_WSM);
    LAS float* scr = (LAS float*)(lds + wid * 8448);
    constexpr int I_IN = 64 * 704, I_PA = 32 * 128, I_O = 64 * 128, NIT = I_IN + 2 * I_PA + I_O;
    for (int it = gw; it < NIT; it += NGW) {
        int r = it;
        if (r < I_IN) { p0_transpose_item(p.win, NC, WTIN, DM, 0, scr, r / 704, r % 704, lane); continue; } r -= I_IN;
        if (r < I_PA) { p0_transpose_item(p.wpa, DM, WTAB, DM, 0, scr, r / 128, r % 128, lane); continue; } r -= I_PA;
        if (r < I_PA) { p0_transpose_item(p.wpb, DM, WTAB, DM, 2048, scr, r / 128, r % 128, lane); continue; } r -= I_PA;
        p0_transpose_item(p.wo, DM, WTO, DM, 0, scr, r / 128, r % 128, lane);
    }
    for (int m = gw; m < MP; m += NGW) {
        u32x2* o8 = (u32x2*)(XN + (size_t)m * DM) + lane;
        if (m < MT) {
            const float* xr = (m < TP) ? p.xp + (size_t)m * DM : p.xs + (size_t)(m - TP) * DM;
            const f32x4* x4 = (const f32x4*)xr + lane; const f32x4* g4 = (const f32x4*)p.gpre + lane;
            f32x4 v[16]; float s = 0.f;
#pragma unroll
            for (int j = 0; j < 16; ++j) { v[j] = x4[64 * j]; s += (v[j][0] * v[j][0] + v[j][1] * v[j][1]) + (v[j][2] * v[j][2] + v[j][3] * v[j][3]); }
            const float rs = __builtin_amdgcn_rsqf(wave_sum(s) * (1.0f / DM) + EPS);
#pragma unroll
            for (int j = 0; j < 16; ++j) { const f32x4 g = g4[64 * j]; u32x2 w; w.x = cvt_pk_bf16(v[j][0] * rs * g[0], v[j][1] * rs * g[1]); w.y = cvt_pk_bf16(v[j][2] * rs * g[2], v[j][3] * rs * g[3]); o8[64 * j] = w; }
        } else {
            u32x2* y8 = (u32x2*)(YAB + (size_t)m * DM) + lane; u32x2 z; z.x = 0u; z.y = 0u;
#pragma unroll
            for (int j = 0; j < 16; ++j) { o8[64 * j] = z; y8[64 * j] = z; }
        }
    }
    for (int i = blockIdx.x * 512 + tid; i < 16 * 128 * 128; i += gridDim.x * 512) { const int s = i & 127, t = (i >> 7) & 127; WSM[i] = (s <= t) ? (bf16_t)(cvt_pk_bf16(p.wsp[i], 0.f) & 0xffffu) : (bf16_t)0; }
}

__device__ __forceinline__ void hgrn_prep_item(const Params& p, LAS unsigned char* lds, int item) {
    const int tid = threadIdx.x, lane = tid & 63, w = tid >> 6, fr = lane & 15, fq = lane >> 4;
    const int h = item & 15, n = (item >> 4) & 31, b = item >> 9;
    const int t0 = b * 2048 + n * 64, d = tid & 127, tq = tid >> 7;
    unsigned char* ws = p.ws;
    const bf16_t* H = (const bf16_t*)(ws + WS_H);
    bf16_t* QT0 = (bf16_t*)(ws + WS_QT0); bf16_t* KTT = (bf16_t*)(ws + WS_KTT); bf16_t* ITT = (bf16_t*)(ws + WS_ITT); float* OIN = (float*)(ws + WS_OIN); float* DEC = (float*)(ws + WS_DEC);
    LAS bf16_t* Qm = (LAS bf16_t*)lds;
    LAS bf16_t* Km = Qm + 64 * 136;
    LAS bf16_t* ITs = Km + 64 * 136;
    LAS bf16_t* Att = ITs + 128 * 72;
    LAS float* tot = (LAS float*)(Att + 64 * 72);
    const bf16_t* hp = H + (size_t)(t0 + tq * 16) * NC + COL_Q + h * 128 + d;
    float lf[16], qv[16]; unsigned iv[16];
#pragma unroll
    for (int j = 0; j < 16; ++j) { qv[j] = bf2f(hp[(size_t)j * NC]); lf[j] = bf2f(hp[(size_t)j * NC + (COL_F - COL_Q)]); iv[j] = hp[(size_t)j * NC + (COL_I - COL_Q)]; }
    float run = 0.f, cs[16];
#pragma unroll
    for (int j = 0; j < 16; ++j) { run += lf[j]; cs[j] = run; }
    tot[tq * 128 + d] = run;
    __syncthreads();
    const float t0v = tot[d], t1v = tot[128 + d], t2v = tot[256 + d], t3v = tot[384 + d];
    const float off = (tq > 0 ? t0v : 0.f) + (tq > 1 ? t1v : 0.f) + (tq > 2 ? t2v : 0.f);
    const float bmid = t0v + t1v, blast = (t0v + t1v) + (t2v + t3v);
    unsigned kl[8], ip[8];
#pragma unroll
    for (int j = 0; j < 16; j += 2) {
        float q0[2], klv[2];
#pragma unroll
        for (int jj = 0; jj < 2; ++jj) { const int J = j + jj; const float bj = off + cs[J]; const float f = __expf(lf[J]); const float k = 1.0f - f;
            q0[jj] = qv[J] * __expf(bj); klv[jj] = k * __expf(blast - bj);
            const float qm = qv[J] * __expf(bj - bmid), km = k * __expf(bmid - bj);
            const unsigned pk = cvt_pk_bf16(qm, km);
            Qm[(tq * 16 + J) * 136 + d] = (bf16_t)(pk & 0xffffu); Km[(tq * 16 + J) * 136 + d] = (bf16_t)(pk >> 16);
            QT0[(size_t)(t0 + tq * 16 + J) * EA + h * 128 + d] = (bf16_t)(cvt_pk_bf16(q0[jj], 0.f) & 0xffffu); }
        kl[j >> 1] = cvt_pk_bf16(klv[0], klv[1]); ip[j >> 1] = iv[j] | (iv[j + 1] << 16);
    }
    { u32x4 a, c2; a.x = kl[0]; a.y = kl[1]; a.z = kl[2]; a.w = kl[3]; c2.x = kl[4]; c2.y = kl[5]; c2.z = kl[6]; c2.w = kl[7];
      u32x4* kp = (u32x4*)(KTT + ((size_t)item * 128 + d) * 64 + tq * 16); kp[0] = a; kp[1] = c2;
      u32x4 e, f2; e.x = ip[0]; e.y = ip[1]; e.z = ip[2]; e.w = ip[3]; f2.x = ip[4]; f2.y = ip[5]; f2.z = ip[6]; f2.w = ip[7];
      u32x4* ipp = (u32x4*)(ITT + ((size_t)item * 128 + d) * 64 + tq * 16); ipp[0] = e; ipp[1] = f2;
      LAS u32x4* il = (LAS u32x4*)(ITs + d * 72 + tq * 16); il[0] = e; il[1] = f2; }
    if (tq == 0) DEC[(size_t)item * 128 + d] = __expf(blast);
    __syncthreads();
    {
        const int tb = w >> 1;
#pragma unroll
        for (int x = 0; x < 2; ++x) { const int sb = (w & 1) * 2 + x; f32x4 acc = {0.f, 0.f, 0.f, 0.f};
            if (sb <= tb) {
#pragma unroll
                for (int ks = 0; ks < 4; ++ks) { const bf16x8 X = *(const LAS bf16x8*)(Km + (sb * 16 + fr) * 136 + ks * 32 + fq * 8), Y = *(const LAS bf16x8*)(Qm + (tb * 16 + fr) * 136 + ks * 32 + fq * 8); acc = MFMA16(X, Y, acc); }
                const int t = tb * 16 + fr, s0 = sb * 16 + fq * 4;
#pragma unroll
                for (int j = 0; j < 4; ++j) acc[j] = (s0 + j <= t) ? acc[j] : 0.f;
            }
            u32x2 o; o.x = cvt_pk_bf16(acc[0], acc[1]); o.y = cvt_pk_bf16(acc[2], acc[3]);
            *(LAS u32x2*)(Att + (tb * 16 + fr) * 72 + sb * 16 + fq * 4) = o; }
    }
    __syncthreads();
    {
        const int eb = w;
#pragma unroll
        for (int tb = 0; tb < 4; ++tb) { f32x4 acc = {0.f, 0.f, 0.f, 0.f};
#pragma unroll
            for (int ks = 0; ks < 2; ++ks) { if (ks * 32 <= tb * 16 + 15) { const bf16x8 X = *(const LAS bf16x8*)(ITs + (eb * 16 + fr) * 72 + ks * 32 + fq * 8), Y = *(const LAS bf16x8*)(Att + (tb * 16 + fr) * 72 + ks * 32 + fq * 8); acc = MFMA16(X, Y, acc); } }
            *(f32x4*)(OIN + (size_t)(t0 + tb * 16 + fr) * EA + h * 128 + eb * 16 + fq * 4) = acc; }
    }
    __syncthreads();
}

__device__ __forceinline__ void hgrn_scan_item(const Params& p, LAS unsigned char* lds, int bh) {
    const int tid = threadIdx.x, lane = tid & 63, w = tid >> 6, fr = lane & 15, fq = lane >> 4;
    const int b = bh >> 4, h = bh & 15;
    unsigned char* ws = p.ws;
    const bf16_t* H = (const bf16_t*)(ws + WS_H); bf16_t* YAB = (bf16_t*)(ws + WS_YAB);
    const bf16_t* QT0 = (const bf16_t*)(ws + WS_QT0); const bf16_t* KTT = (const bf16_t*)(ws + WS_KTT); const bf16_t* ITT = (const bf16_t*)(ws + WS_ITT);
    const float* OIN = (const float*)(ws + WS_OIN); const float* DEC = (const float*)(ws + WS_DEC);
    LAS bf16_t* ST = (LAS bf16_t*)lds;
    LAS float* ssq = (LAS float*)(lds + 128 * 136 * 2);
    f32x4 S[8];
#pragma unroll
    for (int eb = 0; eb < 8; ++eb) S[eb] = (f32x4){0.f, 0.f, 0.f, 0.f};
    const int tb = w & 3, eh = w >> 2;
    const f32x4 gon[4] = { *(const f32x4*)(p.gon + h * 128 + (eh * 4 + 0) * 16 + fq * 4), *(const f32x4*)(p.gon + h * 128 + (eh * 4 + 1) * 16 + fq * 4),
                           *(const f32x4*)(p.gon + h * 128 + (eh * 4 + 2) * 16 + fq * 4), *(const f32x4*)(p.gon + h * 128 + (eh * 4 + 3) * 16 + fq * 4) };
    for (int n = 0; n < 32; ++n) {
        const int itn = (b * 32 + n) * 16 + h, t = b * 2048 + n * 64 + tb * 16 + fr;
#pragma unroll
        for (int eb = 0; eb < 8; ++eb) { u32x2 o; o.x = cvt_pk_bf16(S[eb][0], S[eb][1]); o.y = cvt_pk_bf16(S[eb][2], S[eb][3]); *(LAS u32x2*)(ST + (eb * 16 + fr) * 136 + w * 16 + fq * 4) = o; }
        __syncthreads();
        bf16x8 Yq[4];
#pragma unroll
        for (int ks = 0; ks < 4; ++ks) Yq[ks] = *(const bf16x8*)(QT0 + (size_t)t * EA + h * 128 + ks * 32 + fq * 8);
        f32x4 o[4]; float ss = 0.f;
#pragma unroll
        for (int el = 0; el < 4; ++el) { f32x4 acc = *(const f32x4*)(OIN + (size_t)t * EA + h * 128 + (eh * 4 + el) * 16 + fq * 4);
#pragma unroll
            for (int ks = 0; ks < 4; ++ks) { const bf16x8 X = *(const LAS bf16x8*)(ST + ((eh * 4 + el) * 16 + fr) * 136 + ks * 32 + fq * 8); acc = MFMA16(X, Yq[ks], acc); }
            o[el] = acc; ss += (acc[0] * acc[0] + acc[1] * acc[1]) + (acc[2] * acc[2] + acc[3] * acc[3]); }
        ss += __shfl_xor(ss, 16); ss += __shfl_xor(ss, 32);
        if (fq == 0) ssq[eh * 64 + tb * 16 + fr] = ss;
        __syncthreads();
        const float rs = __builtin_amdgcn_rsqf((ssq[tb * 16 + fr] + ssq[64 + tb * 16 + fr]) * (1.0f / 128.0f) + EPS);
#pragma unroll
        for (int el = 0; el < 4; ++el) { const int col = h * 128 + (eh * 4 + el) * 16 + fq * 4; const u32x2 zb = *(const u32x2*)(H + (size_t)t * NC + COL_ZB + col);
            u32x2 y; y.x = cvt_pk_bf16(o[el][0] * rs * gon[el][0] * f_lo(zb.x), o[el][1] * rs * gon[el][1] * f_hi(zb.x)); y.y = cvt_pk_bf16(o[el][2] * rs * gon[el][2] * f_lo(zb.y), o[el][3] * rs * gon[el][3] * f_hi(zb.y));
            *(u32x2*)(YAB + (size_t)t * DM + 2048 + col) = y; }
        const f32x4 dec = *(const f32x4*)(DEC + (size_t)itn * 128 + w * 16 + fq * 4);
        const bf16x8 Xk0 = *(const bf16x8*)(KTT + ((size_t)itn * 128 + w * 16 + fr) * 64 + fq * 8), Xk1 = *(const bf16x8*)(KTT + ((size_t)itn * 128 + w * 16 + fr) * 64 + 32 + fq * 8);
#pragma unroll
        for (int eb = 0; eb < 8; ++eb) { const bf16_t* ip = ITT + ((size_t)itn * 128 + eb * 16 + fr) * 64 + fq * 8; const bf16x8 Y0 = *(const bf16x8*)ip, Y1 = *(const bf16x8*)(ip + 32);
            f32x4 a = S[eb] * dec; a = MFMA16(Xk0, Y0, a); a = MFMA16(Xk1, Y1, a); S[eb] = a; }
    }
    float* sp = p.out + O_SP + (size_t)bh * 128 * 128;
#pragma unroll
    for (int eb = 0; eb < 8; ++eb)
#pragma unroll
        for (int j = 0; j < 4; ++j) sp[(size_t)(w * 16 + fq * 4 + j) * 128 + eb * 16 + fr] = S[eb][j];
    __syncthreads();
}

__device__ __forceinline__ void hgrn_state_item(const Params& p, int it) {
    const int tid = threadIdx.x, lane = tid & 63, w = tid >> 6, fr = lane & 15, fq = lane >> 4;
    const int bh = it >> 1, eh = it & 1, b = bh >> 4, h = bh & 15;
    unsigned char* ws = p.ws;
    const bf16_t* KTT = (const bf16_t*)(ws + WS_KTT); const bf16_t* ITT = (const bf16_t*)(ws + WS_ITT); const float* DEC = (const float*)(ws + WS_DEC);
    bf16_t* SN = (bf16_t*)(ws + WS_SN);
    f32x4 S[4];
#pragma unroll
    for (int eb = 0; eb < 4; ++eb) S[eb] = (f32x4){0.f, 0.f, 0.f, 0.f};
    bf16x8 Xk0, Xk1, Y0[4], Y1[4]; f32x4 dec;
    {   const size_t itn = (size_t)(b * 32) * 16 + h;
        dec = *(const f32x4*)(DEC + itn * 128 + w * 16 + fq * 4);
        Xk0 = *(const bf16x8*)(KTT + (itn * 128 + w * 16 + fr) * 64 + fq * 8); Xk1 = *(const bf16x8*)(KTT + (itn * 128 + w * 16 + fr) * 64 + 32 + fq * 8);
#pragma unroll
        for (int eb = 0; eb < 4; ++eb) { const bf16_t* ip = ITT + (itn * 128 + (eh * 4 + eb) * 16 + fr) * 64 + fq * 8; Y0[eb] = *(const bf16x8*)ip; Y1[eb] = *(const bf16x8*)(ip + 32); } }
    for (int n = 0; n < 32; ++n) {
        const size_t itn = (size_t)(b * 32 + n) * 16 + h;
        const int nn = (n < 31) ? n + 1 : 31; const size_t itx = (size_t)(b * 32 + nn) * 16 + h;
        const f32x4 ndec = *(const f32x4*)(DEC + itx * 128 + w * 16 + fq * 4);
        const bf16x8 nXk0 = *(const bf16x8*)(KTT + (itx * 128 + w * 16 + fr) * 64 + fq * 8), nXk1 = *(const bf16x8*)(KTT + (itx * 128 + w * 16 + fr) * 64 + 32 + fq * 8);
        bf16x8 nY0[4], nY1[4];
#pragma unroll
        for (int eb = 0; eb < 4; ++eb) { const bf16_t* ip = ITT + (itx * 128 + (eh * 4 + eb) * 16 + fr) * 64 + fq * 8; nY0[eb] = *(const bf16x8*)ip; nY1[eb] = *(const bf16x8*)(ip + 32); }
#pragma unroll
        for (int eb = 0; eb < 4; ++eb) { u32x2 o; o.x = cvt_pk_bf16(S[eb][0], S[eb][1]); o.y = cvt_pk_bf16(S[eb][2], S[eb][3]); *(u32x2*)(SN + (itn * 128 + (eh * 4 + eb) * 16 + fr) * 128 + w * 16 + fq * 4) = o; }
#pragma unroll
        for (int eb = 0; eb < 4; ++eb) { f32x4 a = S[eb] * dec; a = MFMA16(Xk0, Y0[eb], a); a = MFMA16(Xk1, Y1[eb], a); S[eb] = a; }
        dec = ndec; Xk0 = nXk0; Xk1 = nXk1;
#pragma unroll
        for (int eb = 0; eb < 4; ++eb) { Y0[eb] = nY0[eb]; Y1[eb] = nY1[eb]; }
    }
    float* sp = p.out + O_SP + (size_t)bh * 128 * 128;
#pragma unroll
    for (int eb = 0; eb < 4; ++eb)
#pragma unroll
        for (int j = 0; j < 4; ++j) sp[(size_t)(w * 16 + fq * 4 + j) * 128 + (eh * 4 + eb) * 16 + fr] = S[eb][j];
}

__device__ __forceinline__ void hgrn_out_waveitem(const Params& p, int wi) {
    const int lane = threadIdx.x & 63, fr = lane & 15, fq = lane >> 4;
    const int tb = wi & 3, item = wi >> 2, h = item & 15, n = (item >> 4) & 31, b = item >> 9;
    unsigned char* ws = p.ws;
    const bf16_t* H = (const bf16_t*)(ws + WS_H); bf16_t* YAB = (bf16_t*)(ws + WS_YAB);
    const bf16_t* QT0 = (const bf16_t*)(ws + WS_QT0); const float* OIN = (const float*)(ws + WS_OIN); const bf16_t* SN = (const bf16_t*)(ws + WS_SN);
    const int t = b * 2048 + n * 64 + tb * 16 + fr;
    bf16x8 Yq[4];
#pragma unroll
    for (int ks = 0; ks < 4; ++ks) Yq[ks] = *(const bf16x8*)(QT0 + (size_t)t * EA + h * 128 + ks * 32 + fq * 8);
    f32x4 o[8]; float ss = 0.f;
#pragma unroll
    for (int eb = 0; eb < 8; ++eb) { f32x4 acc = *(const f32x4*)(OIN + (size_t)t * EA + h * 128 + eb * 16 + fq * 4);
        if (n > 0) {
#pragma unroll
            for (int ks = 0; ks < 4; ++ks) { const bf16x8 X = *(const bf16x8*)(SN + ((size_t)item * 128 + eb * 16 + fr) * 128 + ks * 32 + fq * 8); acc = MFMA16(X, Yq[ks], acc); } }
        o[eb] = acc; ss += (acc[0] * acc[0] + acc[1] * acc[1]) + (acc[2] * acc[2] + acc[3] * acc[3]); }
    ss += __shfl_xor(ss, 16); ss += __shfl_xor(ss, 32);
    const float rs = __builtin_amdgcn_rsqf(ss * (1.0f / 128.0f) + EPS);
#pragma unroll
    for (int eb = 0; eb < 8; ++eb) { const int col = h * 128 + eb * 16 + fq * 4; const u32x2 zb = *(const u32x2*)(H + (size_t)t * NC + COL_ZB + col); const f32x4 g = *(const f32x4*)(p.gon + col);
        u32x2 y; y.x = cvt_pk_bf16(o[eb][0] * rs * g[0] * f_lo(zb.x), o[eb][1] * rs * g[1] * f_hi(zb.x)); y.y = cvt_pk_bf16(o[eb][2] * rs * g[2] * f_lo(zb.y), o[eb][3] * rs * g[3] * f_hi(zb.y));
        *(u32x2*)(YAB + (size_t)t * DM + 2048 + col) = y; }
}

__device__ __forceinline__ void amix_item(const Params& p, LAS unsigned char* lds, int item) {
    const int tid = threadIdx.x, lane = tid & 63, w = tid >> 6, fr = lane & 15, fq = lane >> 4;
    const int g = item & 15, n = (item >> 4) & 15, b = item >> 8, t0 = b * 2048 + n * 128;
    unsigned char* ws = p.ws;
    const bf16_t* H = (const bf16_t*)(ws + WS_H); bf16_t* YAB = (bf16_t*)(ws + WS_YAB); const bf16_t* WSM = (const bf16_t*)(ws + WS_WSM); const float* LNP = (const float*)(ws + WS_LNP);
    LAS bf16_t* VT = (LAS bf16_t*)lds;
    LAS float* stats = (LAS float*)(lds + 128 * 136 * 2);
    if (tid < 128) { const f32x4* lp = (const f32x4*)(LNP + (size_t)(t0 + tid) * 64); float s1 = 0.f, s2 = 0.f;
#pragma unroll
        for (int i = 0; i < 16; ++i) { const f32x4 v = lp[i]; s1 += v[0] + v[2]; s2 += v[1] + v[3]; }
        const float mean = s1 * (1.0f / 2048.0f), var = s2 * (1.0f / 2048.0f) - mean * mean;
        stats[tid * 2] = mean; stats[tid * 2 + 1] = __builtin_amdgcn_rsqf(var + EPS); }
    __syncthreads();
#pragma unroll
    for (int i = 0; i < 4; ++i) { const int id = tid + 512 * i, r = id & 127, cc = id >> 7;
        const u32x4 v = *(const u32x4*)(H + (size_t)(t0 + r) * NC + COL_V + g * 128 + cc * 8);
        const float mean = stats[r * 2], rstd = stats[r * 2 + 1];
        const f32x4 g0 = *(const f32x4*)(p.lng + g * 128 + cc * 8), g1 = *(const f32x4*)(p.lng + g * 128 + cc * 8 + 4), b0 = *(const f32x4*)(p.lnb + g * 128 + cc * 8), b1 = *(const f32x4*)(p.lnb + g * 128 + cc * 8 + 4);
        float vn[8];
        vn[0] = (f_lo(v.x) - mean) * rstd * g0[0] + b0[0]; vn[1] = (f_hi(v.x) - mean) * rstd * g0[1] + b0[1]; vn[2] = (f_lo(v.y) - mean) * rstd * g0[2] + b0[2]; vn[3] = (f_hi(v.y) - mean) * rstd * g0[3] + b0[3];
        vn[4] = (f_lo(v.z) - mean) * rstd * g1[0] + b1[0]; vn[5] = (f_hi(v.z) - mean) * rstd * g1[1] + b1[1]; vn[6] = (f_lo(v.w) - mean) * rstd * g1[2] + b1[2]; vn[7] = (f_hi(v.w) - mean) * rstd * g1[3] + b1[3];
        if (n == 15) { float* vp = p.out + O_VP + ((size_t)(b * 128 + r)) * EA + g * 128 + cc * 8; *(f32x4*)vp = (f32x4){vn[0], vn[1], vn[2], vn[3]}; *(f32x4*)(vp + 4) = (f32x4){vn[4], vn[5], vn[6], vn[7]}; }
#pragma unroll
        for (int k = 0; k < 8; k += 2) { const unsigned pk = cvt_pk_bf16(vn[k], vn[k + 1]); VT[(cc * 8 + k) * 136 + r] = (bf16_t)(pk & 0xffffu); VT[(cc * 8 + k + 1) * 136 + r] = (bf16_t)(pk >> 16); }
    }
    __syncthreads();
    {
        const int tb = w, nks = (tb >> 1) + 1, t = t0 + tb * 16 + fr;
        bf16x8 Yw[4];
#pragma unroll
        for (int ks = 0; ks < 4; ++ks) { if (ks < nks) Yw[ks] = *(const bf16x8*)(WSM + ((size_t)(g * 128 + tb * 16 + fr)) * 128 + ks * 32 + fq * 8); else Yw[ks] = (bf16x8){0, 0, 0, 0, 0, 0, 0, 0}; }
        const float bs = p.bsp[g * 128 + tb * 16 + fr];
#pragma unroll
        for (int cb = 0; cb < 8; ++cb) { f32x4 acc = {0.f, 0.f, 0.f, 0.f};
#pragma unroll
            for (int ks = 0; ks < 4; ++ks) { if (ks < nks) { const bf16x8 X = *(const LAS bf16x8*)(VT + (cb * 16 + fr) * 136 + ks * 32 + fq * 8); acc = MFMA16(X, Yw[ks], acc); } }
            const int col = g * 128 + cb * 16 + fq * 4;
            const u32x2 u = *(const u32x2*)(H + (size_t)t * NC + COL_U + col), za = *(const u32x2*)(H + (size_t)t * NC + COL_ZA + col);
            u32x2 y; y.x = cvt_pk_bf16(f_lo(u.x) * (acc[0] + bs) * f_lo(za.x), f_hi(u.x) * (acc[1] + bs) * f_hi(za.x)); y.y = cvt_pk_bf16(f_lo(u.y) * (acc[2] + bs) * f_lo(za.y), f_hi(u.y) * (acc[3] + bs) * f_hi(za.y));
            *(u32x2*)(YAB + (size_t)t * DM + col) = y; }
    }
    __syncthreads();
}

__device__ __forceinline__ void hgrn_sample_item(const Params& p, LAS unsigned char* lds, int item) {
    const int tid = threadIdx.x, lane = tid & 63, w = tid >> 6;
    const int bs = item >> 4, h = item & 15, row = TP + bs, e4 = tid & 31, dg = tid >> 5;
    unsigned char* ws = p.ws;
    const bf16_t* H = (const bf16_t*)(ws + WS_H); bf16_t* YAB = (bf16_t*)(ws + WS_YAB);
    LAS float* red = (LAS float*)lds;
    LAS float* ssw = red + 16 * 128;
    const bf16_t* hr = H + (size_t)row * NC + h * 128;
    const u32x2 ii = *(const u32x2*)(hr + COL_I + e4 * 4);
    const f32x4 i4 = {f_lo(ii.x), f_hi(ii.x), f_lo(ii.y), f_hi(ii.y)};
    const u32x4 q8 = *(const u32x4*)(hr + COL_Q + dg * 8), l8 = *(const u32x4*)(hr + COL_F + dg * 8);
    const float qv[8] = {f_lo(q8.x), f_hi(q8.x), f_lo(q8.y), f_hi(q8.y), f_lo(q8.z), f_hi(q8.z), f_lo(q8.w), f_hi(q8.w)};
    const float lv[8] = {f_lo(l8.x), f_hi(l8.x), f_lo(l8.y), f_hi(l8.y), f_lo(l8.z), f_hi(l8.z), f_lo(l8.w), f_hi(l8.w)};
    const size_t sbase = ((size_t)item * 128 + dg * 8) * 128 + e4 * 4;
    const f32x4* s0 = (const f32x4*)(p.st0 + sbase); f32x4* s1 = (f32x4*)(p.out + O_SS + sbase);
    f32x4 po = {0.f, 0.f, 0.f, 0.f};
#pragma unroll
    for (int j = 0; j < 8; ++j) { const float f = __expf(lv[j]), k = 1.0f - f; const f32x4 sn = s0[j * 32] * f + i4 * k; s1[j * 32] = sn; po += sn * qv[j]; }
    *(LAS f32x4*)(red + dg * 128 + e4 * 4) = po;
    __syncthreads();
    float o = 0.f;
    if (tid < 128) {
#pragma unroll
        for (int k = 0; k < 16; ++k) o += red[k * 128 + tid];
        const float s = wave_sum(o * o);
        if (lane == 0) ssw[w] = s;
    }
    __syncthreads();
    if (tid < 128) { const float rs = __builtin_amdgcn_rsqf((ssw[0] + ssw[1]) * (1.0f / 128.0f) + EPS);
        const float y = o * rs * p.gon[h * 128 + tid] * bf2f(hr[COL_ZB + tid]);
        YAB[(size_t)row * DM + 2048 + h * 128 + tid] = (bf16_t)(cvt_pk_bf16(y, 0.f) & 0xffffu); }
    __syncthreads();
}

__device__ __forceinline__ void amix_sample_item(const Params& p, int bs) {
    const int tid = threadIdx.x, row = TP + bs, c0 = tid * 4, g = c0 >> 7;
    unsigned char* ws = p.ws;
    const bf16_t* H = (const bf16_t*)(ws + WS_H); bf16_t* YAB = (bf16_t*)(ws + WS_YAB); const float* LNP = (const float*)(ws + WS_LNP);
    const f32x4* lp = (const f32x4*)(LNP + (size_t)row * 64); float s1 = 0.f, s2 = 0.f;
#pragma unroll
    for (int i = 0; i < 16; ++i) { const f32x4 v = lp[i]; s1 += v[0] + v[2]; s2 += v[1] + v[3]; }
    const float mean = s1 * (1.0f / 2048.0f), rstd = __builtin_amdgcn_rsqf(s2 * (1.0f / 2048.0f) - mean * mean + EPS);
    const bf16_t* hr = H + (size_t)row * NC + c0;
    const u32x2 v = *(const u32x2*)(hr + COL_V), u = *(const u32x2*)(hr + COL_U), za = *(const u32x2*)(hr + COL_ZA);
    const f32x4 lg = *(const f32x4*)(p.lng + c0), lb = *(const f32x4*)(p.lnb + c0);
    f32x4 vn; vn[0] = (f_lo(v.x) - mean) * rstd * lg[0] + lb[0]; vn[1] = (f_hi(v.x) - mean) * rstd * lg[1] + lb[1]; vn[2] = (f_lo(v.y) - mean) * rstd * lg[2] + lb[2]; vn[3] = (f_hi(v.y) - mean) * rstd * lg[3] + lb[3];
    *(f32x4*)(p.out + O_VS + (size_t)bs * EA + c0) = vn;
    const float w00 = p.wsp[(size_t)g * 128 * 128], b0 = p.bsp[g * 128];
    u32x2 y; y.x = cvt_pk_bf16(f_lo(u.x) * (w00 * vn[0] + b0) * f_lo(za.x), f_hi(u.x) * (w00 * vn[1] + b0) * f_hi(za.x)); y.y = cvt_pk_bf16(f_lo(u.y) * (w00 * vn[2] + b0) * f_lo(za.y), f_hi(u.y) * (w00 * vn[3] + b0) * f_hi(za.y));
    *(u32x2*)(YAB + (size_t)row * DM + c0) = y;
}

__device__ __forceinline__ void phase_final(const Params& p) {
    const int tid = threadIdx.x, lane = tid & 63, wid = tid >> 6;
    const int gw = blockIdx.x * 8 + wid, NGW = gridDim.x * 8;
    const bf16_t* Z = (const bf16_t*)(p.ws + WS_Z); const float* SSP = (const float*)(p.ws + WS_SSP);
    for (int m = gw; m < MT; m += NGW) {
        const float rs = __builtin_amdgcn_rsqf(wave_sum(SSP[(size_t)m * 64 + lane]) * (1.0f / DM) + EPS);
        const float* xr = (m < TP) ? p.xp + (size_t)m * DM : p.xs + (size_t)(m - TP) * DM;
        float* yr = p.out + (size_t)m * DM;
        const f32x4* x4 = (const f32x4*)xr + lane; const f32x4* g4 = (const f32x4*)p.gpost + lane; const u32x2* z8 = (const u32x2*)(Z + (size_t)m * DM) + lane; f32x4* y4 = (f32x4*)yr + lane;
#pragma unroll
        for (int j = 0; j < 16; ++j) { const f32x4 x = x4[64 * j], g = g4[64 * j]; const u32x2 z = z8[64 * j];
            f32x4 y; y[0] = x[0] + f_lo(z.x) * rs * g[0]; y[1] = x[1] + f_hi(z.x) * rs * g[1]; y[2] = x[2] + f_lo(z.y) * rs * g[2]; y[3] = x[3] + f_hi(z.y) * rs * g[3]; y4[64 * j] = y; }
    }
}

constexpr int NPH = 8;
__global__ void __launch_bounds__(512, 2) mega(Params p) {
    extern __shared__ __attribute__((aligned(16))) unsigned char lds_raw[];
    LAS unsigned char* lds = (LAS unsigned char*)lds_raw;
    cg::grid_group grid = cg::this_grid();
    const int lo = p.lo, hi = p.hi, G = gridDim.x, bid = blockIdx.x;
    unsigned char* ws = p.ws;
    if (threadIdx.x < 64) ((LAS unsigned*)(lds + LDS_STAGE))[threadIdx.x] = 0u;
    __syncthreads();
    XcdBarrier bar = xcd_barrier_post((unsigned*)(ws + 16384), (volatile LAS unsigned*)(lds + LDS_STAGE));
    if (hi - lo > 1) grid.sync();
#define IN(k) (lo <= (k) && (k) < hi)
#define GSYNC() xcd_barrier(bar)
#define SEAM(k) do { if (IN(k) && IN((k) + 1)) GSYNC(); } while (0)
#define REPS(k) (1 + ((MK_REP >> (k)) & 1))
    for (int rep = 0; rep < REPS(0); ++rep) { if (rep) GSYNC(); if (IN(0)) phase0(p, lds); }
    SEAM(0);
    for (int rep = 0; rep < REPS(1); ++rep) { if (rep) GSYNC();
        if (IN(1)) {
            pg8::Gemm g{(const bf16_t*)(ws + WS_XN), (const bf16_t*)(ws + WS_WTIN), MP, NC, DM, DM / 64, 0}; pg8::StaticOrder S; S.init(MP, NC, G, bid);
            pg8::EpiAct E{(bf16_t*)(ws + WS_H), p.lbl, (float*)(ws + WS_LNP)};
            pg8::gemm_phase<pg8::EpiAct, pg8::StaticOrder, true, true>(lds, g, S, E);
        } }
    SEAM(1);
    for (int rep = 0; rep < REPS(2); ++rep) { if (rep) GSYNC(); if (IN(2)) { for (int it = bid; it < 2048; it += G) hgrn_prep_item(p, lds, it); } }
    SEAM(2);
    for (int rep = 0; rep < REPS(3); ++rep) { if (rep) GSYNC();
        if (IN(3)) {
            constexpr int T_SC = 128, T_AM = 512, T_HS = 256, T_AS = 8, T_TOT = T_SC + T_AM + T_HS + T_AS;
            unsigned* ctr = (unsigned*)ws + 64 * (1 + rep); LAS int* slot = (LAS int*)(lds + LDS_STAGE + 64);
            int it = bid;
            while (it < T_TOT) {
                int nxt = 0; if (threadIdx.x == 0) nxt = G + (int)atomicAdd(ctr, 1u);
                if (it < T_SC) { for (int r2 = 0; r2 < 1 + (MK_SUB & 1); ++r2) hgrn_state_item(p, it); }
                else if (it < T_SC + T_AM) { for (int k = 0; k < 2; ++k) amix_item(p, lds, (it - T_SC) * 2 + k); }
                else if (it < T_SC + T_AM + T_HS) { for (int k = 0; k < 8; ++k) hgrn_sample_item(p, lds, (it - T_SC - T_AM) * 8 + k); }
                else { for (int k = 0; k < 16; ++k) amix_sample_item(p, (it - T_SC - T_AM - T_HS) * 16 + k); }
                if (threadIdx.x == 0) *slot = nxt;
                __syncthreads(); it = *slot; __syncthreads();
            }
        } }
    SEAM(3);
    for (int rep = 0; rep < REPS(4); ++rep) { if (IN(4)) { for (int wi = bid * 8 + (int)(threadIdx.x >> 6); wi < 8192; wi += G * 8) hgrn_out_waveitem(p, wi); } }
    SEAM(4);
    for (int rep = 0; rep < REPS(5); ++rep) { if (rep) GSYNC();
        if (IN(5)) {
            pg8::Gemm g{(const bf16_t*)(ws + WS_YAB), (const bf16_t*)(ws + WS_WTAB), MP, DM, DM, 32, (size_t)2048 * 2}; pg8::PairOrder S; S.init(MP, DM, G, bid);
            pg8::EpiMerge E{(const bf16_t*)(ws + WS_H), (bf16_t*)(ws + WS_MRG)};
            pg8::gemm_phase<pg8::EpiMerge, pg8::PairOrder, true, true>(lds, g, S, E);
        } }
    SEAM(5);
    for (int rep = 0; rep < REPS(6); ++rep) { if (rep) GSYNC();
        if (IN(6)) {
            pg8::Gemm g{(const bf16_t*)(ws + WS_MRG), (const bf16_t*)(ws + WS_WTO), MP, DM, DM, DM / 64, 0}; pg8::StaticOrder S; S.init(MP, DM, G, bid);
            pg8::EpiZ E{(bf16_t*)(ws + WS_Z), (float*)(ws + WS_SSP)};
            pg8::gemm_phase<pg8::EpiZ, pg8::StaticOrder, true, true>(lds, g, S, E);
        } }
    SEAM(6);
    for (int rep = 0; rep < REPS(7); ++rep) { if (IN(7)) phase_final(p); }
    for (int x = 0; x < MK_XSYNC; ++x) GSYNC();
#undef IN
#undef SEAM
#undef GSYNC
#undef REPS
}

extern "C" void kernel_launch(void* const* d_in, const int* in_sizes, int n_in, void* d_out, int out_size, void* d_ws, size_t ws_size, hipStream_t stream) {
    static int grid = 0;
    if (grid == 0) {
        if (n_in != 15 || (size_t)out_size != O_END || ws_size < WS_END) { fprintf(stderr, "kernel_launch: unexpected shapes: n_in %d out %d ws %zu (need %zu)\n", n_in, out_size, ws_size, (size_t)WS_END); grid = -1; return; }
        int dev = 0, cus = 0, per_cu = 0;
        if (hipGetDevice(&dev) != hipSuccess || hipDeviceGetAttribute(&cus, hipDeviceAttributeMultiprocessorCount, dev) != hipSuccess) { fprintf(stderr, "kernel_launch: device query failed\n"); grid = -1; return; }
        if (hipFuncSetAttribute((const void*)mega, hipFuncAttributeMaxDynamicSharedMemorySize, LDS_BYTES) != hipSuccess) { fprintf(stderr, "kernel_launch: hipFuncSetAttribute failed\n"); grid = -1; return; }
        if (hipOccupancyMaxActiveBlocksPerMultiprocessor(&per_cu, (const void*)mega, 512, LDS_BYTES) != hipSuccess || per_cu < 1) { fprintf(stderr, "kernel_launch: occupancy query says %d\n", per_cu); per_cu = 1; }
        (void)hipGetLastError();
        grid = cus * per_cu;
        fprintf(stderr, "kernel_launch: grid %d (cus %d x %d)\n", grid, cus, per_cu);
    }
    if (grid < 0) return;
    (void)hipMemsetAsync(d_ws, 0, WS_CTLB, stream);
    Params p{};
    p.xp = (const float*)d_in[0]; p.xs = (const float*)d_in[1]; p.st0 = (const float*)d_in[2]; p.lbl = (const float*)d_in[3]; p.gpre = (const float*)d_in[4]; p.win = (const float*)d_in[5];
    p.lng = (const float*)d_in[6]; p.lnb = (const float*)d_in[7]; p.wsp = (const float*)d_in[8]; p.bsp = (const float*)d_in[9]; p.gon = (const float*)d_in[10]; p.wpa = (const float*)d_in[11];
    p.wpb = (const float*)d_in[12]; p.wo = (const float*)d_in[13]; p.gpost = (const float*)d_in[14];
    p.out = (float*)d_out; p.ws = (unsigned char*)d_ws;
#if MK_MULTI
    for (int ph = 0; ph < NPH; ++ph) { p.lo = ph; p.hi = ph + 1; hipLaunchKernelGGL(mega, dim3(grid), dim3(512), LDS_BYTES, stream, p); }
#else
    p.lo = 0; p.hi = NPH;
    void* args[] = {&p};
    hipError_t e = hipLaunchCooperativeKernel((const void*)mega, dim3(grid), dim3(512), args, LDS_BYTES, stream);
    if (e != hipSuccess) fprintf(stderr, "kernel_launch: cooperative launch failed: %s (grid %d)\n", hipGetErrorString(e), grid);
#endif
}
```

```cpp
#include <hip/hip_runtime.h>
#include <hip/hip_cooperative_groups.h>
#include <cstdio>
#include <cstdint>
namespace cg = cooperative_groups;

#ifndef MK_MULTI
#define MK_MULTI 0
#endif

#ifndef G1ORDER
#define G1ORDER StaticOrder
#endif
#ifndef MK_DELAY_US
#define MK_DELAY_US 0
#endif
#ifndef MK_REP
#define MK_REP 0
#endif
#ifndef MK_SUB
#define MK_SUB 0
#endif
#ifndef MK_XSYNC
#define MK_XSYNC 0
#endif
#ifndef MK_SK
#define MK_SK 0
#endif
#ifndef MK_DUMP
#define MK_DUMP 0
#endif

constexpr int DM = 4096, NC = 22528, TP = 8192, TS = 128, MT = TP + TS, MP = 8448, EA = 2048;
constexpr int COL_U = 0, COL_V = 2048, COL_ZA = 4096, COL_Q = 6144, COL_F = 8192, COL_I = 10240, COL_ZB = 12288, COL_GA = 14336, COL_GB = 18432;
constexpr float EPS = 1e-6f;
constexpr size_t WS_CTLB = 65536;
constexpr size_t WS_WTIN = WS_CTLB;
constexpr size_t WS_WTAB = WS_WTIN + (size_t)NC * DM * 2;
constexpr size_t WS_WTO  = WS_WTAB + (size_t)DM * DM * 2;
constexpr size_t WS_XN   = WS_WTO + (size_t)DM * DM * 2;
constexpr size_t WS_H    = WS_XN + (size_t)MP * DM * 2;
constexpr size_t WS_YAB  = WS_H + (size_t)MP * NC * 2;
constexpr size_t WS_MRG  = WS_YAB + (size_t)MP * DM * 2;
constexpr size_t WS_SN   = WS_MRG;
constexpr size_t WS_Z    = WS_MRG + (size_t)MP * DM * 2;
constexpr size_t WS_LNP  = WS_Z + (size_t)MP * DM * 2;
constexpr size_t WS_SSP  = WS_LNP + (size_t)MP * 64 * 4;
constexpr size_t WS_WSM  = WS_SSP + (size_t)MP * 64 * 4;
constexpr size_t WS_QT0  = WS_WSM + (size_t)16 * 128 * 128 * 2;
constexpr size_t WS_KTT  = WS_QT0 + (size_t)TP * EA * 2;
constexpr size_t WS_ITT  = WS_KTT + (size_t)TP * EA * 2;
constexpr size_t WS_OIN  = WS_ITT + (size_t)TP * EA * 2;
constexpr size_t WS_DEC  = WS_OIN + (size_t)TP * EA * 4;
constexpr size_t WS_LNPS = WS_DEC + (size_t)2048 * 128 * 4;
constexpr size_t WS_SSPS = WS_LNPS + (size_t)128 * 256 * 4;
constexpr size_t WS_END  = WS_SSPS + (size_t)128 * 256 * 4;
constexpr size_t O_YP = 0, O_YS = O_YP + (size_t)TP * DM, O_SP = O_YS + (size_t)TS * DM, O_SS = O_SP + (size_t)4 * 16 * 128 * 128,
                 O_VP = O_SS + (size_t)128 * 16 * 128 * 128, O_VS = O_VP + (size_t)4 * 128 * EA, O_END = O_VS + (size_t)128 * EA;
constexpr int LDS_STAGE = 128 * 1024, LDS_BYTES = LDS_STAGE + 256;

#define LAS __attribute__((address_space(3)))
#define XB_TMO      128
#define XB_XCNT(j)  (256  + 64 * (j))
#define XB_XSUB(j)  (1280 + 64 * (j))
#define XB_XGEN(j)  (2304 + 64 * (j))
#define XB_TOP      3328
#define XB_TOPGEN   3392
#define XCD_BAR_WORDS 3456
#define XB_SPIN_CAP (1u << 18)

__device__ __forceinline__ unsigned xb_ld(unsigned* p)              { return __hip_atomic_load(p, __ATOMIC_RELAXED, __HIP_MEMORY_SCOPE_AGENT); }
__device__ __forceinline__ unsigned xb_add(unsigned* p, unsigned v) { return __hip_atomic_fetch_add(p, v, __ATOMIC_RELAXED, __HIP_MEMORY_SCOPE_AGENT); }
__device__ __forceinline__ unsigned xb_xcc_id() { return (unsigned)__builtin_amdgcn_s_getreg((3 << 11) | 20) & 0xFu; }
#define XB_SPIN(cond, bar) do { unsigned _sp = 0; while (cond) { __builtin_amdgcn_s_sleep(1); \
    if ((++_sp & 255u) == 0u) { if (xb_ld(&(bar)[XB_TMO])) break; if (_sp > XB_SPIN_CAP) { atomicAdd(&(bar)[XB_TMO], 1u); break; } } } } while (0)

struct XcdBarrier {
    unsigned* bar; unsigned x;
    volatile LAS unsigned* st;
};

__device__ __forceinline__ XcdBarrier xcd_barrier_post(unsigned* bar, volatile LAS unsigned* st) {
    XcdBarrier b; b.bar = bar; b.x = xb_xcc_id(); b.st = st;
    if (threadIdx.x == 0) (void)xb_add(&bar[XB_XCNT(b.x)], 1u);
    return b;
}
__device__ __forceinline__ void xcd_barrier_complete(unsigned* bar, unsigned x, unsigned& nloc, unsigned& nx) {
    const unsigned G = gridDim.x * gridDim.y * gridDim.z;
    unsigned sum, cnt, mine, sp = 0u;
    for (;;) {
        sum = 0u; cnt = 0u; mine = 0u;
#pragma unroll
        for (unsigned j = 0; j < 16; ++j) { const unsigned c = xb_ld(&bar[XB_XCNT(j)]); sum += c; cnt += (c > 0u) ? 1u : 0u; mine = (j == x) ? c : mine; }
        if (sum == G) break;
        __builtin_amdgcn_s_sleep(1);
        if ((++sp & 255u) == 0u) { if (xb_ld(&bar[XB_TMO])) break; if (sp > XB_SPIN_CAP) { atomicAdd(&bar[XB_TMO], 1u); break; } }
    }
    nloc = mine > 0u ? mine : 1u; nx = cnt > 0u ? cnt : 1u;
}

__device__ __forceinline__ void xcd_barrier(const XcdBarrier& b) {
    asm volatile("s_waitcnt vmcnt(0)" ::: "memory");
    __syncthreads();
    if (threadIdx.x == 0) {
        unsigned* bar = b.bar;
        __builtin_amdgcn_s_waitcnt(0);
        unsigned nloc = b.st[0], nx = b.st[1];
        if (nloc == 0u) { xcd_barrier_complete(bar, b.x, nloc, nx); b.st[0] = nloc; b.st[1] = nx; }
        const unsigned old = xb_add(&bar[XB_XSUB(b.x)], 1u);
        const unsigned gen = old / nloc;
        if (old + 1u == (gen + 1u) * nloc) {
            __builtin_amdgcn_fence(__ATOMIC_RELEASE, "agent");
            asm volatile("s_waitcnt vmcnt(0)" ::: "memory");
            const unsigned og = xb_add(&bar[XB_TOP], 1u);
            const unsigned tg = og / nx;
            if (og + 1u == (tg + 1u) * nx) xb_add(&bar[XB_TOPGEN], 1u);
            else XB_SPIN(xb_ld(&bar[XB_TOPGEN]) == tg, bar);
            __builtin_amdgcn_fence(__ATOMIC_ACQUIRE, "agent");
            xb_add(&bar[XB_XGEN(b.x)], 1u);
            asm volatile("s_waitcnt vmcnt(0)" ::: "memory");
        } else {
            XB_SPIN(xb_ld(&bar[XB_XGEN(b.x)]) == gen, bar);
            __builtin_amdgcn_fence(__ATOMIC_ACQUIRE, "agent");
            asm volatile("s_waitcnt vmcnt(0)" ::: "memory");
        }
    }
    __syncthreads();
}

namespace pg8 {
#define PG8_LAS __attribute__((address_space(3)))
typedef unsigned short bf16_t;
typedef short bf16x8 __attribute__((ext_vector_type(8)));
typedef float f32x4 __attribute__((ext_vector_type(4)));
typedef unsigned u32x4 __attribute__((ext_vector_type(4)));
constexpr int BM = 256, BK = 64, HALF = 128, HTB = HALF * BK * 2  , STAGE_BYTES = 8 * HTB, NXCD = 8, WGM = 8;

__host__ __device__ __forceinline__ int lds_byte(int r, int c) { const int st = (r >> 4) * 2 + (c >> 5), rr = r & 15, cc = c & 31, ob = rr * 64 + cc * 2; return st * 1024 + (ob ^ (((ob >> 9) & 1) << 5)); }
__host__ __device__ __forceinline__ void stage_rc(int b, int& R, int& C) { const int st = b / 1024, sb = b % 1024, swz = sb ^ (((sb >> 9) & 1) << 5); R = (st >> 1) * 16 + swz / 64; C = (st & 1) * 32 + (swz % 64) / 2; }
__host__ __device__ __forceinline__ int perm32(int rho) { const int n = rho >> 4, i = rho & 15; return 8 * (i >> 2) + 4 * n + (i & 3); }

struct Unit { int pm, pn, kh; };
struct Gemm { const bf16_t* A; const bf16_t* Bt; int M, N, K, nt; size_t khoff; };

struct StaticOrder {
    int nM, nN, nwg, G, c;
    __host__ __device__ void init(int M, int N, int G_, int c_) { nM = M / BM; nN = N / BM; nwg = nM * nN; G = G_; c = c_; }
    __host__ __device__ bool next(int i, Unit& u) const {
        const long L = (long)i * G + c; if (L >= nwg) return false;
        int wgid = (int)L; { const int q = nwg / NXCD, r = nwg % NXCD, xcd = wgid % NXCD, off = wgid / NXCD; wgid = (xcd < r ? xcd * (q + 1) : r * (q + 1) + (xcd - r) * q) + off; }
        const int nig = WGM * nN, gid = wgid / nig, fm = gid * WGM, gsz = (nM - fm) < WGM ? (nM - fm) : WGM;
        u.pm = fm + ((wgid % nig) % gsz); u.pn = (wgid % nig) / gsz; u.kh = 0; return true;
    }
    __device__ __forceinline__ void a_ready(const Unit&) const {}
    __device__ __forceinline__ void done(const Unit&) const {}
};

typedef float f32x2 __attribute__((ext_vector_type(2)));
typedef __bf16 bf16x2_t __attribute__((ext_vector_type(2)));
__device__ __forceinline__ unsigned cvt_pk_bf16(float lo, float hi) { const f32x2 v = {lo, hi}; return __builtin_bit_cast(unsigned, __builtin_convertvector(v, bf16x2_t)); }
__device__ __forceinline__ float bf2f(unsigned short b) { return __builtin_bit_cast(float, (unsigned)b << 16); }
__device__ __forceinline__ float f_lo(unsigned w) { return __builtin_bit_cast(float, w << 16); }
__device__ __forceinline__ float f_hi(unsigned w) { return __builtin_bit_cast(float, w & 0xffff0000u); }
__device__ __forceinline__ float fsigmoid(float x) { return __builtin_amdgcn_rcpf(1.0f + __expf(-x)); }
__device__ __forceinline__ float fsilu(float x) { return x * fsigmoid(x); }
__device__ __forceinline__ float fgelu(float x) { return x * fsigmoid(1.5957691216057308f * (x + 0.044715f * x * x * x)); }

struct EpiAct {
    static constexpr bool PERM = true, AFTER_DRAIN = false, CARRY = false;
    bf16_t* H; const float* lbl; float* lnp;
    template <int ACT> __device__ __forceinline__ void run(const f32x4 (&acc)[2][2][4][2], const Unit& u, int wr, int wc, int fr, int fq) const {
        const int row0 = u.pm * BM + wr * 64 + fr, col0 = u.pn * BM + wc * 32 + 8 * fq;
        float lb[2][8];
        if (ACT == 3) {
#pragma unroll
            for (int bj = 0; bj < 2; ++bj) { const float* l0 = lbl + (col0 + bj * HALF - 8192); const f32x4 a0 = *(const f32x4*)l0, a1 = *(const f32x4*)(l0 + 4), b0 = *(const f32x4*)(l0 + 2048), b1 = *(const f32x4*)(l0 + 2052);
#pragma unroll
                for (int k = 0; k < 4; ++k) { lb[bj][k] = __builtin_amdgcn_rcpf(1.0f + __expf(b0[k] - a0[k])); lb[bj][4 + k] = __builtin_amdgcn_rcpf(1.0f + __expf(b1[k] - a1[k])); } }
        }
#pragma unroll
        for (int ai = 0; ai < 2; ++ai)
#pragma unroll
            for (int m = 0; m < 4; ++m) { const int row = row0 + ai * HALF + m * 16; bf16_t* rowp = H + (size_t)row * 22528 + col0; float s1 = 0.f, s2 = 0.f;
#pragma unroll
                for (int bj = 0; bj < 2; ++bj) { float v[8];
#pragma unroll
                    for (int k = 0; k < 4; ++k) { v[k] = acc[ai][bj][m][0][k]; v[4 + k] = acc[ai][bj][m][1][k]; }
#pragma unroll
                    for (int k = 0; k < 8; ++k) {
                        if (ACT == 0 || ACT == 1) v[k] = fgelu(v[k]);
                        if (ACT == 2) v[k] = fsilu(v[k]);
                        if (ACT == 3) v[k] = __logf(lb[bj][k] + (1.0f - lb[bj][k]) * fsigmoid(v[k]));
                        if (ACT == 5) v[k] = fsigmoid(v[k]);
                        if (ACT == 1) { s1 += v[k]; s2 += v[k] * v[k]; }
                    }
                    u32x4 w; w.x = cvt_pk_bf16(v[0], v[1]); w.y = cvt_pk_bf16(v[2], v[3]); w.z = cvt_pk_bf16(v[4], v[5]); w.w = cvt_pk_bf16(v[6], v[7]);
                    *(u32x4*)(rowp + bj * HALF) = w; }
                if (ACT == 1) { s1 += __shfl_xor(s1, 16); s1 += __shfl_xor(s1, 32); s2 += __shfl_xor(s2, 16); s2 += __shfl_xor(s2, 32);
                    if (fq == 0) { f32x2 o; o.x = s1; o.y = s2; *(f32x2*)(lnp + (size_t)row * 64 + ((u.pn - 8) * 4 + wc) * 2) = o; } }
            }
    }
    __device__ __forceinline__ void operator()(const f32x4 (&acc)[2][2][4][2], const Unit& u, int wr, int wc, int fr, int fq) const {
        const int pn = u.pn;
        if (pn < 8) run<0>(acc, u, wr, wc, fr, fq);
        else if (pn < 16) run<1>(acc, u, wr, wc, fr, fq);
        else if (pn < 32) run<2>(acc, u, wr, wc, fr, fq);
        else if (pn < 40) run<3>(acc, u, wr, wc, fr, fq);
        else if (pn < 48) run<4>(acc, u, wr, wc, fr, fq);
        else if (pn < 56) run<2>(acc, u, wr, wc, fr, fq);
        else run<5>(acc, u, wr, wc, fr, fq);
    }
};

struct EpiMerge {
    static constexpr bool PERM = true, AFTER_DRAIN = false, CARRY = true;
    const bf16_t* H; bf16_t* O;
    __device__ __forceinline__ void mid(f32x4 (&acc)[2][2][4][2], const Unit& u, int wr, int wc, int fr, int fq) const {
        const int row0 = u.pm * BM + wr * 64 + fr, col0 = u.pn * BM + wc * 32 + 8 * fq;
#pragma unroll
        for (int ai = 0; ai < 2; ++ai)
#pragma unroll
            for (int m = 0; m < 4; ++m) { const bf16_t* gp = H + (size_t)(row0 + ai * HALF + m * 16) * 22528 + 14336 + col0;
#pragma unroll
                for (int bj = 0; bj < 2; ++bj) { const u32x4 a = *(const u32x4*)(gp + bj * HALF), b = *(const u32x4*)(gp + 4096 + bj * HALF);
                    f32x4 r0, r1;
                    r0[0] = f_lo(a.x) * __builtin_amdgcn_rcpf(f_lo(b.x)); r0[1] = f_hi(a.x) * __builtin_amdgcn_rcpf(f_hi(b.x)); r0[2] = f_lo(a.y) * __builtin_amdgcn_rcpf(f_lo(b.y)); r0[3] = f_hi(a.y) * __builtin_amdgcn_rcpf(f_hi(b.y));
                    r1[0] = f_lo(a.z) * __builtin_amdgcn_rcpf(f_lo(b.z)); r1[1] = f_hi(a.z) * __builtin_amdgcn_rcpf(f_hi(b.z)); r1[2] = f_lo(a.w) * __builtin_amdgcn_rcpf(f_lo(b.w)); r1[3] = f_hi(a.w) * __builtin_amdgcn_rcpf(f_hi(b.w));
                    acc[ai][bj][m][0] *= r0; acc[ai][bj][m][1] *= r1; }
                asm volatile("" ::: "memory"); }
    }
    __device__ __forceinline__ void operator()(f32x4 (&acc)[2][2][4][2], const Unit& u, int wr, int wc, int fr, int fq) const {
        if (u.kh == 0) { mid(acc, u, wr, wc, fr, fq); return; }
        const int row0 = u.pm * BM + wr * 64 + fr, col0 = u.pn * BM + wc * 32 + 8 * fq;
#pragma unroll
        for (int ai = 0; ai < 2; ++ai)
#pragma unroll
            for (int m = 0; m < 4; ++m) { const int row = row0 + ai * HALF + m * 16; const bf16_t* gp = H + (size_t)row * 22528 + 18432 + col0; bf16_t* rowp = O + (size_t)row * 4096 + col0;
#pragma unroll
                for (int bj = 0; bj < 2; ++bj) { const u32x4 b = *(const u32x4*)(gp + bj * HALF); const f32x4 v0 = acc[ai][bj][m][0], v1 = acc[ai][bj][m][1];
                    u32x4 w; w.x = cvt_pk_bf16(v0[0] * f_lo(b.x), v0[1] * f_hi(b.x)); w.y = cvt_pk_bf16(v0[2] * f_lo(b.y), v0[3] * f_hi(b.y));
                    w.z = cvt_pk_bf16(v1[0] * f_lo(b.z), v1[1] * f_hi(b.z)); w.w = cvt_pk_bf16(v1[2] * f_lo(b.w), v1[3] * f_hi(b.w));
                    *(u32x4*)(rowp + bj * HALF) = w; }
                asm volatile("" ::: "memory"); }
    }
};

struct EpiZ {
    static constexpr bool PERM = true, AFTER_DRAIN = false, CARRY = false;
    bf16_t* Z; float* ssp;
    __device__ __forceinline__ void operator()(const f32x4 (&acc)[2][2][4][2], const Unit& u, int wr, int wc, int fr, int fq) const {
        const int row0 = u.pm * BM + wr * 64 + fr, col0 = u.pn * BM + wc * 32 + 8 * fq;
#pragma unroll
        for (int ai = 0; ai < 2; ++ai)
#pragma unroll
            for (int m = 0; m < 4; ++m) { const int row = row0 + ai * HALF + m * 16; bf16_t* rowp = Z + (size_t)row * 4096 + col0; float ss = 0.f;
#pragma unroll
                for (int bj = 0; bj < 2; ++bj) { const f32x4 v0 = acc[ai][bj][m][0], v1 = acc[ai][bj][m][1];
                    ss += (v0[0] * v0[0] + v0[1] * v0[1]) + (v0[2] * v0[2] + v0[3] * v0[3]) + (v1[0] * v1[0] + v1[1] * v1[1]) + (v1[2] * v1[2] + v1[3] * v1[3]);
                    u32x4 w; w.x = cvt_pk_bf16(v0[0], v0[1]); w.y = cvt_pk_bf16(v0[2], v0[3]); w.z = cvt_pk_bf16(v1[0], v1[1]); w.w = cvt_pk_bf16(v1[2], v1[3]);
                    *(u32x4*)(rowp + bj * HALF) = w; }
                ss += __shfl_xor(ss, 16); ss += __shfl_xor(ss, 32);
                if (fq == 0) ssp[(size_t)row * 64 + u.pn * 4 + wc] = ss; }
    }
};

struct PairOrder : StaticOrder {
    __device__ bool next(int i, Unit& u) const { if (!StaticOrder::next(i >> 1, u)) return false; u.kh = i & 1; return true; }
};

struct RevOrder : StaticOrder {
    __device__ bool next(int i, Unit& u) const { if (!StaticOrder::next(i, u)) return false; u.pn = nN - 1 - u.pn; return true; }
};

template <class Epi, class Sched, bool ALIGN_EPI = false, bool SP2 = false>
__device__ __forceinline__ void gemm_phase(PG8_LAS unsigned char* lds, const Gemm g, const Sched& S, const Epi& E) {
    int tid_o = threadIdx.x; asm volatile("" : "+v"(tid_o));
    const int tid = tid_o, wid = __builtin_amdgcn_readfirstlane(tid >> 6), lane = tid & 63, wr = wid >> 2, wc = wid & 3, fr = lane & 15, fq = lane >> 4;
    const int K = g.K, nt = g.nt;
    unsigned voffA[2], voffB[2];
#pragma unroll
    for (int i = 0; i < 2; ++i) { int R, C; stage_rc(tid * 16 + i * 8192, R, C); const int Rb = Epi::PERM ? ((R & ~31) + perm32(R & 31)) : R;
        voffA[i] = (unsigned)(R * K + C) * 2u; voffB[i] = (unsigned)(Rb * K + C) * 2u; }
    const size_t kstep = (size_t)(BK * 2);
    const size_t hstep = (size_t)HALF * K * 2;
    const size_t tstep = 2 * hstep;
    const unsigned ldsw = (unsigned)wid * 1024u;
    const int aoff = lds_byte(wr * 64 + fr, fq * 8), boff = lds_byte(wc * 32 + fr, fq * 8);
#define PG8_SA(b, h) (((b) * 2 + (h)) * HTB)
#define PG8_SB(b, h) ((4 + (b) * 2 + (h)) * HTB)
#define PG8_STAGE(bufoff, gbase, voff) do { _Pragma("unroll") for (int _i = 0; _i < 2; ++_i) \
        __builtin_amdgcn_global_load_lds((const unsigned*)((const char*)(gbase) + (voff)[_i]), (PG8_LAS unsigned*)(lds + (bufoff) + ldsw + _i * 8192), 16, 0, 0); } while (0)
#define PG8_LDA(dst, b, h) do { _Pragma("unroll") for (int m = 0; m < 4; ++m) _Pragma("unroll") for (int k = 0; k < 2; ++k) dst[m][k] = *(const PG8_LAS bf16x8*)(lds + PG8_SA(b, h) + aoff + m * 2048 + k * 1024); } while (0)
#define PG8_LDB(dst, b, h) do { _Pragma("unroll") for (int n = 0; n < 2; ++n) _Pragma("unroll") for (int k = 0; k < 2; ++k) dst[n][k] = *(const PG8_LAS bf16x8*)(lds + PG8_SB(b, h) + boff + n * 2048 + k * 1024); } while (0)
#define PG8_MMA(ai, bj, At, Bt) do { __builtin_amdgcn_s_setprio(1); _Pragma("unroll") for (int m = 0; m < 4; ++m) _Pragma("unroll") for (int n = 0; n < 2; ++n) _Pragma("unroll") for (int k = 0; k < 2; ++k) \
        acc[ai][bj][m][n] = __builtin_amdgcn_mfma_f32_16x16x32_bf16(Bt[n][k], At[m][k], acc[ai][bj][m][n], 0, 0, 0); __builtin_amdgcn_s_setprio(0); } while (0)
#define PG8_WAIT_V(n) asm volatile("s_waitcnt vmcnt(" #n ")" ::: "memory")
#define PG8_WAIT_L(n) asm volatile("s_waitcnt lgkmcnt(" #n ")" ::: "memory")
#define PG8_BAR __builtin_amdgcn_s_barrier()
#define PG8_SCHED __builtin_amdgcn_sched_barrier(0)
    Unit cur, nxt; int ui = 0;
    if (!S.next(0, cur)) return;
    f32x4 acc[2][2][4][2];
#pragma unroll
    for (int a = 0; a < 2; ++a)
#pragma unroll
        for (int b = 0; b < 2; ++b)
#pragma unroll
            for (int m = 0; m < 4; ++m)
#pragma unroll
                for (int n = 0; n < 2; ++n) acc[a][b][m][n] = (f32x4){0.f, 0.f, 0.f, 0.f};
    bf16x8 At[4][2], B0[2][2], B1[2][2];
    const char* cA = (const char*)g.A + (size_t)cur.pm * tstep + (size_t)cur.kh * g.khoff; const char* cB = (const char*)g.Bt + (size_t)cur.pn * tstep + (size_t)cur.kh * g.khoff;
    S.a_ready(cur);
    if constexpr (SP2) {
        PG8_STAGE(PG8_SB(0, 0), cB, voffB); PG8_STAGE(PG8_SB(0, 1), cB + hstep, voffB); PG8_STAGE(PG8_SA(0, 0), cA, voffA); PG8_STAGE(PG8_SA(0, 1), cA + hstep, voffA);
        if (wr == 1) PG8_BAR;
        PG8_WAIT_V(2); PG8_BAR;
        PG8_STAGE(PG8_SB(1, 0), cB + kstep, voffB); PG8_STAGE(PG8_SA(1, 0), cA + kstep, voffA); PG8_STAGE(PG8_SB(1, 1), cB + hstep + kstep, voffB);
        PG8_WAIT_V(6); PG8_BAR;
    } else {
        PG8_STAGE(PG8_SB(0, 0), cB, voffB); PG8_STAGE(PG8_SA(0, 0), cA, voffA); PG8_STAGE(PG8_SB(0, 1), cB + hstep, voffB); PG8_STAGE(PG8_SA(0, 1), cA + hstep, voffA);
        if (wr == 1) PG8_BAR;
        PG8_WAIT_V(4); PG8_BAR;
        PG8_STAGE(PG8_SB(1, 0), cB + kstep, voffB); PG8_STAGE(PG8_SA(1, 0), cA + kstep, voffA); PG8_STAGE(PG8_SB(1, 1), cB + hstep + kstep, voffB);
        PG8_WAIT_V(6); PG8_BAR;
    }
    for (;;) {
        const bool has_next = S.next(ui + 1, nxt);
        const char* nA = has_next ? (const char*)g.A + (size_t)nxt.pm * tstep + (size_t)nxt.kh * g.khoff : cA; const char* nB = has_next ? (const char*)g.Bt + (size_t)nxt.pn * tstep + (size_t)nxt.kh * g.khoff : cB;
        for (int t = 0; t < nt; t += 2) {
            const bool last = (t == nt - 2);
            const char* a1 = cA + (size_t)(t + 1) * kstep;
            const char* a2 = last ? nA : cA + (size_t)(t + 2) * kstep; const char* b2 = last ? nB : cB + (size_t)(t + 2) * kstep;
            const char* a3 = a2 + kstep; const char* b3 = b2 + kstep;
            if (last && has_next) S.a_ready(nxt);
            if constexpr (SP2) {
            PG8_LDB(B0, 0, 0); PG8_LDB(B1, 0, 1); PG8_SCHED; PG8_LDA(At, 0, 0); PG8_STAGE(PG8_SA(1, 1), a1 + hstep, voffA);
            PG8_WAIT_V(8); PG8_WAIT_L(0); PG8_BAR; PG8_MMA(0, 0, At, B0); PG8_MMA(0, 1, At, B1); PG8_BAR; PG8_SCHED;
            PG8_LDA(At, 0, 1); PG8_STAGE(PG8_SB(0, 0), b2, voffB); PG8_STAGE(PG8_SB(0, 1), b2 + hstep, voffB); PG8_STAGE(PG8_SA(0, 0), a2, voffA);
            PG8_WAIT_V(8); PG8_WAIT_L(0); PG8_BAR; PG8_MMA(1, 0, At, B0); PG8_MMA(1, 1, At, B1); PG8_BAR; PG8_SCHED;
            PG8_LDB(B0, 1, 0); PG8_LDB(B1, 1, 1); PG8_SCHED; PG8_LDA(At, 1, 0); PG8_STAGE(PG8_SA(0, 1), a2 + hstep, voffA);
            PG8_WAIT_V(8); PG8_WAIT_L(0); PG8_BAR; PG8_MMA(0, 0, At, B0); PG8_MMA(0, 1, At, B1); PG8_BAR; PG8_SCHED;
            PG8_LDA(At, 1, 1); PG8_STAGE(PG8_SB(1, 0), b3, voffB); PG8_STAGE(PG8_SB(1, 1), b3 + hstep, voffB); PG8_STAGE(PG8_SA(1, 0), a3, voffA);
            PG8_WAIT_V(8); PG8_WAIT_L(0); PG8_BAR; PG8_MMA(1, 0, At, B0); PG8_MMA(1, 1, At, B1); PG8_BAR; PG8_SCHED;
            } else {
            PG8_LDB(B0, 0, 0); PG8_SCHED; PG8_LDA(At, 0, 0); PG8_STAGE(PG8_SA(1, 1), a1 + hstep, voffA);
            PG8_WAIT_L(8); PG8_BAR; PG8_WAIT_L(0); PG8_MMA(0, 0, At, B0); PG8_BAR; PG8_SCHED;
            PG8_LDB(B1, 0, 1); PG8_STAGE(PG8_SB(0, 0), b2, voffB);
            PG8_BAR; PG8_WAIT_L(0); PG8_MMA(0, 1, At, B1); PG8_BAR;
            PG8_LDA(At, 0, 1); PG8_STAGE(PG8_SA(0, 0), a2, voffA);
            PG8_BAR; PG8_WAIT_L(0); PG8_MMA(1, 0, At, B0); PG8_BAR; PG8_SCHED;
            PG8_STAGE(PG8_SB(0, 1), b2 + hstep, voffB);
            PG8_WAIT_V(6); PG8_BAR; PG8_MMA(1, 1, At, B1); PG8_BAR;
            PG8_LDB(B0, 1, 0); PG8_SCHED; PG8_LDA(At, 1, 0); PG8_STAGE(PG8_SA(0, 1), a2 + hstep, voffA);
            PG8_WAIT_L(8); PG8_BAR; PG8_WAIT_L(0); PG8_MMA(0, 0, At, B0); PG8_BAR; PG8_SCHED;
            PG8_LDB(B1, 1, 1); PG8_STAGE(PG8_SB(1, 0), b3, voffB);
            PG8_BAR; PG8_WAIT_L(0); PG8_MMA(0, 1, At, B1); PG8_BAR;
            PG8_LDA(At, 1, 1); PG8_STAGE(PG8_SA(1, 0), a3, voffA);
            PG8_BAR; PG8_WAIT_L(0); PG8_MMA(1, 0, At, B0); PG8_BAR; PG8_SCHED;
            PG8_STAGE(PG8_SB(1, 1), b3 + hstep, voffB);
            PG8_WAIT_V(6); PG8_BAR; PG8_MMA(1, 1, At, B1); PG8_BAR;
            }
        }
        if constexpr (ALIGN_EPI) { if (wr == 0) PG8_BAR; }
        if constexpr (!Epi::AFTER_DRAIN) { E(acc, cur, wr, wc, fr, fq); S.done(cur); }
        if (!has_next) break;
        if (!(Epi::CARRY && cur.kh == 0)) {
#pragma unroll
        for (int a = 0; a < 2; ++a)
#pragma unroll
            for (int b = 0; b < 2; ++b)
#pragma unroll
                for (int m = 0; m < 4; ++m)
#pragma unroll
                    for (int n = 0; n < 2; ++n) acc[a][b][m][n] = (f32x4){0.f, 0.f, 0.f, 0.f};
        }
        cur = nxt; cA = nA; cB = nB; ++ui;
        if constexpr (ALIGN_EPI) { if (wr == 1) PG8_BAR; }
    }
    PG8_WAIT_V(0);
    if constexpr (!ALIGN_EPI) { if (wr == 0) PG8_BAR; }
    PG8_BAR;
    if constexpr (Epi::AFTER_DRAIN) { E.fused(acc, cur, wr, wc, fr, fq, lds, wid, lane); S.done(cur); }
#undef PG8_SA
#undef PG8_SB
#undef PG8_STAGE
#undef PG8_LDA
#undef PG8_LDB
#undef PG8_MMA
#undef PG8_WAIT_V
#undef PG8_WAIT_L
#undef PG8_BAR
#undef PG8_SCHED
}
}

using pg8::bf16_t; using pg8::bf16x8; using pg8::f32x4; using pg8::u32x4; using pg8::f32x2; using pg8::cvt_pk_bf16; using pg8::bf2f; using pg8::f_lo; using pg8::f_hi;
typedef unsigned u32x2 __attribute__((ext_vector_type(2)));
#define LDS_WAIT() asm volatile("s_waitcnt lgkmcnt(0)" ::: "memory")
#define MFMA16(X, Y, C) __builtin_amdgcn_mfma_f32_16x16x32_bf16((X), (Y), (C), 0, 0, 0)

struct Params {
    const float *xp, *xs, *st0, *lbl, *gpre, *win, *lng, *lnb, *wsp, *bsp, *gon, *wpa, *wpb, *wo, *gpost;
    float* out; unsigned char* ws; int lo, hi;
};

__device__ __forceinline__ float wave_sum(float v) {
#pragma unroll
    for (int o = 1; o < 64; o <<= 1) v += __shfl_xor(v, o);
    return v;
}

__device__ __forceinline__ void p0_transpose_item(const float* W, int N, bf16_t* WT, int ldd, int koff, LAS float* scr, int kb, int nb, int lane) {
    const int k0 = 64 * kb, n0 = 32 * nb;
#pragma unroll 8
    for (int i = 0; i < 32; ++i) { const int kk = 2 * i + (lane >> 5); scr[kk * 33 + (lane & 31)] = W[(size_t)(k0 + kk) * N + n0 + (lane & 31)]; }
    LDS_WAIT(); asm volatile("" ::: "memory");
    const int c = lane & 7;
#pragma unroll
    for (int j = 0; j < 4; ++j) { const int n = (lane >> 3) + 8 * j; const LAS float* s = scr + (8 * c) * 33 + n;
        u32x4 o; o.x = cvt_pk_bf16(s[0 * 33], s[1 * 33]); o.y = cvt_pk_bf16(s[2 * 33], s[3 * 33]); o.z = cvt_pk_bf16(s[4 * 33], s[5 * 33]); o.w = cvt_pk_bf16(s[6 * 33], s[7 * 33]);
        *(u32x4*)(WT + (size_t)(n0 + n) * ldd + koff + k0 + 8 * c) = o; }
    LDS_WAIT(); asm volatile("" ::: "memory");
}

__device__ __forceinline__ void phase0(const Params& p, LAS unsigned char* lds) {
    const int tid = threadIdx.x, lane = tid & 63, wid = tid >> 6;
    const int gw = blockIdx.x * 8 + wid, NGW = gridDim.x * 8;
    unsigned char* ws = p.ws;
    bf16_t* WTIN = (bf16_t*)(ws + WS_WTIN); bf16_t* WTAB = (bf16_t*)(ws + WS_WTAB); bf16_t* WTO = (bf16_t*)(ws + WS_WTO);
    bf16_t* XN = (bf16_t*)(ws + WS_XN); bf16_t* YAB = (bf16_t*)(ws + WS_YAB); bf16_t* WSM = (bf16_t*)(ws + WS_WSM);
    LAS float* scr = (LAS float*)(lds + wid * 8448);
    constexpr int I_IN = 64 * 704, I_PA = 32 * 128, I_O = 64 * 128, NIT = I_IN + 2 * I_PA + I_O;
    for (int it = gw; it < NIT; it += NGW) {
        int r = it;
        if (r < I_IN) { p0_transpose_item(p.win, NC, WTIN, DM, 0, scr, r / 704, r % 704, lane); continue; } r -= I_IN;
        if (r < I_PA) { p0_transpose_item(p.wpa, DM, WTAB, DM, 0, scr, r / 128, r % 128, lane); continue; } r -= I_PA;
        if (r < I_PA) { p0_transpose_item(p.wpb, DM, WTAB, DM, 2048, scr, r / 128, r % 128, lane); continue; } r -= I_PA;
        p0_transpose_item(p.wo, DM, WTO, DM, 0, scr, r / 128, r % 128, lane);
    }
    for (int m = gw; m < MP; m += NGW) {
        u32x2* o8 = (u32x2*)(XN + (size_t)m * DM) + lane;
        if (m < MT) {
            const float* xr = (m < TP) ? p.xp + (size_t)m * DM : p.xs + (size_t)(m - TP) * DM;
            const f32x4* x4 = (const f32x4*)xr + lane; const f32x4* g4 = (const f32x4*)p.gpre + lane;
            f32x4 v[16]; float s = 0.f;
#pragma unroll
            for (int j = 0; j < 16; ++j) { v[j] = x4[64 * j]; s += (v[j][0] * v[j][0] + v[j][1] * v[j][1]) + (v[j][2] * v[j][2] + v[j][3] * v[j][3]); }
            const float rs = __builtin_amdgcn_rsqf(wave_sum(s) * (1.0f / DM) + EPS);
#pragma unroll
            for (int j = 0; j < 16; ++j) { const f32x4 g = g4[64 * j]; u32x2 w; w.x = cvt_pk_bf16(v[j][0] * rs * g[0], v[j][1] * rs * g[1]); w.y = cvt_pk_bf16(v[j][2] * rs * g[2], v[j][3] * rs * g[3]); o8[64 * j] = w; }
        } else {
            u32x2* y8 = (u32x2*)(YAB + (size_t)m * DM) + lane; u32x2 z; z.x = 0u; z.y = 0u;
#pragma unroll
            for (int j = 0; j < 16; ++j) { o8[64 * j] = z; y8[64 * j] = z; }
        }
    }
    for (int i = blockIdx.x * 512 + tid; i < 16 * 128 * 128; i += gridDim.x * 512) { const int s = i & 127, t = (i >> 7) & 127; WSM[i] = (s <= t) ? (bf16_t)(cvt_pk_bf16(p.wsp[i], 0.f) & 0xffffu) : (bf16_t)0; }
}

__device__ __forceinline__ void hgrn_prep_phase(const Params& p, LAS unsigned char* lds) {
    int tid_o = threadIdx.x; asm volatile("" : "+v"(tid_o));
    const int tid = tid_o, lane = tid & 63, w = tid >> 6, fr = lane & 15, fq = lane >> 4, d = tid & 127, tq = tid >> 7;
    const int pr = tid >> 4, pc = (tid & 15) * 8;
    u32x4 R[6];
#define PREP_LOAD(item_) do { const int h_ = (item_) & 15, n_ = ((item_) >> 4) & 31, b_ = (item_) >> 9; const bf16_t* g_ = (const bf16_t*)(p.ws + WS_H) + (size_t)(b_ * 2048 + n_ * 64 + pr) * NC + COL_Q + h_ * 128 + pc; \
        R[0] = *(const u32x4*)g_; R[1] = *(const u32x4*)(g_ + (size_t)32 * NC); R[2] = *(const u32x4*)(g_ + (COL_F - COL_Q)); R[3] = *(const u32x4*)(g_ + (size_t)32 * NC + (COL_F - COL_Q)); \
        R[4] = *(const u32x4*)(g_ + (COL_I - COL_Q)); R[5] = *(const u32x4*)(g_ + (size_t)32 * NC + (COL_I - COL_Q)); } while (0)
    if ((int)blockIdx.x < 2048) PREP_LOAD((int)blockIdx.x);
    for (int item = blockIdx.x; item < 2048; item += gridDim.x) {
    const int h = item & 15, n = (item >> 4) & 31, b = item >> 9;
    const int t0 = b * 2048 + n * 64;
    unsigned char* ws = p.ws;
    bf16_t* QT0 = (bf16_t*)(ws + WS_QT0); bf16_t* KTT = (bf16_t*)(ws + WS_KTT); bf16_t* ITT = (bf16_t*)(ws + WS_ITT); float* OIN = (float*)(ws + WS_OIN); float* DEC = (float*)(ws + WS_DEC);
    LAS bf16_t* Qm = (LAS bf16_t*)lds;
    LAS bf16_t* Km = Qm + 64 * 136;
    LAS bf16_t* ITs = Km + 64 * 136;
    LAS bf16_t* Att = ITs + 128 * 72;
    LAS float* tot = (LAS float*)(Att + 64 * 72);
    LAS bf16_t* Lq = (LAS bf16_t*)(tot + 512);
    LAS bf16_t* Lf = Lq + 64 * 136; LAS bf16_t* Li = Lf + 64 * 136;
    *(LAS u32x4*)(Lq + pr * 136 + pc) = R[0]; *(LAS u32x4*)(Lq + (pr + 32) * 136 + pc) = R[1]; *(LAS u32x4*)(Lf + pr * 136 + pc) = R[2]; *(LAS u32x4*)(Lf + (pr + 32) * 136 + pc) = R[3];
    *(LAS u32x4*)(Li + pr * 136 + pc) = R[4]; *(LAS u32x4*)(Li + (pr + 32) * 136 + pc) = R[5];
    __syncthreads();
    { const int nx = item + (int)gridDim.x; if (nx < 2048) PREP_LOAD(nx); }
    float lf[16], qv[16]; unsigned iv[16];
#pragma unroll
    for (int j = 0; j < 16; ++j) { qv[j] = bf2f(Lq[(tq * 16 + j) * 136 + d]); lf[j] = bf2f(Lf[(tq * 16 + j) * 136 + d]); iv[j] = Li[(tq * 16 + j) * 136 + d]; }
    float run = 0.f, cs[16];
#pragma unroll
    for (int j = 0; j < 16; ++j) { run += lf[j]; cs[j] = run; }
    tot[tq * 128 + d] = run;
    __syncthreads();
    const float t0v = tot[d], t1v = tot[128 + d], t2v = tot[256 + d], t3v = tot[384 + d];
    const float off = (tq > 0 ? t0v : 0.f) + (tq > 1 ? t1v : 0.f) + (tq > 2 ? t2v : 0.f);
    const float bmid = t0v + t1v, blast = (t0v + t1v) + (t2v + t3v);
    unsigned kl[8], ip[8];
#pragma unroll
    for (int j = 0; j < 16; j += 2) {
        float q0[2], klv[2];
#pragma unroll
        for (int jj = 0; jj < 2; ++jj) { const int J = j + jj; const float bj = off + cs[J]; const float f = __expf(lf[J]); const float k = 1.0f - f;
            q0[jj] = qv[J] * __expf(bj); klv[jj] = k * __expf(blast - bj);
            const float qm = qv[J] * __expf(bj - bmid), km = k * __expf(bmid - bj);
            const unsigned pk = cvt_pk_bf16(qm, km);
            Qm[(tq * 16 + J) * 136 + d] = (bf16_t)(pk & 0xffffu); Km[(tq * 16 + J) * 136 + d] = (bf16_t)(pk >> 16);
            QT0[(size_t)(t0 + tq * 16 + J) * EA + h * 128 + d] = (bf16_t)(cvt_pk_bf16(q0[jj], 0.f) & 0xffffu); }
        kl[j >> 1] = cvt_pk_bf16(klv[0], klv[1]); ip[j >> 1] = iv[j] | (iv[j + 1] << 16);
    }
    { u32x4 a, c2; a.x = kl[0]; a.y = kl[1]; a.z = kl[2]; a.w = kl[3]; c2.x = kl[4]; c2.y = kl[5]; c2.z = kl[6]; c2.w = kl[7];
      u32x4* kp = (u32x4*)(KTT + ((size_t)item * 128 + d) * 64 + tq * 16); kp[0] = a; kp[1] = c2;
      u32x4 e, f2; e.x = ip[0]; e.y = ip[1]; e.z = ip[2]; e.w = ip[3]; f2.x = ip[4]; f2.y = ip[5]; f2.z = ip[6]; f2.w = ip[7];
      u32x4* ipp = (u32x4*)(ITT + ((size_t)item * 128 + d) * 64 + tq * 16); ipp[0] = e; ipp[1] = f2;
      LAS u32x4* il = (LAS u32x4*)(ITs + d * 72 + tq * 16); il[0] = e; il[1] = f2; }
    if (tq == 0) DEC[(size_t)item * 128 + d] = __expf(blast);
    __syncthreads();
    {
        const int tb = w >> 1;
#pragma unroll
        for (int x = 0; x < 2; ++x) { const int sb = (w & 1) * 2 + x; f32x4 acc = {0.f, 0.f, 0.f, 0.f};
            if (sb <= tb) {
#pragma unroll
                for (int ks = 0; ks < 4; ++ks) { const bf16x8 X = *(const LAS bf16x8*)(Km + (sb * 16 + fr) * 136 + ks * 32 + fq * 8), Y = *(const LAS bf16x8*)(Qm + (tb * 16 + fr) * 136 + ks * 32 + fq * 8); acc = MFMA16(X, Y, acc); }
                const int t = tb * 16 + fr, s0 = sb * 16 + fq * 4;
#pragma unroll
                for (int j = 0; j < 4; ++j) acc[j] = (s0 + j <= t) ? acc[j] : 0.f;
            }
            u32x2 o; o.x = cvt_pk_bf16(acc[0], acc[1]); o.y = cvt_pk_bf16(acc[2], acc[3]);
            *(LAS u32x2*)(Att + (tb * 16 + fr) * 72 + sb * 16 + fq * 4) = o; }
    }
    __syncthreads();
    {
        const int eb = w;
#pragma unroll
        for (int tb = 0; tb < 4; ++tb) { f32x4 acc = {0.f, 0.f, 0.f, 0.f};
#pragma unroll
            for (int ks = 0; ks < 2; ++ks) { if (ks * 32 <= tb * 16 + 15) { const bf16x8 X = *(const LAS bf16x8*)(ITs + (eb * 16 + fr) * 72 + ks * 32 + fq * 8), Y = *(const LAS bf16x8*)(Att + (tb * 16 + fr) * 72 + ks * 32 + fq * 8); acc = MFMA16(X, Y, acc); } }
            *(f32x4*)(OIN + (size_t)(t0 + tb * 16 + fr) * EA + h * 128 + eb * 16 + fq * 4) = acc; }
    }
    __syncthreads();
    }
#undef PREP_LOAD
}

__device__ __forceinline__ void hgrn_scan_item(const Params& p, LAS unsigned char* lds, int bh) {
    const int tid = threadIdx.x, lane = tid & 63, w = tid >> 6, fr = lane & 15, fq = lane >> 4;
    const int b = bh >> 4, h = bh & 15;
    unsigned char* ws = p.ws;
    const bf16_t* H = (const bf16_t*)(ws + WS_H); bf16_t* YAB = (bf16_t*)(ws + WS_YAB);
    const bf16_t* QT0 = (const bf16_t*)(ws + WS_QT0); const bf16_t* KTT = (const bf16_t*)(ws + WS_KTT); const bf16_t* ITT = (const bf16_t*)(ws + WS_ITT);
    const float* OIN = (const float*)(ws + WS_OIN); const float* DEC = (const float*)(ws + WS_DEC);
    LAS bf16_t* ST = (LAS bf16_t*)lds;
    LAS float* ssq = (LAS float*)(lds + 128 * 136 * 2);
    f32x4 S[8];
#pragma unroll
    for (int eb = 0; eb < 8; ++eb) S[eb] = (f32x4){0.f, 0.f, 0.f, 0.f};
    const int tb = w & 3, eh = w >> 2;
    const f32x4 gon[4] = { *(const f32x4*)(p.gon + h * 128 + (eh * 4 + 0) * 16 + fq * 4), *(const f32x4*)(p.gon + h * 128 + (eh * 4 + 1) * 16 + fq * 4),
                           *(const f32x4*)(p.gon + h * 128 + (eh * 4 + 2) * 16 + fq * 4), *(const f32x4*)(p.gon + h * 128 + (eh * 4 + 3) * 16 + fq * 4) };
    for (int n = 0; n < 32; ++n) {
        const int itn = (b * 32 + n) * 16 + h, t = b * 2048 + n * 64 + tb * 16 + fr;
#pragma unroll
        for (int eb = 0; eb < 8; ++eb) { u32x2 o; o.x = cvt_pk_bf16(S[eb][0], S[eb][1]); o.y = cvt_pk_bf16(S[eb][2], S[eb][3]); *(LAS u32x2*)(ST + (eb * 16 + fr) * 136 + w * 16 + fq * 4) = o; }
        __syncthreads();
        bf16x8 Yq[4];
#pragma unroll
        for (int ks = 0; ks < 4; ++ks) Yq[ks] = *(const bf16x8*)(QT0 + (size_t)t * EA + h * 128 + ks * 32 + fq * 8);
        f32x4 o[4]; float ss = 0.f;
#pragma unroll
        for (int el = 0; el < 4; ++el) { f32x4 acc = *(const f32x4*)(OIN + (size_t)t * EA + h * 128 + (eh * 4 + el) * 16 + fq * 4);
#pragma unroll
            for (int ks = 0; ks < 4; ++ks) { const bf16x8 X = *(const LAS bf16x8*)(ST + ((eh * 4 + el) * 16 + fr) * 136 + ks * 32 + fq * 8); acc = MFMA16(X, Yq[ks], acc); }
            o[el] = acc; ss += (acc[0] * acc[0] + acc[1] * acc[1]) + (acc[2] * acc[2] + acc[3] * acc[3]); }
        ss += __shfl_xor(ss, 16); ss += __shfl_xor(ss, 32);
        if (fq == 0) ssq[eh * 64 + tb * 16 + fr] = ss;
        __syncthreads();
        const float rs = __builtin_amdgcn_rsqf((ssq[tb * 16 + fr] + ssq[64 + tb * 16 + fr]) * (1.0f / 128.0f) + EPS);
#pragma unroll
        for (int el = 0; el < 4; ++el) { const int col = h * 128 + (eh * 4 + el) * 16 + fq * 4; const u32x2 zb = *(const u32x2*)(H + (size_t)t * NC + COL_ZB + col);
            u32x2 y; y.x = cvt_pk_bf16(o[el][0] * rs * gon[el][0] * f_lo(zb.x), o[el][1] * rs * gon[el][1] * f_hi(zb.x)); y.y = cvt_pk_bf16(o[el][2] * rs * gon[el][2] * f_lo(zb.y), o[el][3] * rs * gon[el][3] * f_hi(zb.y));
            *(u32x2*)(YAB + (size_t)t * DM + 2048 + col) = y; }
        const f32x4 dec = *(const f32x4*)(DEC + (size_t)itn * 128 + w * 16 + fq * 4);
        const bf16x8 Xk0 = *(const bf16x8*)(KTT + ((size_t)itn * 128 + w * 16 + fr) * 64 + fq * 8), Xk1 = *(const bf16x8*)(KTT + ((size_t)itn * 128 + w * 16 + fr) * 64 + 32 + fq * 8);
#pragma unroll
        for (int eb = 0; eb < 8; ++eb) { const bf16_t* ip = ITT + ((size_t)itn * 128 + eb * 16 + fr) * 64 + fq * 8; const bf16x8 Y0 = *(const bf16x8*)ip, Y1 = *(const bf16x8*)(ip + 32);
            f32x4 a = S[eb] * dec; a = MFMA16(Xk0, Y0, a); a = MFMA16(Xk1, Y1, a); S[eb] = a; }
    }
    float* sp = p.out + O_SP + (size_t)bh * 128 * 128;
#pragma unroll
    for (int eb = 0; eb < 8; ++eb)
#pragma unroll
        for (int j = 0; j < 4; ++j) sp[(size_t)(w * 16 + fq * 4 + j) * 128 + eb * 16 + fr] = S[eb][j];
    __syncthreads();
}

__device__ __forceinline__ void hgrn_state_item(const Params& p, int it) {
    const int tid = threadIdx.x, lane = tid & 63, w = tid >> 6, fr = lane & 15, fq = lane >> 4;
    const int bh = it >> 1, eh = it & 1, b = bh >> 4, h = bh & 15;
    unsigned char* ws = p.ws;
    const bf16_t* KTT = (const bf16_t*)(ws + WS_KTT); const bf16_t* ITT = (const bf16_t*)(ws + WS_ITT); const float* DEC = (const float*)(ws + WS_DEC);
    bf16_t* SN = (bf16_t*)(ws + WS_SN);
    f32x4 S[4];
#pragma unroll
    for (int eb = 0; eb < 4; ++eb) S[eb] = (f32x4){0.f, 0.f, 0.f, 0.f};
    bf16x8 Xk0, Xk1, Y0[4], Y1[4]; f32x4 dec;
    {   const size_t itn = (size_t)(b * 32) * 16 + h;
        dec = *(const f32x4*)(DEC + itn * 128 + w * 16 + fq * 4);
        Xk0 = *(const bf16x8*)(KTT + (itn * 128 + w * 16 + fr) * 64 + fq * 8); Xk1 = *(const bf16x8*)(KTT + (itn * 128 + w * 16 + fr) * 64 + 32 + fq * 8);
#pragma unroll
        for (int eb = 0; eb < 4; ++eb) { const bf16_t* ip = ITT + (itn * 128 + (eh * 4 + eb) * 16 + fr) * 64 + fq * 8; Y0[eb] = *(const bf16x8*)ip; Y1[eb] = *(const bf16x8*)(ip + 32); } }
    for (int n = 0; n < 32; ++n) {
        const size_t itn = (size_t)(b * 32 + n) * 16 + h;
        const int nn = (n < 31) ? n + 1 : 31; const size_t itx = (size_t)(b * 32 + nn) * 16 + h;
        const f32x4 ndec = *(const f32x4*)(DEC + itx * 128 + w * 16 + fq * 4);
        const bf16x8 nXk0 = *(const bf16x8*)(KTT + (itx * 128 + w * 16 + fr) * 64 + fq * 8), nXk1 = *(const bf16x8*)(KTT + (itx * 128 + w * 16 + fr) * 64 + 32 + fq * 8);
        bf16x8 nY0[4], nY1[4];
#pragma unroll
        for (int eb = 0; eb < 4; ++eb) { const bf16_t* ip = ITT + (itx * 128 + (eh * 4 + eb) * 16 + fr) * 64 + fq * 8; nY0[eb] = *(const bf16x8*)ip; nY1[eb] = *(const bf16x8*)(ip + 32); }
#pragma unroll
        for (int eb = 0; eb < 4; ++eb) { u32x2 o; o.x = cvt_pk_bf16(S[eb][0], S[eb][1]); o.y = cvt_pk_bf16(S[eb][2], S[eb][3]); *(u32x2*)(SN + (itn * 128 + (eh * 4 + eb) * 16 + fr) * 128 + w * 16 + fq * 4) = o; }
#pragma unroll
        for (int eb = 0; eb < 4; ++eb) { f32x4 a = S[eb] * dec; a = MFMA16(Xk0, Y0[eb], a); a = MFMA16(Xk1, Y1[eb], a); S[eb] = a; }
        dec = ndec; Xk0 = nXk0; Xk1 = nXk1;
#pragma unroll
        for (int eb = 0; eb < 4; ++eb) { Y0[eb] = nY0[eb]; Y1[eb] = nY1[eb]; }
    }
    float* sp = p.out + O_SP + (size_t)bh * 128 * 128;
#pragma unroll
    for (int eb = 0; eb < 4; ++eb)
#pragma unroll
        for (int j = 0; j < 4; ++j) sp[(size_t)(w * 16 + fq * 4 + j) * 128 + (eh * 4 + eb) * 16 + fr] = S[eb][j];
}

__device__ __forceinline__ void hgrn_out_waveitem(const Params& p, int wi) {
    const int lane = threadIdx.x & 63, fr = lane & 15, fq = lane >> 4;
    const int tb = wi & 3, item = wi >> 2, h = item & 15, n = (item >> 4) & 31, b = item >> 9;
    unsigned char* ws = p.ws;
    const bf16_t* H = (const bf16_t*)(ws + WS_H); bf16_t* YAB = (bf16_t*)(ws + WS_YAB);
    const bf16_t* QT0 = (const bf16_t*)(ws + WS_QT0); const float* OIN = (const float*)(ws + WS_OIN); const bf16_t* SN = (const bf16_t*)(ws + WS_SN);
    const int t = b * 2048 + n * 64 + tb * 16 + fr;
    bf16x8 Yq[4];
#pragma unroll
    for (int ks = 0; ks < 4; ++ks) Yq[ks] = *(const bf16x8*)(QT0 + (size_t)t * EA + h * 128 + ks * 32 + fq * 8);
    f32x4 o[8]; float ss = 0.f;
#pragma unroll
    for (int eb = 0; eb < 8; ++eb) { f32x4 acc = *(const f32x4*)(OIN + (size_t)t * EA + h * 128 + eb * 16 + fq * 4);
        if (n > 0) {
#pragma unroll
            for (int ks = 0; ks < 4; ++ks) { const bf16x8 X = *(const bf16x8*)(SN + ((size_t)item * 128 + eb * 16 + fr) * 128 + ks * 32 + fq * 8); acc = MFMA16(X, Yq[ks], acc); } }
        o[eb] = acc; ss += (acc[0] * acc[0] + acc[1] * acc[1]) + (acc[2] * acc[2] + acc[3] * acc[3]); }
    ss += __shfl_xor(ss, 16); ss += __shfl_xor(ss, 32);
    const float rs = __builtin_amdgcn_rsqf(ss * (1.0f / 128.0f) + EPS);
#pragma unroll
    for (int eb = 0; eb < 8; ++eb) { const int col = h * 128 + eb * 16 + fq * 4; const u32x2 zb = *(const u32x2*)(H + (size_t)t * NC + COL_ZB + col); const f32x4 g = *(const f32x4*)(p.gon + col);
        u32x2 y; y.x = cvt_pk_bf16(o[eb][0] * rs * g[0] * f_lo(zb.x), o[eb][1] * rs * g[1] * f_hi(zb.x)); y.y = cvt_pk_bf16(o[eb][2] * rs * g[2] * f_lo(zb.y), o[eb][3] * rs * g[3] * f_hi(zb.y));
        *(u32x2*)(YAB + (size_t)t * DM + 2048 + col) = y; }
}

__device__ __forceinline__ void amix_item(const Params& p, LAS unsigned char* lds, int item) {
    const int tid = threadIdx.x, lane = tid & 63, w = tid >> 6, fr = lane & 15, fq = lane >> 4;
    const int g = item & 15, n = (item >> 4) & 15, b = item >> 8, t0 = b * 2048 + n * 128;
    unsigned char* ws = p.ws;
    const bf16_t* H = (const bf16_t*)(ws + WS_H); bf16_t* YAB = (bf16_t*)(ws + WS_YAB); const bf16_t* WSM = (const bf16_t*)(ws + WS_WSM); const float* LNP = (const float*)(ws + WS_LNP);
    LAS bf16_t* VT = (LAS bf16_t*)lds;
    LAS float* stats = (LAS float*)(lds + 128 * 136 * 2);
    if (tid < 128) { const f32x4* lp = (const f32x4*)(LNP + (size_t)(t0 + tid) * 64); float s1 = 0.f, s2 = 0.f;
#pragma unroll
        for (int i = 0; i < 16; ++i) { const f32x4 v = lp[i]; s1 += v[0] + v[2]; s2 += v[1] + v[3]; }
        const float mean = s1 * (1.0f / 2048.0f), var = s2 * (1.0f / 2048.0f) - mean * mean;
        stats[tid * 2] = mean; stats[tid * 2 + 1] = __builtin_amdgcn_rsqf(var + EPS); }
    __syncthreads();
#pragma unroll
    for (int i = 0; i < 4; ++i) { const int id = tid + 512 * i, r = id & 127, cc = id >> 7;
        const u32x4 v = *(const u32x4*)(H + (size_t)(t0 + r) * NC + COL_V + g * 128 + cc * 8);
        const float mean = stats[r * 2], rstd = stats[r * 2 + 1];
        const f32x4 g0 = *(const f32x4*)(p.lng + g * 128 + cc * 8), g1 = *(const f32x4*)(p.lng + g * 128 + cc * 8 + 4), b0 = *(const f32x4*)(p.lnb + g * 128 + cc * 8), b1 = *(const f32x4*)(p.lnb + g * 128 + cc * 8 + 4);
        float vn[8];
        vn[0] = (f_lo(v.x) - mean) * rstd * g0[0] + b0[0]; vn[1] = (f_hi(v.x) - mean) * rstd * g0[1] + b0[1]; vn[2] = (f_lo(v.y) - mean) * rstd * g0[2] + b0[2]; vn[3] = (f_hi(v.y) - mean) * rstd * g0[3] + b0[3];
        vn[4] = (f_lo(v.z) - mean) * rstd * g1[0] + b1[0]; vn[5] = (f_hi(v.z) - mean) * rstd * g1[1] + b1[1]; vn[6] = (f_lo(v.w) - mean) * rstd * g1[2] + b1[2]; vn[7] = (f_hi(v.w) - mean) * rstd * g1[3] + b1[3];
        if (n == 15) { float* vp = p.out + O_VP + ((size_t)(b * 128 + r)) * EA + g * 128 + cc * 8; *(f32x4*)vp = (f32x4){vn[0], vn[1], vn[2], vn[3]}; *(f32x4*)(vp + 4) = (f32x4){vn[4], vn[5], vn[6], vn[7]}; }
#pragma unroll
        for (int k = 0; k < 8; k += 2) { const unsigned pk = cvt_pk_bf16(vn[k], vn[k + 1]); VT[(cc * 8 + k) * 136 + r] = (bf16_t)(pk & 0xffffu); VT[(cc * 8 + k + 1) * 136 + r] = (bf16_t)(pk >> 16); }
    }
    __syncthreads();
    {
        const int tb = w, nks = (tb >> 1) + 1, t = t0 + tb * 16 + fr;
        bf16x8 Yw[4];
#pragma unroll
        for (int ks = 0; ks < 4; ++ks) { if (ks < nks) Yw[ks] = *(const bf16x8*)(WSM + ((size_t)(g * 128 + tb * 16 + fr)) * 128 + ks * 32 + fq * 8); else Yw[ks] = (bf16x8){0, 0, 0, 0, 0, 0, 0, 0}; }
        const float bs = p.bsp[g * 128 + tb * 16 + fr];
#pragma unroll
        for (int cb = 0; cb < 8; ++cb) { f32x4 acc = {0.f, 0.f, 0.f, 0.f};
#pragma unroll
            for (int ks = 0; ks < 4; ++ks) { if (ks < nks) { const bf16x8 X = *(const LAS bf16x8*)(VT + (cb * 16 + fr) * 136 + ks * 32 + fq * 8); acc = MFMA16(X, Yw[ks], acc); } }
            const int col = g * 128 + cb * 16 + fq * 4;
            const u32x2 u = *(const u32x2*)(H + (size_t)t * NC + COL_U + col), za = *(const u32x2*)(H + (size_t)t * NC + COL_ZA + col);
            u32x2 y; y.x = cvt_pk_bf16(f_lo(u.x) * (acc[0] + bs) * f_lo(za.x), f_hi(u.x) * (acc[1] + bs) * f_hi(za.x)); y.y = cvt_pk_bf16(f_lo(u.y) * (acc[2] + bs) * f_lo(za.y), f_hi(u.y) * (acc[3] + bs) * f_hi(za.y));
            *(u32x2*)(YAB + (size_t)t * DM + col) = y; }
    }
    __syncthreads();
}

__device__ __forceinline__ void hgrn_sample_item(const Params& p, LAS unsigned char* lds, int item) {
    const int tid = threadIdx.x, lane = tid & 63, w = tid >> 6;
    const int bs = item >> 4, h = item & 15, row = TP + bs, e4 = tid & 31, dg = tid >> 5;
    unsigned char* ws = p.ws;
    const bf16_t* H = (const bf16_t*)(ws + WS_H); bf16_t* YAB = (bf16_t*)(ws + WS_YAB);
    LAS float* red = (LAS float*)lds;
    LAS float* ssw = red + 16 * 128;
    const bf16_t* hr = H + (size_t)row * NC + h * 128;
    const u32x2 ii = *(const u32x2*)(hr + COL_I + e4 * 4);
    const f32x4 i4 = {f_lo(ii.x), f_hi(ii.x), f_lo(ii.y), f_hi(ii.y)};
    const u32x4 q8 = *(const u32x4*)(hr + COL_Q + dg * 8), l8 = *(const u32x4*)(hr + COL_F + dg * 8);
    const float qv[8] = {f_lo(q8.x), f_hi(q8.x), f_lo(q8.y), f_hi(q8.y), f_lo(q8.z), f_hi(q8.z), f_lo(q8.w), f_hi(q8.w)};
    const float lv[8] = {f_lo(l8.x), f_hi(l8.x), f_lo(l8.y), f_hi(l8.y), f_lo(l8.z), f_hi(l8.z), f_lo(l8.w), f_hi(l8.w)};
    const size_t sbase = ((size_t)item * 128 + dg * 8) * 128 + e4 * 4;
    const f32x4* s0 = (const f32x4*)(p.st0 + sbase); f32x4* s1 = (f32x4*)(p.out + O_SS + sbase);
    f32x4 po = {0.f, 0.f, 0.f, 0.f};
#pragma unroll
    for (int j = 0; j < 8; ++j) { const float f = __expf(lv[j]), k = 1.0f - f; const f32x4 sn = s0[j * 32] * f + i4 * k; s1[j * 32] = sn; po += sn * qv[j]; }
    *(LAS f32x4*)(red + dg * 128 + e4 * 4) = po;
    __syncthreads();
    float o = 0.f;
    if (tid < 128) {
#pragma unroll
        for (int k = 0; k < 16; ++k) o += red[k * 128 + tid];
        const float s = wave_sum(o * o);
        if (lane == 0) ssw[w] = s;
    }
    __syncthreads();
    if (tid < 128) { const float rs = __builtin_amdgcn_rsqf((ssw[0] + ssw[1]) * (1.0f / 128.0f) + EPS);
        const float y = o * rs * p.gon[h * 128 + tid] * bf2f(hr[COL_ZB + tid]);
        YAB[(size_t)row * DM + 2048 + h * 128 + tid] = (bf16_t)(cvt_pk_bf16(y, 0.f) & 0xffffu); }
    __syncthreads();
}

__device__ __forceinline__ void amix_sample_item(const Params& p, int bs) {
    const int tid = threadIdx.x, row = TP + bs, c0 = tid * 4, g = c0 >> 7;
    unsigned char* ws = p.ws;
    const bf16_t* H = (const bf16_t*)(ws + WS_H); bf16_t* YAB = (bf16_t*)(ws + WS_YAB); const float* LNP = (const float*)(ws + WS_LNPS);
    const f32x4 lv = *((const f32x4*)(LNP + (size_t)bs * 256) + (tid & 63));
    const float s1 = wave_sum(lv[0] + lv[2]), s2 = wave_sum(lv[1] + lv[3]);
    const float mean = s1 * (1.0f / 2048.0f), rstd = __builtin_amdgcn_rsqf(s2 * (1.0f / 2048.0f) - mean * mean + EPS);
    const bf16_t* hr = H + (size_t)row * NC + c0;
    const u32x2 v = *(const u32x2*)(hr + COL_V), u = *(const u32x2*)(hr + COL_U), za = *(const u32x2*)(hr + COL_ZA);
    const f32x4 lg = *(const f32x4*)(p.lng + c0), lb = *(const f32x4*)(p.lnb + c0);
    f32x4 vn; vn[0] = (f_lo(v.x) - mean) * rstd * lg[0] + lb[0]; vn[1] = (f_hi(v.x) - mean) * rstd * lg[1] + lb[1]; vn[2] = (f_lo(v.y) - mean) * rstd * lg[2] + lb[2]; vn[3] = (f_hi(v.y) - mean) * rstd * lg[3] + lb[3];
    *(f32x4*)(p.out + O_VS + (size_t)bs * EA + c0) = vn;
    const float w00 = p.wsp[(size_t)g * 128 * 128], b0 = p.bsp[g * 128];
    u32x2 y; y.x = cvt_pk_bf16(f_lo(u.x) * (w00 * vn[0] + b0) * f_lo(za.x), f_hi(u.x) * (w00 * vn[1] + b0) * f_hi(za.x)); y.y = cvt_pk_bf16(f_lo(u.y) * (w00 * vn[2] + b0) * f_lo(za.y), f_hi(u.y) * (w00 * vn[3] + b0) * f_hi(za.y));
    *(u32x2*)(YAB + (size_t)row * DM + c0) = y;
}

template <int MODE> __device__ __forceinline__ void skinny_gemm(const Params& p, LAS unsigned char* lds) {
    int tid0 = threadIdx.x; asm volatile("" : "+v"(tid0));
    const int tid = tid0, lane = tid & 63, w = tid >> 6, fr = lane & 15, fq = lane >> 4;
    unsigned char* ws = p.ws;
    const bf16_t* A = (const bf16_t*)(ws + (MODE == 1 ? WS_XN : MODE == 2 ? WS_YAB : WS_MRG)) + (size_t)TP * DM;
    const bf16_t* Bt = (const bf16_t*)(ws + (MODE == 1 ? WS_WTIN : MODE == 2 ? WS_WTAB : WS_WTO));
    bf16_t* H = (bf16_t*)(ws + WS_H);
    constexpr int NG = (MODE == 1 ? NC : DM) / 128, AP = 264;
    LAS bf16_t* As = (LAS bf16_t*)lds;
    const int sr = tid >> 5, sc = (tid & 31) * 8;
    const int wu = __builtin_amdgcn_readfirstlane(w);
    unsigned aoff[8];
#pragma unroll
    for (int i = 0; i < 8; ++i) aoff[i] = (unsigned)(((sr + 16 * i) * DM + sc) * 2);
    const unsigned boff = (unsigned)((fr * DM + fq * 8) * 2);
    for (int g = blockIdx.x; g < NG; g += gridDim.x) {
        const int n0 = g * 128 + wu * 16, col = n0 + 4 * fq;
        const char* ab = (const char*)A; const char* bb = (const char*)Bt + (size_t)n0 * DM * 2;
        f32x4 acc[8];
#pragma unroll
        for (int mb = 0; mb < 8; ++mb) acc[mb] = (f32x4){0.f, 0.f, 0.f, 0.f};
        u32x4 ar[8]; bf16x8 bc[8];
#pragma unroll
        for (int i = 0; i < 8; ++i) ar[i] = *(const u32x4*)(ab + aoff[i]);
#pragma unroll
        for (int ks = 0; ks < 8; ++ks) bc[ks] = *(const bf16x8*)(bb + boff + ks * 64);
#pragma unroll
        for (int i = 0; i < 8; ++i) *(LAS u32x4*)(As + (sr + 16 * i) * AP + sc) = ar[i];
        __syncthreads();
        for (int kc = 0; kc < 16; ++kc) {
            const int kn = (kc < 15) ? kc + 1 : 15;
#pragma unroll
            for (int i = 0; i < 8; ++i) ar[i] = *(const u32x4*)(ab + kn * 512 + aoff[i]);
#pragma unroll
            for (int ks = 0; ks < 8; ++ks) {
#pragma unroll
                for (int mb = 0; mb < 8; ++mb) { const bf16x8 Y = *(const LAS bf16x8*)(As + (mb * 16 + fr) * AP + ks * 32 + fq * 8); acc[mb] = MFMA16(bc[ks], Y, acc[mb]); }
                bc[ks] = *(const bf16x8*)(bb + kn * 512 + boff + ks * 64);
                __builtin_amdgcn_sched_barrier(0);
            }
            if (MODE == 2 && kc == 7) {
#pragma unroll
                for (int mb = 0; mb < 8; ++mb) { const int row = TP + mb * 16 + fr; const u32x2 ga = *(const u32x2*)(H + (size_t)row * NC + COL_GA + col), gb = *(const u32x2*)(H + (size_t)row * NC + COL_GB + col);
                    acc[mb][0] *= f_lo(ga.x) * __builtin_amdgcn_rcpf(f_lo(gb.x)); acc[mb][1] *= f_hi(ga.x) * __builtin_amdgcn_rcpf(f_hi(gb.x)); acc[mb][2] *= f_lo(ga.y) * __builtin_amdgcn_rcpf(f_lo(gb.y)); acc[mb][3] *= f_hi(ga.y) * __builtin_amdgcn_rcpf(f_hi(gb.y)); if (mb & 1) asm volatile("" ::: "memory"); }
            }
            __syncthreads();
#pragma unroll
            for (int i = 0; i < 8; ++i) *(LAS u32x4*)(As + (sr + 16 * i) * AP + sc) = ar[i];
            __syncthreads();
        }
        if (MODE == 1) {
            const int type = n0 < 2048 ? 0 : n0 < 4096 ? 1 : n0 < 8192 ? 2 : n0 < 10240 ? 3 : n0 < 12288 ? 4 : n0 < 14336 ? 2 : 5;
            float lb[4] = {0.f, 0.f, 0.f, 0.f};
            if (type == 3) { const f32x4 l0 = *(const f32x4*)(p.lbl + col - 8192), l1 = *(const f32x4*)(p.lbl + 2048 + col - 8192);
#pragma unroll
                for (int j = 0; j < 4; ++j) lb[j] = __builtin_amdgcn_rcpf(1.0f + __expf(l1[j] - l0[j])); }
            float* LNPS = (float*)(ws + WS_LNPS);
#pragma unroll
            for (int mb = 0; mb < 8; ++mb) { const int row = TP + mb * 16 + fr; float v[4]; float s1 = 0.f, s2 = 0.f;
#pragma unroll
                for (int j = 0; j < 4; ++j) { float x = acc[mb][j];
                    if (type <= 1) x = pg8::fgelu(x); else if (type == 2) x = pg8::fsilu(x); else if (type == 3) x = __logf(lb[j] + (1.0f - lb[j]) * pg8::fsigmoid(x)); else if (type == 5) x = pg8::fsigmoid(x);
                    v[j] = x; s1 += x; s2 += x * x; }
                u32x2 o; o.x = cvt_pk_bf16(v[0], v[1]); o.y = cvt_pk_bf16(v[2], v[3]); *(u32x2*)(H + (size_t)row * NC + col) = o;
                if (type == 1) { s1 += __shfl_xor(s1, 16); s1 += __shfl_xor(s1, 32); s2 += __shfl_xor(s2, 16); s2 += __shfl_xor(s2, 32);
                    if (fq == 0) { f32x2 q; q.x = s1; q.y = s2; *(f32x2*)(LNPS + (size_t)(row - TP) * 256 + ((n0 - 2048) >> 4) * 2) = q; } } }
        } else if (MODE == 2) {
            bf16_t* MRG = (bf16_t*)(ws + WS_MRG);
#pragma unroll
            for (int mb = 0; mb < 8; ++mb) { const int row = TP + mb * 16 + fr; const u32x2 gb = *(const u32x2*)(H + (size_t)row * NC + COL_GB + col);
                u32x2 o; o.x = cvt_pk_bf16(acc[mb][0] * f_lo(gb.x), acc[mb][1] * f_hi(gb.x)); o.y = cvt_pk_bf16(acc[mb][2] * f_lo(gb.y), acc[mb][3] * f_hi(gb.y)); *(u32x2*)(MRG + (size_t)row * DM + col) = o; }
        } else {
            bf16_t* Z = (bf16_t*)(ws + WS_Z); float* SSPS = (float*)(ws + WS_SSPS);
#pragma unroll
            for (int mb = 0; mb < 8; ++mb) { const int row = TP + mb * 16 + fr; const f32x4 v = acc[mb];
                u32x2 o; o.x = cvt_pk_bf16(v[0], v[1]); o.y = cvt_pk_bf16(v[2], v[3]); *(u32x2*)(Z + (size_t)row * DM + col) = o;
                float ss = (v[0] * v[0] + v[1] * v[1]) + (v[2] * v[2] + v[3] * v[3]); ss += __shfl_xor(ss, 16); ss += __shfl_xor(ss, 32);
                if (fq == 0) SSPS[(size_t)(row - TP) * 256 + (n0 >> 4)] = ss; }
        }
        __syncthreads();
    }
}

__device__ __forceinline__ void phase_final(const Params& p) {
    int tid_o = threadIdx.x; asm volatile("" : "+v"(tid_o));
    const int tid = tid_o, lane = tid & 63, wid = tid >> 6;
    const int gw = blockIdx.x * 8 + wid, NGW = gridDim.x * 8;
    const bf16_t* Z = (const bf16_t*)(p.ws + WS_Z); const float* SSP = (const float*)(p.ws + WS_SSP);
    for (int m = gw; m < MT; m += NGW) {
        float sq; if (m < TP) sq = SSP[(size_t)m * 64 + lane]; else { const f32x4 q = *((const f32x4*)((const float*)(p.ws + WS_SSPS) + (size_t)(m - TP) * 256) + lane); sq = (q[0] + q[1]) + (q[2] + q[3]); }
        const float rs = __builtin_amdgcn_rsqf(wave_sum(sq) * (1.0f / DM) + EPS);
        const float* xr = (m < TP) ? p.xp + (size_t)m * DM : p.xs + (size_t)(m - TP) * DM;
        float* yr = p.out + (size_t)m * DM;
        const f32x4* x4 = (const f32x4*)xr + lane; const f32x4* g4 = (const f32x4*)p.gpost + lane; const u32x2* z8 = (const u32x2*)(Z + (size_t)m * DM) + lane; f32x4* y4 = (f32x4*)yr + lane;
#pragma unroll
        for (int j = 0; j < 16; ++j) { const f32x4 x = x4[64 * j], g = g4[64 * j]; const u32x2 z = z8[64 * j];
            f32x4 y; y[0] = x[0] + f_lo(z.x) * rs * g[0]; y[1] = x[1] + f_hi(z.x) * rs * g[1]; y[2] = x[2] + f_lo(z.y) * rs * g[2]; y[3] = x[3] + f_hi(z.y) * rs * g[3]; y4[64 * j] = y; }
    }
}

constexpr int NPH = 8;
__global__ void __launch_bounds__(512, 2) mega(Params p) {
    extern __shared__ __attribute__((aligned(16))) unsigned char lds_raw[];
    LAS unsigned char* lds = (LAS unsigned char*)lds_raw;
    cg::grid_group grid = cg::this_grid();
    const int lo = p.lo, hi = p.hi, G = gridDim.x, bid = blockIdx.x;
    unsigned char* ws = p.ws;
    if (threadIdx.x < 64) ((LAS unsigned*)(lds + LDS_STAGE))[threadIdx.x] = 0u;
    __syncthreads();
    XcdBarrier bar = xcd_barrier_post((unsigned*)(ws + 16384), (volatile LAS unsigned*)(lds + LDS_STAGE));
    if (hi - lo > 1) grid.sync();
#define IN(k) (lo <= (k) && (k) < hi)
#define GSYNC() xcd_barrier(bar)
#define SEAM(k) do { if (IN(k) && IN((k) + 1)) GSYNC(); } while (0)
#define REPS(k) (1 + ((MK_REP >> (k)) & 1))
    for (int rep = 0; rep < REPS(0); ++rep) { if (rep) GSYNC(); if (IN(0)) phase0(p, lds); }
    SEAM(0);
    for (int rep = 0; rep < REPS(1); ++rep) { if (rep) GSYNC();
        if (IN(1)) {
            pg8::Gemm g{(const bf16_t*)(ws + WS_XN), (const bf16_t*)(ws + WS_WTIN), TP, NC, DM, DM / 64, 0}; pg8::StaticOrder S; S.init(TP, NC, G, bid);
            pg8::EpiAct E{(bf16_t*)(ws + WS_H), p.lbl, (float*)(ws + WS_LNP)};
            pg8::gemm_phase<pg8::EpiAct, pg8::StaticOrder, true, true>(lds, g, S, E);
            for (int r2 = 0; r2 < 1 + MK_SK; ++r2) skinny_gemm<1>(p, lds);
        } }
    SEAM(1);
    for (int rep = 0; rep < REPS(2); ++rep) { if (rep) GSYNC(); if (IN(2)) hgrn_prep_phase(p, lds); }
    SEAM(2);
    for (int rep = 0; rep < REPS(3); ++rep) { if (rep) GSYNC();
        if (IN(3)) {
            constexpr int T_SC = 128, T_AM = 512, T_HS = 256, T_AS = 8, T_TOT = T_SC + T_AM + T_HS + T_AS;
            unsigned* ctr = (unsigned*)ws + 64 * (1 + rep); LAS int* slot = (LAS int*)(lds + LDS_STAGE + 64);
            int it = bid;
            while (it < T_TOT) {
                int nxt = 0; if (threadIdx.x == 0) nxt = G + (int)atomicAdd(ctr, 1u);
                if (it < T_SC) { for (int r2 = 0; r2 < 1 + (MK_SUB & 1); ++r2) hgrn_state_item(p, it); }
                else if (it < T_SC + T_AM) { for (int k = 0; k < 2; ++k) amix_item(p, lds, (it - T_SC) * 2 + k); }
                else if (it < T_SC + T_AM + T_HS) { for (int k = 0; k < 8; ++k) hgrn_sample_item(p, lds, (it - T_SC - T_AM) * 8 + k); }
                else { for (int k = 0; k < 16; ++k) amix_sample_item(p, (it - T_SC - T_AM - T_HS) * 16 + k); }
                if (threadIdx.x == 0) *slot = nxt;
                __syncthreads(); it = *slot; __syncthreads();
            }
        } }
    SEAM(3);
    for (int rep = 0; rep < REPS(4); ++rep) { if (IN(4)) { for (int wi = bid * 8 + (int)(threadIdx.x >> 6); wi < 8192; wi += G * 8) hgrn_out_waveitem(p, wi); } }
    SEAM(4);
    for (int rep = 0; rep < REPS(5); ++rep) { if (rep) GSYNC();
        if (IN(5)) {
            pg8::Gemm g{(const bf16_t*)(ws + WS_YAB), (const bf16_t*)(ws + WS_WTAB), TP, DM, DM, 32, (size_t)2048 * 2}; pg8::PairOrder S; S.init(TP, DM, G, bid);
            pg8::EpiMerge E{(const bf16_t*)(ws + WS_H), (bf16_t*)(ws + WS_MRG)};
            pg8::gemm_phase<pg8::EpiMerge, pg8::PairOrder, true, true>(lds, g, S, E);
            for (int r2 = 0; r2 < 1 + MK_SK; ++r2) skinny_gemm<2>(p, lds);
        } }
    SEAM(5);
    for (int rep = 0; rep < REPS(6); ++rep) { if (rep) GSYNC();
        if (IN(6)) {
            pg8::Gemm g{(const bf16_t*)(ws + WS_MRG), (const bf16_t*)(ws + WS_WTO), TP, DM, DM, DM / 64, 0}; pg8::StaticOrder S; S.init(TP, DM, G, bid);
            pg8::EpiZ E{(bf16_t*)(ws + WS_Z), (float*)(ws + WS_SSP)};
            pg8::gemm_phase<pg8::EpiZ, pg8::StaticOrder, true, true>(lds, g, S, E);
            for (int r2 = 0; r2 < 1 + MK_SK; ++r2) skinny_gemm<3>(p, lds);
        } }
    SEAM(6);
    for (int rep = 0; rep < REPS(7); ++rep) { if (IN(7)) phase_final(p); }
    for (int x = 0; x < MK_XSYNC; ++x) GSYNC();
#undef IN
#undef SEAM
#undef GSYNC
#undef REPS
}

extern "C" void kernel_launch(void* const* d_in, const int* in_sizes, int n_in, void* d_out, int out_size, void* d_ws, size_t ws_size, hipStream_t stream) {
    static int grid = 0;
    if (grid == 0) {
        if (n_in != 15 || (size_t)out_size != O_END || ws_size < WS_END) { fprintf(stderr, "kernel_launch: unexpected shapes: n_in %d out %d ws %zu (need %zu)\n", n_in, out_size, ws_size, (size_t)WS_END); grid = -1; return; }
        int dev = 0, cus = 0, per_cu = 0;
        if (hipGetDevice(&dev) != hipSuccess || hipDeviceGetAttribute(&cus, hipDeviceAttributeMultiprocessorCount, dev) != hipSuccess) { fprintf(stderr, "kernel_launch: device query failed\n"); grid = -1; return; }
        if (hipFuncSetAttribute((const void*)mega, hipFuncAttributeMaxDynamicSharedMemorySize, LDS_BYTES) != hipSuccess) { fprintf(stderr, "kernel_launch: hipFuncSetAttribute failed\n"); grid = -1; return; }
        if (hipOccupancyMaxActiveBlocksPerMultiprocessor(&per_cu, (const void*)mega, 512, LDS_BYTES) != hipSuccess || per_cu < 1) { fprintf(stderr, "kernel_launch: occupancy query says %d\n", per_cu); per_cu = 1; }
        (void)hipGetLastError();
        grid = cus * per_cu;
        fprintf(stderr, "kernel_launch: grid %d (cus %d x %d)\n", grid, cus, per_cu);
    }
    if (grid < 0) return;
    (void)hipMemsetAsync(d_ws, 0, WS_CTLB, stream);
    Params p{};
    p.xp = (const float*)d_in[0]; p.xs = (const float*)d_in[1]; p.st0 = (const float*)d_in[2]; p.lbl = (const float*)d_in[3]; p.gpre = (const float*)d_in[4]; p.win = (const float*)d_in[5];
    p.lng = (const float*)d_in[6]; p.lnb = (const float*)d_in[7]; p.wsp = (const float*)d_in[8]; p.bsp = (const float*)d_in[9]; p.gon = (const float*)d_in[10]; p.wpa = (const float*)d_in[11];
    p.wpb = (const float*)d_in[12]; p.wo = (const float*)d_in[13]; p.gpost = (const float*)d_in[14];
    p.out = (float*)d_out; p.ws = (unsigned char*)d_ws;
#if MK_MULTI
    for (int ph = 0; ph < NPH; ++ph) { p.lo = ph; p.hi = ph + 1; hipLaunchKernelGGL(mega, dim3(grid), dim3(512), LDS_BYTES, stream, p); }
#else
    p.lo = 0; p.hi = NPH;
    void* args[] = {&p};
    hipError_t e = hipLaunchCooperativeKernel((const void*)mega, dim3(grid), dim3(512), args, LDS_BYTES, stream);
    if (e != hipSuccess) fprintf(stderr, "kernel_launch: cooperative launch failed: %s (grid %d)\n", hipGetErrorString(e), grid);
#endif
}
```

```cpp
#include <hip/hip_runtime.h>
#include <hip/hip_cooperative_groups.h>
#include <cstdio>
#include <cstdint>
namespace cg = cooperative_groups;

#ifndef MK_MULTI
#define MK_MULTI 0
#endif

#ifndef G1ORDER
#define G1ORDER StaticOrder
#endif
#ifndef MK_DELAY_US
#define MK_DELAY_US 0
#endif
#ifndef MK_REP
#define MK_REP 0
#endif
#ifndef MK_SUB
#define MK_SUB 0
#endif
#ifndef MK_XSYNC
#define MK_XSYNC 0
#endif
#ifndef MK_SK
#define MK_SK 0
#endif
#ifndef MK_DUMP
#define MK_DUMP 0
#endif

constexpr int DM = 4096, NC = 22528, TP = 8192, TS = 128, MT = TP + TS, MP = 8448, EA = 2048;
constexpr int COL_U = 0, COL_V = 2048, COL_ZA = 4096, COL_Q = 6144, COL_F = 8192, COL_I = 10240, COL_ZB = 12288, COL_GA = 14336, COL_GB = 18432;
constexpr float EPS = 1e-6f;
constexpr size_t WS_CTLB = 65536;
constexpr size_t WS_WTIN = WS_CTLB;
constexpr size_t WS_WTAB = WS_WTIN + (size_t)NC * DM * 2;
constexpr size_t WS_WTO  = WS_WTAB + (size_t)DM * DM * 2;
constexpr size_t WS_XN   = WS_WTO + (size_t)DM * DM * 2;
constexpr size_t WS_H    = WS_XN + (size_t)MP * DM * 2;
constexpr size_t WS_YAB  = WS_H + (size_t)MP * NC * 2;
constexpr size_t WS_MRG  = WS_YAB + (size_t)MP * DM * 2;
constexpr size_t WS_SN   = WS_MRG;
constexpr size_t WS_Z    = WS_MRG + (size_t)MP * DM * 2;
constexpr size_t WS_LNP  = WS_Z + (size_t)MP * DM * 2;
constexpr size_t WS_SSP  = WS_LNP + (size_t)MP * 64 * 4;
constexpr size_t WS_WSM  = WS_SSP + (size_t)MP * 64 * 4;
constexpr size_t WS_QT0  = WS_WSM + (size_t)16 * 128 * 128 * 2;
constexpr size_t WS_KTT  = WS_QT0 + (size_t)TP * EA * 2;
constexpr size_t WS_ITT  = WS_KTT + (size_t)TP * EA * 2;
constexpr size_t WS_OIN  = WS_ITT + (size_t)TP * EA * 2;
constexpr size_t WS_DEC  = WS_OIN + (size_t)TP * EA * 4;
constexpr size_t WS_LNPS = WS_DEC + (size_t)2048 * 128 * 4;
constexpr size_t WS_SSPS = WS_LNPS + (size_t)128 * 256 * 4;
constexpr size_t WS_END  = WS_SSPS + (size_t)128 * 256 * 4;
constexpr size_t O_YP = 0, O_YS = O_YP + (size_t)TP * DM, O_SP = O_YS + (size_t)TS * DM, O_SS = O_SP + (size_t)4 * 16 * 128 * 128,
                 O_VP = O_SS + (size_t)128 * 16 * 128 * 128, O_VS = O_VP + (size_t)4 * 128 * EA, O_END = O_VS + (size_t)128 * EA;
constexpr int LDS_STAGE = 128 * 1024, LDS_BYTES = LDS_STAGE + 256;

#define LAS __attribute__((address_space(3)))
#define XB_TMO      128
#define XB_XCNT(j)  (256  + 64 * (j))
#define XB_XSUB(j)  (1280 + 64 * (j))
#define XB_XGEN(j)  (2304 + 64 * (j))
#define XB_TOP      3328
#define XB_TOPGEN   3392
#define XCD_BAR_WORDS 3456
#define XB_SPIN_CAP (1u << 18)

__device__ __forceinline__ unsigned xb_ld(unsigned* p)              { return __hip_atomic_load(p, __ATOMIC_RELAXED, __HIP_MEMORY_SCOPE_AGENT); }
__device__ __forceinline__ unsigned xb_add(unsigned* p, unsigned v) { return __hip_atomic_fetch_add(p, v, __ATOMIC_RELAXED, __HIP_MEMORY_SCOPE_AGENT); }
__device__ __forceinline__ unsigned xb_xcc_id() { return (unsigned)__builtin_amdgcn_s_getreg((3 << 11) | 20) & 0xFu; }
#define XB_SPIN(cond, bar) do { unsigned _sp = 0; while (cond) { __builtin_amdgcn_s_sleep(1); \
    if ((++_sp & 255u) == 0u) { if (xb_ld(&(bar)[XB_TMO])) break; if (_sp > XB_SPIN_CAP) { atomicAdd(&(bar)[XB_TMO], 1u); break; } } } } while (0)

struct XcdBarrier {
    unsigned* bar; unsigned x;
    volatile LAS unsigned* st;
};

__device__ __forceinline__ XcdBarrier xcd_barrier_post(unsigned* bar, volatile LAS unsigned* st) {
    XcdBarrier b; b.bar = bar; b.x = xb_xcc_id(); b.st = st;
    if (threadIdx.x == 0) (void)xb_add(&bar[XB_XCNT(b.x)], 1u);
    return b;
}
__device__ __forceinline__ void xcd_barrier_complete(unsigned* bar, unsigned x, unsigned& nloc, unsigned& nx) {
    const unsigned G = gridDim.x * gridDim.y * gridDim.z;
    unsigned sum, cnt, mine, sp = 0u;
    for (;;) {
        sum = 0u; cnt = 0u; mine = 0u;
#pragma unroll
        for (unsigned j = 0; j < 16; ++j) { const unsigned c = xb_ld(&bar[XB_XCNT(j)]); sum += c; cnt += (c > 0u) ? 1u : 0u; mine = (j == x) ? c : mine; }
        if (sum == G) break;
        __builtin_amdgcn_s_sleep(1);
        if ((++sp & 255u) == 0u) { if (xb_ld(&bar[XB_TMO])) break; if (sp > XB_SPIN_CAP) { atomicAdd(&bar[XB_TMO], 1u); break; } }
    }
    nloc = mine > 0u ? mine : 1u; nx = cnt > 0u ? cnt : 1u;
}

__device__ __forceinline__ void xcd_barrier(const XcdBarrier& b) {
    asm volatile("s_waitcnt vmcnt(0)" ::: "memory");
    __syncthreads();
    if (threadIdx.x == 0) {
        unsigned* bar = b.bar;
        __builtin_amdgcn_s_waitcnt(0);
        unsigned nloc = b.st[0], nx = b.st[1];
        if (nloc == 0u) { xcd_barrier_complete(bar, b.x, nloc, nx); b.st[0] = nloc; b.st[1] = nx; }
        const unsigned old = xb_add(&bar[XB_XSUB(b.x)], 1u);
        const unsigned gen = old / nloc;
        if (old + 1u == (gen + 1u) * nloc) {
            __builtin_amdgcn_fence(__ATOMIC_RELEASE, "agent");
            asm volatile("s_waitcnt vmcnt(0)" ::: "memory");
            const unsigned og = xb_add(&bar[XB_TOP], 1u);
            const unsigned tg = og / nx;
            if (og + 1u == (tg + 1u) * nx) xb_add(&bar[XB_TOPGEN], 1u);
            else XB_SPIN(xb_ld(&bar[XB_TOPGEN]) == tg, bar);
            __builtin_amdgcn_fence(__ATOMIC_ACQUIRE, "agent");
            xb_add(&bar[XB_XGEN(b.x)], 1u);
            asm volatile("s_waitcnt vmcnt(0)" ::: "memory");
        } else {
            XB_SPIN(xb_ld(&bar[XB_XGEN(b.x)]) == gen, bar);
            __builtin_amdgcn_fence(__ATOMIC_ACQUIRE, "agent");
            asm volatile("s_waitcnt vmcnt(0)" ::: "memory");
        }
    }
    __syncthreads();
}

namespace pg8 {
#define PG8_LAS __attribute__((address_space(3)))
typedef unsigned short bf16_t;
typedef short bf16x8 __attribute__((ext_vector_type(8)));
typedef float f32x4 __attribute__((ext_vector_type(4)));
typedef unsigned u32x4 __attribute__((ext_vector_type(4)));
constexpr int BM = 256, BK = 64, HALF = 128, HTB = HALF * BK * 2  , STAGE_BYTES = 8 * HTB, NXCD = 8, WGM = 8;

__host__ __device__ __forceinline__ int lds_byte(int r, int c) { const int st = (r >> 4) * 2 + (c >> 5), rr = r & 15, cc = c & 31, ob = rr * 64 + cc * 2; return st * 1024 + (ob ^ (((ob >> 9) & 1) << 5)); }
__host__ __device__ __forceinline__ void stage_rc(int b, int& R, int& C) { const int st = b / 1024, sb = b % 1024, swz = sb ^ (((sb >> 9) & 1) << 5); R = (st >> 1) * 16 + swz / 64; C = (st & 1) * 32 + (swz % 64) / 2; }
__host__ __device__ __forceinline__ int perm32(int rho) { const int n = rho >> 4, i = rho & 15; return 8 * (i >> 2) + 4 * n + (i & 3); }

struct Unit { int pm, pn, kh; };
struct Gemm { const bf16_t* A; const bf16_t* Bt; int M, N, K, nt; size_t khoff; };

struct StaticOrder {
    int nM, nN, nwg, G, c;
    __host__ __device__ void init(int M, int N, int G_, int c_) { nM = M / BM; nN = N / BM; nwg = nM * nN; G = G_; c = c_; }
    __host__ __device__ bool next(int i, Unit& u) const {
        const long L = (long)i * G + c; if (L >= nwg) return false;
        int wgid = (int)L; { const int q = nwg / NXCD, r = nwg % NXCD, xcd = wgid % NXCD, off = wgid / NXCD; wgid = (xcd < r ? xcd * (q + 1) : r * (q + 1) + (xcd - r) * q) + off; }
        const int nig = WGM * nN, gid = wgid / nig, fm = gid * WGM, gsz = (nM - fm) < WGM ? (nM - fm) : WGM;
        u.pm = fm + ((wgid % nig) % gsz); u.pn = (wgid % nig) / gsz; u.kh = 0; return true;
    }
    __device__ __forceinline__ void a_ready(const Unit&) const {}
    __device__ __forceinline__ void done(const Unit&) const {}
};

typedef float f32x2 __attribute__((ext_vector_type(2)));
typedef __bf16 bf16x2_t __attribute__((ext_vector_type(2)));
__device__ __forceinline__ unsigned cvt_pk_bf16(float lo, float hi) { const f32x2 v = {lo, hi}; return __builtin_bit_cast(unsigned, __builtin_convertvector(v, bf16x2_t)); }
__device__ __forceinline__ float bf2f(unsigned short b) { return __builtin_bit_cast(float, (unsigned)b << 16); }
__device__ __forceinline__ float f_lo(unsigned w) { return __builtin_bit_cast(float, w << 16); }
__device__ __forceinline__ float f_hi(unsigned w) { return __builtin_bit_cast(float, w & 0xffff0000u); }
__device__ __forceinline__ float fsigmoid(float x) { return __builtin_amdgcn_rcpf(1.0f + __expf(-x)); }
__device__ __forceinline__ float fsilu(float x) { return x * fsigmoid(x); }
__device__ __forceinline__ float fgelu(float x) { return x * fsigmoid(1.5957691216057308f * (x + 0.044715f * x * x * x)); }

struct EpiAct {
    static constexpr bool PERM = true, AFTER_DRAIN = false, CARRY = false;
    bf16_t* H; const float* lbl; float* lnp;
    template <int ACT> __device__ __forceinline__ void run(const f32x4 (&acc)[2][2][4][2], const Unit& u, int wr, int wc, int fr, int fq) const {
        const int row0 = u.pm * BM + wr * 64 + fr, col0 = u.pn * BM + wc * 32 + 8 * fq;
        float lb[2][8];
        if (ACT == 3) {
#pragma unroll
            for (int bj = 0; bj < 2; ++bj) { const float* l0 = lbl + (col0 + bj * HALF - 8192); const f32x4 a0 = *(const f32x4*)l0, a1 = *(const f32x4*)(l0 + 4), b0 = *(const f32x4*)(l0 + 2048), b1 = *(const f32x4*)(l0 + 2052);
#pragma unroll
                for (int k = 0; k < 4; ++k) { lb[bj][k] = __builtin_amdgcn_rcpf(1.0f + __expf(b0[k] - a0[k])); lb[bj][4 + k] = __builtin_amdgcn_rcpf(1.0f + __expf(b1[k] - a1[k])); } }
        }
#pragma unroll
        for (int ai = 0; ai < 2; ++ai)
#pragma unroll
            for (int m = 0; m < 4; ++m) { const int row = row0 + ai * HALF + m * 16; bf16_t* rowp = H + (size_t)row * 22528 + col0; float s1 = 0.f, s2 = 0.f;
#pragma unroll
                for (int bj = 0; bj < 2; ++bj) { float v[8];
#pragma unroll
                    for (int k = 0; k < 4; ++k) { v[k] = acc[ai][bj][m][0][k]; v[4 + k] = acc[ai][bj][m][1][k]; }
#pragma unroll
                    for (int k = 0; k < 8; ++k) {
                        if (ACT == 0 || ACT == 1) v[k] = fgelu(v[k]);
                        if (ACT == 2) v[k] = fsilu(v[k]);
                        if (ACT == 3) v[k] = __logf(lb[bj][k] + (1.0f - lb[bj][k]) * fsigmoid(v[k]));
                        if (ACT == 5) v[k] = fsigmoid(v[k]);
                        if (ACT == 1) { s1 += v[k]; s2 += v[k] * v[k]; }
                    }
                    u32x4 w; w.x = cvt_pk_bf16(v[0], v[1]); w.y = cvt_pk_bf16(v[2], v[3]); w.z = cvt_pk_bf16(v[4], v[5]); w.w = cvt_pk_bf16(v[6], v[7]);
                    *(u32x4*)(rowp + bj * HALF) = w; }
                if (ACT == 1) { s1 += __shfl_xor(s1, 16); s1 += __shfl_xor(s1, 32); s2 += __shfl_xor(s2, 16); s2 += __shfl_xor(s2, 32);
                    if (fq == 0) { f32x2 o; o.x = s1; o.y = s2; *(f32x2*)(lnp + (size_t)row * 64 + ((u.pn - 8) * 4 + wc) * 2) = o; } }
            }
    }
    __device__ __forceinline__ void operator()(const f32x4 (&acc)[2][2][4][2], const Unit& u, int wr, int wc, int fr, int fq) const {
        const int pn = u.pn;
        if (pn < 8) run<0>(acc, u, wr, wc, fr, fq);
        else if (pn < 16) run<1>(acc, u, wr, wc, fr, fq);
        else if (pn < 32) run<2>(acc, u, wr, wc, fr, fq);
        else if (pn < 40) run<3>(acc, u, wr, wc, fr, fq);
        else if (pn < 48) run<4>(acc, u, wr, wc, fr, fq);
        else if (pn < 56) run<2>(acc, u, wr, wc, fr, fq);
        else run<5>(acc, u, wr, wc, fr, fq);
    }
};

struct EpiMerge {
    static constexpr bool PERM = true, AFTER_DRAIN = false, CARRY = true;
    const bf16_t* H; bf16_t* O;
    __device__ __forceinline__ void mid(f32x4 (&acc)[2][2][4][2], const Unit& u, int wr, int wc, int fr, int fq) const {
        const int row0 = u.pm * BM + wr * 64 + fr, col0 = u.pn * BM + wc * 32 + 8 * fq;
#pragma unroll
        for (int ai = 0; ai < 2; ++ai)
#pragma unroll
            for (int m = 0; m < 4; ++m) { const bf16_t* gp = H + (size_t)(row0 + ai * HALF + m * 16) * 22528 + 14336 + col0;
#pragma unroll
                for (int bj = 0; bj < 2; ++bj) { const u32x4 a = *(const u32x4*)(gp + bj * HALF), b = *(const u32x4*)(gp + 4096 + bj * HALF);
                    f32x4 r0, r1;
                    r0[0] = f_lo(a.x) * __builtin_amdgcn_rcpf(f_lo(b.x)); r0[1] = f_hi(a.x) * __builtin_amdgcn_rcpf(f_hi(b.x)); r0[2] = f_lo(a.y) * __builtin_amdgcn_rcpf(f_lo(b.y)); r0[3] = f_hi(a.y) * __builtin_amdgcn_rcpf(f_hi(b.y));
                    r1[0] = f_lo(a.z) * __builtin_amdgcn_rcpf(f_lo(b.z)); r1[1] = f_hi(a.z) * __builtin_amdgcn_rcpf(f_hi(b.z)); r1[2] = f_lo(a.w) * __builtin_amdgcn_rcpf(f_lo(b.w)); r1[3] = f_hi(a.w) * __builtin_amdgcn_rcpf(f_hi(b.w));
                    acc[ai][bj][m][0] *= r0; acc[ai][bj][m][1] *= r1; }
                if (m & 1) asm volatile("" ::: "memory"); }
    }
    __device__ __forceinline__ void operator()(f32x4 (&acc)[2][2][4][2], const Unit& u, int wr, int wc, int fr, int fq) const {
        if (u.kh == 0) { mid(acc, u, wr, wc, fr, fq); return; }
        const int row0 = u.pm * BM + wr * 64 + fr, col0 = u.pn * BM + wc * 32 + 8 * fq;
#pragma unroll
        for (int ai = 0; ai < 2; ++ai)
#pragma unroll
            for (int m = 0; m < 4; ++m) { const int row = row0 + ai * HALF + m * 16; const bf16_t* gp = H + (size_t)row * 22528 + 18432 + col0; bf16_t* rowp = O + (size_t)row * 4096 + col0;
#pragma unroll
                for (int bj = 0; bj < 2; ++bj) { const u32x4 b = *(const u32x4*)(gp + bj * HALF); const f32x4 v0 = acc[ai][bj][m][0], v1 = acc[ai][bj][m][1];
                    u32x4 w; w.x = cvt_pk_bf16(v0[0] * f_lo(b.x), v0[1] * f_hi(b.x)); w.y = cvt_pk_bf16(v0[2] * f_lo(b.y), v0[3] * f_hi(b.y));
                    w.z = cvt_pk_bf16(v1[0] * f_lo(b.z), v1[1] * f_hi(b.z)); w.w = cvt_pk_bf16(v1[2] * f_lo(b.w), v1[3] * f_hi(b.w));
                    *(u32x4*)(rowp + bj * HALF) = w; }
                if (m & 1) asm volatile("" ::: "memory"); }
    }
};

struct EpiZ {
    static constexpr bool PERM = true, AFTER_DRAIN = false, CARRY = false;
    bf16_t* Z; float* ssp;
    __device__ __forceinline__ void operator()(const f32x4 (&acc)[2][2][4][2], const Unit& u, int wr, int wc, int fr, int fq) const {
        const int row0 = u.pm * BM + wr * 64 + fr, col0 = u.pn * BM + wc * 32 + 8 * fq;
#pragma unroll
        for (int ai = 0; ai < 2; ++ai)
#pragma unroll
            for (int m = 0; m < 4; ++m) { const int row = row0 + ai * HALF + m * 16; bf16_t* rowp = Z + (size_t)row * 4096 + col0; float ss = 0.f;
#pragma unroll
                for (int bj = 0; bj < 2; ++bj) { const f32x4 v0 = acc[ai][bj][m][0], v1 = acc[ai][bj][m][1];
                    ss += (v0[0] * v0[0] + v0[1] * v0[1]) + (v0[2] * v0[2] + v0[3] * v0[3]) + (v1[0] * v1[0] + v1[1] * v1[1]) + (v1[2] * v1[2] + v1[3] * v1[3]);
                    u32x4 w; w.x = cvt_pk_bf16(v0[0], v0[1]); w.y = cvt_pk_bf16(v0[2], v0[3]); w.z = cvt_pk_bf16(v1[0], v1[1]); w.w = cvt_pk_bf16(v1[2], v1[3]);
                    *(u32x4*)(rowp + bj * HALF) = w; }
                ss += __shfl_xor(ss, 16); ss += __shfl_xor(ss, 32);
                if (fq == 0) ssp[(size_t)row * 64 + u.pn * 4 + wc] = ss; }
    }
};

struct PairOrder : StaticOrder {
    __device__ bool next(int i, Unit& u) const { if (!StaticOrder::next(i >> 1, u)) return false; u.kh = i & 1; return true; }
};

struct RevOrder : StaticOrder {
    __device__ bool next(int i, Unit& u) const { if (!StaticOrder::next(i, u)) return false; u.pn = nN - 1 - u.pn; return true; }
};

template <class Epi, class Sched, bool ALIGN_EPI = false, bool SP2 = false>
__device__ __forceinline__ void gemm_phase(PG8_LAS unsigned char* lds, const Gemm g, const Sched& S, const Epi& E) {
    int tid_o = threadIdx.x; asm volatile("" : "+v"(tid_o));
    const int tid = tid_o, wid = __builtin_amdgcn_readfirstlane(tid >> 6), lane = tid & 63, wr = wid >> 2, wc = wid & 3, fr = lane & 15, fq = lane >> 4;
    const int K = g.K, nt = g.nt;
    unsigned voffA[2], voffB[2];
#pragma unroll
    for (int i = 0; i < 2; ++i) { int R, C; stage_rc(tid * 16 + i * 8192, R, C); const int Rb = Epi::PERM ? ((R & ~31) + perm32(R & 31)) : R;
        voffA[i] = (unsigned)(R * K + C) * 2u; voffB[i] = (unsigned)(Rb * K + C) * 2u; }
    const size_t kstep = (size_t)(BK * 2);
    const size_t hstep = (size_t)HALF * K * 2;
    const size_t tstep = 2 * hstep;
    const unsigned ldsw = (unsigned)wid * 1024u;
    const int aoff = lds_byte(wr * 64 + fr, fq * 8), boff = lds_byte(wc * 32 + fr, fq * 8);
#define PG8_SA(b, h) (((b) * 2 + (h)) * HTB)
#define PG8_SB(b, h) ((4 + (b) * 2 + (h)) * HTB)
#define PG8_STAGE(bufoff, gbase, voff) do { _Pragma("unroll") for (int _i = 0; _i < 2; ++_i) \
        __builtin_amdgcn_global_load_lds((const unsigned*)((const char*)(gbase) + (voff)[_i]), (PG8_LAS unsigned*)(lds + (bufoff) + ldsw + _i * 8192), 16, 0, 0); } while (0)
#define PG8_LDA(dst, b, h) do { _Pragma("unroll") for (int m = 0; m < 4; ++m) _Pragma("unroll") for (int k = 0; k < 2; ++k) dst[m][k] = *(const PG8_LAS bf16x8*)(lds + PG8_SA(b, h) + aoff + m * 2048 + k * 1024); } while (0)
#define PG8_LDB(dst, b, h) do { _Pragma("unroll") for (int n = 0; n < 2; ++n) _Pragma("unroll") for (int k = 0; k < 2; ++k) dst[n][k] = *(const PG8_LAS bf16x8*)(lds + PG8_SB(b, h) + boff + n * 2048 + k * 1024); } while (0)
#define PG8_MMA(ai, bj, At, Bt) do { __builtin_amdgcn_s_setprio(1); _Pragma("unroll") for (int m = 0; m < 4; ++m) _Pragma("unroll") for (int n = 0; n < 2; ++n) _Pragma("unroll") for (int k = 0; k < 2; ++k) \
        acc[ai][bj][m][n] = __builtin_amdgcn_mfma_f32_16x16x32_bf16(Bt[n][k], At[m][k], acc[ai][bj][m][n], 0, 0, 0); __builtin_amdgcn_s_setprio(0); } while (0)
#define PG8_WAIT_V(n) asm volatile("s_waitcnt vmcnt(" #n ")" ::: "memory")
#define PG8_WAIT_L(n) asm volatile("s_waitcnt lgkmcnt(" #n ")" ::: "memory")
#define PG8_BAR __builtin_amdgcn_s_barrier()
#define PG8_SCHED __builtin_amdgcn_sched_barrier(0)
    Unit cur, nxt; int ui = 0;
    if (!S.next(0, cur)) return;
    f32x4 acc[2][2][4][2];
#pragma unroll
    for (int a = 0; a < 2; ++a)
#pragma unroll
        for (int b = 0; b < 2; ++b)
#pragma unroll
            for (int m = 0; m < 4; ++m)
#pragma unroll
                for (int n = 0; n < 2; ++n) acc[a][b][m][n] = (f32x4){0.f, 0.f, 0.f, 0.f};
    bf16x8 At[4][2], B0[2][2], B1[2][2];
    const char* cA = (const char*)g.A + (size_t)cur.pm * tstep + (size_t)cur.kh * g.khoff; const char* cB = (const char*)g.Bt + (size_t)cur.pn * tstep + (size_t)cur.kh * g.khoff;
    S.a_ready(cur);
    if constexpr (SP2) {
        PG8_STAGE(PG8_SB(0, 0), cB, voffB); PG8_STAGE(PG8_SB(0, 1), cB + hstep, voffB); PG8_STAGE(PG8_SA(0, 0), cA, voffA); PG8_STAGE(PG8_SA(0, 1), cA + hstep, voffA);
        if (wr == 1) PG8_BAR;
        PG8_WAIT_V(2); PG8_BAR;
        PG8_STAGE(PG8_SB(1, 0), cB + kstep, voffB); PG8_STAGE(PG8_SA(1, 0), cA + kstep, voffA); PG8_STAGE(PG8_SB(1, 1), cB + hstep + kstep, voffB);
        PG8_WAIT_V(6); PG8_BAR;
    } else {
        PG8_STAGE(PG8_SB(0, 0), cB, voffB); PG8_STAGE(PG8_SA(0, 0), cA, voffA); PG8_STAGE(PG8_SB(0, 1), cB + hstep, voffB); PG8_STAGE(PG8_SA(0, 1), cA + hstep, voffA);
        if (wr == 1) PG8_BAR;
        PG8_WAIT_V(4); PG8_BAR;
        PG8_STAGE(PG8_SB(1, 0), cB + kstep, voffB); PG8_STAGE(PG8_SA(1, 0), cA + kstep, voffA); PG8_STAGE(PG8_SB(1, 1), cB + hstep + kstep, voffB);
        PG8_WAIT_V(6); PG8_BAR;
    }
    for (;;) {
        const bool has_next = S.next(ui + 1, nxt);
        const char* nA = has_next ? (const char*)g.A + (size_t)nxt.pm * tstep + (size_t)nxt.kh * g.khoff : cA; const char* nB = has_next ? (const char*)g.Bt + (size_t)nxt.pn * tstep + (size_t)nxt.kh * g.khoff : cB;
        for (int t = 0; t < nt; t += 2) {
            const bool last = (t == nt - 2);
            const char* a1 = cA + (size_t)(t + 1) * kstep;
            const char* a2 = last ? nA : cA + (size_t)(t + 2) * kstep; const char* b2 = last ? nB : cB + (size_t)(t + 2) * kstep;
            const char* a3 = a2 + kstep; const char* b3 = b2 + kstep;
            if (last && has_next) S.a_ready(nxt);
            if constexpr (SP2) {
            PG8_LDB(B0, 0, 0); PG8_LDB(B1, 0, 1); PG8_SCHED; PG8_LDA(At, 0, 0); PG8_STAGE(PG8_SA(1, 1), a1 + hstep, voffA);
            PG8_WAIT_V(8); PG8_WAIT_L(0); PG8_BAR; PG8_MMA(0, 0, At, B0); PG8_MMA(0, 1, At, B1); PG8_BAR; PG8_SCHED;
            PG8_LDA(At, 0, 1); PG8_STAGE(PG8_SB(0, 0), b2, voffB); PG8_STAGE(PG8_SB(0, 1), b2 + hstep, voffB); PG8_STAGE(PG8_SA(0, 0), a2, voffA);
            PG8_WAIT_V(8); PG8_WAIT_L(0); PG8_BAR; PG8_MMA(1, 0, At, B0); PG8_MMA(1, 1, At, B1); PG8_BAR; PG8_SCHED;
            PG8_LDB(B0, 1, 0); PG8_LDB(B1, 1, 1); PG8_SCHED; PG8_LDA(At, 1, 0); PG8_STAGE(PG8_SA(0, 1), a2 + hstep, voffA);
            PG8_WAIT_V(8); PG8_WAIT_L(0); PG8_BAR; PG8_MMA(0, 0, At, B0); PG8_MMA(0, 1, At, B1); PG8_BAR; PG8_SCHED;
            PG8_LDA(At, 1, 1); PG8_STAGE(PG8_SB(1, 0), b3, voffB); PG8_STAGE(PG8_SB(1, 1), b3 + hstep, voffB); PG8_STAGE(PG8_SA(1, 0), a3, voffA);
            PG8_WAIT_V(8); PG8_WAIT_L(0); PG8_BAR; PG8_MMA(1, 0, At, B0); PG8_MMA(1, 1, At, B1); PG8_BAR; PG8_SCHED;
            } else {
            PG8_LDB(B0, 0, 0); PG8_SCHED; PG8_LDA(At, 0, 0); PG8_STAGE(PG8_SA(1, 1), a1 + hstep, voffA);
            PG8_WAIT_L(8); PG8_BAR; PG8_WAIT_L(0); PG8_MMA(0, 0, At, B0); PG8_BAR; PG8_SCHED;
            PG8_LDB(B1, 0, 1); PG8_STAGE(PG8_SB(0, 0), b2, voffB);
            PG8_BAR; PG8_WAIT_L(0); PG8_MMA(0, 1, At, B1); PG8_BAR;
            PG8_LDA(At, 0, 1); PG8_STAGE(PG8_SA(0, 0), a2, voffA);
            PG8_BAR; PG8_WAIT_L(0); PG8_MMA(1, 0, At, B0); PG8_BAR; PG8_SCHED;
            PG8_STAGE(PG8_SB(0, 1), b2 + hstep, voffB);
            PG8_WAIT_V(6); PG8_BAR; PG8_MMA(1, 1, At, B1); PG8_BAR;
            PG8_LDB(B0, 1, 0); PG8_SCHED; PG8_LDA(At, 1, 0); PG8_STAGE(PG8_SA(0, 1), a2 + hstep, voffA);
            PG8_WAIT_L(8); PG8_BAR; PG8_WAIT_L(0); PG8_MMA(0, 0, At, B0); PG8_BAR; PG8_SCHED;
            PG8_LDB(B1, 1, 1); PG8_STAGE(PG8_SB(1, 0), b3, voffB);
            PG8_BAR; PG8_WAIT_L(0); PG8_MMA(0, 1, At, B1); PG8_BAR;
            PG8_LDA(At, 1, 1); PG8_STAGE(PG8_SA(1, 0), a3, voffA);
            PG8_BAR; PG8_WAIT_L(0); PG8_MMA(1, 0, At, B0); PG8_BAR; PG8_SCHED;
            PG8_STAGE(PG8_SB(1, 1), b3 + hstep, voffB);
            PG8_WAIT_V(6); PG8_BAR; PG8_MMA(1, 1, At, B1); PG8_BAR;
            }
        }
        if constexpr (ALIGN_EPI) { if (wr == 0) PG8_BAR; }
        if constexpr (!Epi::AFTER_DRAIN) { E(acc, cur, wr, wc, fr, fq); S.done(cur); }
        if (!has_next) break;
        if (!(Epi::CARRY && cur.kh == 0)) {
#pragma unroll
        for (int a = 0; a < 2; ++a)
#pragma unroll
            for (int b = 0; b < 2; ++b)
#pragma unroll
                for (int m = 0; m < 4; ++m)
#pragma unroll
                    for (int n = 0; n < 2; ++n) acc[a][b][m][n] = (f32x4){0.f, 0.f, 0.f, 0.f};
        }
        cur = nxt; cA = nA; cB = nB; ++ui;
        if constexpr (ALIGN_EPI) { if (wr == 1) PG8_BAR; }
    }
    PG8_WAIT_V(0);
    if constexpr (!ALIGN_EPI) { if (wr == 0) PG8_BAR; }
    PG8_BAR;
    if constexpr (Epi::AFTER_DRAIN) { E.fused(acc, cur, wr, wc, fr, fq, lds, wid, lane); S.done(cur); }
#undef PG8_SA
#undef PG8_SB
#undef PG8_STAGE
#undef PG8_LDA
#undef PG8_LDB
#undef PG8_MMA
#undef PG8_WAIT_V
#undef PG8_WAIT_L
#undef PG8_BAR
#undef PG8_SCHED
}
}

using pg8::bf16_t; using pg8::bf16x8; using pg8::f32x4; using pg8::u32x4; using pg8::f32x2; using pg8::cvt_pk_bf16; using pg8::bf2f; using pg8::f_lo; using pg8::f_hi;
typedef unsigned u32x2 __attribute__((ext_vector_type(2)));
#define LDS_WAIT() asm volatile("s_waitcnt lgkmcnt(0)" ::: "memory")
#define MFMA16(X, Y, C) __builtin_amdgcn_mfma_f32_16x16x32_bf16((X), (Y), (C), 0, 0, 0)

struct Params {
    const float *xp, *xs, *st0, *lbl, *gpre, *win, *lng, *lnb, *wsp, *bsp, *gon, *wpa, *wpb, *wo, *gpost;
    float* out; unsigned char* ws; int lo, hi;
};

__device__ __forceinline__ float wave_sum(float v) {
#pragma unroll
    for (int o = 1; o < 64; o <<= 1) v += __shfl_xor(v, o);
    return v;
}

__device__ __forceinline__ void p0_transpose_item(const float* W, int N, bf16_t* WT, int ldd, int koff, LAS float* scr, int kb, int nb, int lane) {
    const int k0 = 64 * kb, n0 = 32 * nb;
    float wv[32];
#pragma unroll
    for (int i = 0; i < 32; ++i) wv[i] = W[(size_t)(k0 + 2 * i + (lane >> 5)) * N + n0 + (lane & 31)];
#pragma unroll
    for (int i = 0; i < 32; ++i) scr[(2 * i + (lane >> 5)) * 33 + (lane & 31)] = wv[i];
    LDS_WAIT(); asm volatile("" ::: "memory");
    const int c = lane & 7;
#pragma unroll
    for (int j = 0; j < 4; ++j) { const int n = (lane >> 3) + 8 * j; const LAS float* s = scr + (8 * c) * 33 + n;
        u32x4 o; o.x = cvt_pk_bf16(s[0 * 33], s[1 * 33]); o.y = cvt_pk_bf16(s[2 * 33], s[3 * 33]); o.z = cvt_pk_bf16(s[4 * 33], s[5 * 33]); o.w = cvt_pk_bf16(s[6 * 33], s[7 * 33]);
        *(u32x4*)(WT + (size_t)(n0 + n) * ldd + koff + k0 + 8 * c) = o; }
    LDS_WAIT(); asm volatile("" ::: "memory");
}

__device__ __forceinline__ void phase0(const Params& p, LAS unsigned char* lds) {
    const int tid = threadIdx.x, lane = tid & 63, wid = tid >> 6;
    const int gw = blockIdx.x * 8 + wid, NGW = gridDim.x * 8;
    unsigned char* ws = p.ws;
    bf16_t* WTIN = (bf16_t*)(ws + WS_WTIN); bf16_t* WTAB = (bf16_t*)(ws + WS_WTAB); bf16_t* WTO = (bf16_t*)(ws + WS_WTO);
    bf16_t* XN = (bf16_t*)(ws + WS_XN); bf16_t* YAB = (bf16_t*)(ws + WS_YAB); bf16_t* WSM = (bf16_t*)(ws + WS_WSM);
    LAS float* scr = (LAS float*)(lds + wid * 8448);
    constexpr int I_IN = 64 * 704, I_PA = 32 * 128, I_O = 64 * 128, NIT = I_IN + 2 * I_PA + I_O;
    for (int it = gw; it < NIT; it += NGW) {
        int r = it;
        if (r < I_IN) { p0_transpose_item(p.win, NC, WTIN, DM, 0, scr, r / 704, r % 704, lane); continue; } r -= I_IN;
        if (r < I_PA) { p0_transpose_item(p.wpa, DM, WTAB, DM, 0, scr, r / 128, r % 128, lane); continue; } r -= I_PA;
        if (r < I_PA) { p0_transpose_item(p.wpb, DM, WTAB, DM, 2048, scr, r / 128, r % 128, lane); continue; } r -= I_PA;
        p0_transpose_item(p.wo, DM, WTO, DM, 0, scr, r / 128, r % 128, lane);
    }
    for (int m = gw; m < MP; m += NGW) {
        u32x2* o8 = (u32x2*)(XN + (size_t)m * DM) + lane;
        if (m < MT) {
            const float* xr = (m < TP) ? p.xp + (size_t)m * DM : p.xs + (size_t)(m - TP) * DM;
            const f32x4* x4 = (const f32x4*)xr + lane; const f32x4* g4 = (const f32x4*)p.gpre + lane;
            f32x4 v[16]; float s = 0.f;
#pragma unroll
            for (int j = 0; j < 16; ++j) { v[j] = x4[64 * j]; s += (v[j][0] * v[j][0] + v[j][1] * v[j][1]) + (v[j][2] * v[j][2] + v[j][3] * v[j][3]); }
            const float rs = __builtin_amdgcn_rsqf(wave_sum(s) * (1.0f / DM) + EPS);
#pragma unroll
            for (int j = 0; j < 16; ++j) { const f32x4 g = g4[64 * j]; u32x2 w; w.x = cvt_pk_bf16(v[j][0] * rs * g[0], v[j][1] * rs * g[1]); w.y = cvt_pk_bf16(v[j][2] * rs * g[2], v[j][3] * rs * g[3]); o8[64 * j] = w; }
        } else {
            u32x2* y8 = (u32x2*)(YAB + (size_t)m * DM) + lane; u32x2 z; z.x = 0u; z.y = 0u;
#pragma unroll
            for (int j = 0; j < 16; ++j) { o8[64 * j] = z; y8[64 * j] = z; }
        }
    }
    for (int i = blockIdx.x * 512 + tid; i < 16 * 128 * 128; i += gridDim.x * 512) { const int s = i & 127, t = (i >> 7) & 127; WSM[i] = (s <= t) ? (bf16_t)(cvt_pk_bf16(p.wsp[i], 0.f) & 0xffffu) : (bf16_t)0; }
}

__device__ __forceinline__ void hgrn_prep_phase(const Params& p, LAS unsigned char* lds) {
    int tid_o = threadIdx.x; asm volatile("" : "+v"(tid_o));
    const int tid = tid_o, lane = tid & 63, w = tid >> 6, fr = lane & 15, fq = lane >> 4, d = tid & 127, tq = tid >> 7;
    const int pr = tid >> 4, pc = (tid & 15) * 8;
    u32x4 R[6];
#define PREP_LOAD(item_) do { const int h_ = (item_) & 15, n_ = ((item_) >> 4) & 31, b_ = (item_) >> 9; const bf16_t* g_ = (const bf16_t*)(p.ws + WS_H) + (size_t)(b_ * 2048 + n_ * 64 + pr) * NC + COL_Q + h_ * 128 + pc; \
        R[0] = *(const u32x4*)g_; R[1] = *(const u32x4*)(g_ + (size_t)32 * NC); R[2] = *(const u32x4*)(g_ + (COL_F - COL_Q)); R[3] = *(const u32x4*)(g_ + (size_t)32 * NC + (COL_F - COL_Q)); \
        R[4] = *(const u32x4*)(g_ + (COL_I - COL_Q)); R[5] = *(const u32x4*)(g_ + (size_t)32 * NC + (COL_I - COL_Q)); } while (0)
    if ((int)blockIdx.x < 2048) PREP_LOAD((int)blockIdx.x);
    for (int item = blockIdx.x; item < 2048; item += gridDim.x) {
    const int h = item & 15, n = (item >> 4) & 31, b = item >> 9;
    const int t0 = b * 2048 + n * 64;
    unsigned char* ws = p.ws;
    bf16_t* QT0 = (bf16_t*)(ws + WS_QT0); bf16_t* KTT = (bf16_t*)(ws + WS_KTT); bf16_t* ITT = (bf16_t*)(ws + WS_ITT); float* OIN = (float*)(ws + WS_OIN); float* DEC = (float*)(ws + WS_DEC);
    LAS bf16_t* Qm = (LAS bf16_t*)lds;
    LAS bf16_t* Km = Qm + 64 * 136;
    LAS bf16_t* ITs = Km + 64 * 136;
    LAS bf16_t* Att = ITs + 128 * 72;
    LAS float* tot = (LAS float*)(Att + 64 * 72);
    LAS bf16_t* Lq = (LAS bf16_t*)(tot + 512);
    LAS bf16_t* Lf = Lq + 64 * 136; LAS bf16_t* Li = Lf + 64 * 136;
    *(LAS u32x4*)(Lq + pr * 136 + pc) = R[0]; *(LAS u32x4*)(Lq + (pr + 32) * 136 + pc) = R[1]; *(LAS u32x4*)(Lf + pr * 136 + pc) = R[2]; *(LAS u32x4*)(Lf + (pr + 32) * 136 + pc) = R[3];
    *(LAS u32x4*)(Li + pr * 136 + pc) = R[4]; *(LAS u32x4*)(Li + (pr + 32) * 136 + pc) = R[5];
    __syncthreads();
    { const int nx = item + (int)gridDim.x; if (nx < 2048) PREP_LOAD(nx); }
    float lf[16], qv[16]; unsigned iv[16];
#pragma unroll
    for (int j = 0; j < 16; ++j) { qv[j] = bf2f(Lq[(tq * 16 + j) * 136 + d]); lf[j] = bf2f(Lf[(tq * 16 + j) * 136 + d]); iv[j] = Li[(tq * 16 + j) * 136 + d]; }
    float run = 0.f, cs[16];
#pragma unroll
    for (int j = 0; j < 16; ++j) { run += lf[j]; cs[j] = run; }
    tot[tq * 128 + d] = run;
    __syncthreads();
    const float t0v = tot[d], t1v = tot[128 + d], t2v = tot[256 + d], t3v = tot[384 + d];
    const float off = (tq > 0 ? t0v : 0.f) + (tq > 1 ? t1v : 0.f) + (tq > 2 ? t2v : 0.f);
    const float bmid = t0v + t1v, blast = (t0v + t1v) + (t2v + t3v);
    unsigned kl[8], ip[8];
#pragma unroll
    for (int j = 0; j < 16; j += 2) {
        float q0[2], klv[2];
#pragma unroll
        for (int jj = 0; jj < 2; ++jj) { const int J = j + jj; const float bj = off + cs[J]; const float f = __expf(lf[J]); const float k = 1.0f - f;
            q0[jj] = qv[J] * __expf(bj); klv[jj] = k * __expf(blast - bj);
            const float qm = qv[J] * __expf(bj - bmid), km = k * __expf(bmid - bj);
            const unsigned pk = cvt_pk_bf16(qm, km);
            Qm[(tq * 16 + J) * 136 + d] = (bf16_t)(pk & 0xffffu); Km[(tq * 16 + J) * 136 + d] = (bf16_t)(pk >> 16);
            QT0[(size_t)(t0 + tq * 16 + J) * EA + h * 128 + d] = (bf16_t)(cvt_pk_bf16(q0[jj], 0.f) & 0xffffu); }
        kl[j >> 1] = cvt_pk_bf16(klv[0], klv[1]); ip[j >> 1] = iv[j] | (iv[j + 1] << 16);
    }
    { u32x4 a, c2; a.x = kl[0]; a.y = kl[1]; a.z = kl[2]; a.w = kl[3]; c2.x = kl[4]; c2.y = kl[5]; c2.z = kl[6]; c2.w = kl[7];
      u32x4* kp = (u32x4*)(KTT + ((size_t)item * 128 + d) * 64 + tq * 16); kp[0] = a; kp[1] = c2;
      u32x4 e, f2; e.x = ip[0]; e.y = ip[1]; e.z = ip[2]; e.w = ip[3]; f2.x = ip[4]; f2.y = ip[5]; f2.z = ip[6]; f2.w = ip[7];
      u32x4* ipp = (u32x4*)(ITT + ((size_t)item * 128 + d) * 64 + tq * 16); ipp[0] = e; ipp[1] = f2;
      LAS u32x4* il = (LAS u32x4*)(ITs + d * 72 + tq * 16); il[0] = e; il[1] = f2; }
    if (tq == 0) DEC[(size_t)item * 128 + d] = __expf(blast);
    __syncthreads();
    {
        const int tb = w >> 1;
#pragma unroll
        for (int x = 0; x < 2; ++x) { const int sb = (w & 1) * 2 + x; f32x4 acc = {0.f, 0.f, 0.f, 0.f};
            if (sb <= tb) {
#pragma unroll
                for (int ks = 0; ks < 4; ++ks) { const bf16x8 X = *(const LAS bf16x8*)(Km + (sb * 16 + fr) * 136 + ks * 32 + fq * 8), Y = *(const LAS bf16x8*)(Qm + (tb * 16 + fr) * 136 + ks * 32 + fq * 8); acc = MFMA16(X, Y, acc); }
                const int t = tb * 16 + fr, s0 = sb * 16 + fq * 4;
#pragma unroll
                for (int j = 0; j < 4; ++j) acc[j] = (s0 + j <= t) ? acc[j] : 0.f;
            }
            u32x2 o; o.x = cvt_pk_bf16(acc[0], acc[1]); o.y = cvt_pk_bf16(acc[2], acc[3]);
            *(LAS u32x2*)(Att + (tb * 16 + fr) * 72 + sb * 16 + fq * 4) = o; }
    }
    __syncthreads();
    {
        const int eb = w;
#pragma unroll
        for (int tb = 0; tb < 4; ++tb) { f32x4 acc = {0.f, 0.f, 0.f, 0.f};
#pragma unroll
            for (int ks = 0; ks < 2; ++ks) { if (ks * 32 <= tb * 16 + 15) { const bf16x8 X = *(const LAS bf16x8*)(ITs + (eb * 16 + fr) * 72 + ks * 32 + fq * 8), Y = *(const LAS bf16x8*)(Att + (tb * 16 + fr) * 72 + ks * 32 + fq * 8); acc = MFMA16(X, Y, acc); } }
            *(f32x4*)(OIN + (size_t)(t0 + tb * 16 + fr) * EA + h * 128 + eb * 16 + fq * 4) = acc; }
    }
    __syncthreads();
    }
#undef PREP_LOAD
}

__device__ __forceinline__ void hgrn_scan_item(const Params& p, LAS unsigned char* lds, int bh) {
    const int tid = threadIdx.x, lane = tid & 63, w = tid >> 6, fr = lane & 15, fq = lane >> 4;
    const int b = bh >> 4, h = bh & 15;
    unsigned char* ws = p.ws;
    const bf16_t* H = (const bf16_t*)(ws + WS_H); bf16_t* YAB = (bf16_t*)(ws + WS_YAB);
    const bf16_t* QT0 = (const bf16_t*)(ws + WS_QT0); const bf16_t* KTT = (const bf16_t*)(ws + WS_KTT); const bf16_t* ITT = (const bf16_t*)(ws + WS_ITT);
    const float* OIN = (const float*)(ws + WS_OIN); const float* DEC = (const float*)(ws + WS_DEC);
    LAS bf16_t* ST = (LAS bf16_t*)lds;
    LAS float* ssq = (LAS float*)(lds + 128 * 136 * 2);
    f32x4 S[8];
#pragma unroll
    for (int eb = 0; eb < 8; ++eb) S[eb] = (f32x4){0.f, 0.f, 0.f, 0.f};
    const int tb = w & 3, eh = w >> 2;
    const f32x4 gon[4] = { *(const f32x4*)(p.gon + h * 128 + (eh * 4 + 0) * 16 + fq * 4), *(const f32x4*)(p.gon + h * 128 + (eh * 4 + 1) * 16 + fq * 4),
                           *(const f32x4*)(p.gon + h * 128 + (eh * 4 + 2) * 16 + fq * 4), *(const f32x4*)(p.gon + h * 128 + (eh * 4 + 3) * 16 + fq * 4) };
    for (int n = 0; n < 32; ++n) {
        const int itn = (b * 32 + n) * 16 + h, t = b * 2048 + n * 64 + tb * 16 + fr;
#pragma unroll
        for (int eb = 0; eb < 8; ++eb) { u32x2 o; o.x = cvt_pk_bf16(S[eb][0], S[eb][1]); o.y = cvt_pk_bf16(S[eb][2], S[eb][3]); *(LAS u32x2*)(ST + (eb * 16 + fr) * 136 + w * 16 + fq * 4) = o; }
        __syncthreads();
        bf16x8 Yq[4];
#pragma unroll
        for (int ks = 0; ks < 4; ++ks) Yq[ks] = *(const bf16x8*)(QT0 + (size_t)t * EA + h * 128 + ks * 32 + fq * 8);
        f32x4 o[4]; float ss = 0.f;
#pragma unroll
        for (int el = 0; el < 4; ++el) { f32x4 acc = *(const f32x4*)(OIN + (size_t)t * EA + h * 128 + (eh * 4 + el) * 16 + fq * 4);
#pragma unroll
            for (int ks = 0; ks < 4; ++ks) { const bf16x8 X = *(const LAS bf16x8*)(ST + ((eh * 4 + el) * 16 + fr) * 136 + ks * 32 + fq * 8); acc = MFMA16(X, Yq[ks], acc); }
            o[el] = acc; ss += (acc[0] * acc[0] + acc[1] * acc[1]) + (acc[2] * acc[2] + acc[3] * acc[3]); }
        ss += __shfl_xor(ss, 16); ss += __shfl_xor(ss, 32);
        if (fq == 0) ssq[eh * 64 + tb * 16 + fr] = ss;
        __syncthreads();
        const float rs = __builtin_amdgcn_rsqf((ssq[tb * 16 + fr] + ssq[64 + tb * 16 + fr]) * (1.0f / 128.0f) + EPS);
#pragma unroll
        for (int el = 0; el < 4; ++el) { const int col = h * 128 + (eh * 4 + el) * 16 + fq * 4; const u32x2 zb = *(const u32x2*)(H + (size_t)t * NC + COL_ZB + col);
            u32x2 y; y.x = cvt_pk_bf16(o[el][0] * rs * gon[el][0] * f_lo(zb.x), o[el][1] * rs * gon[el][1] * f_hi(zb.x)); y.y = cvt_pk_bf16(o[el][2] * rs * gon[el][2] * f_lo(zb.y), o[el][3] * rs * gon[el][3] * f_hi(zb.y));
            *(u32x2*)(YAB + (size_t)t * DM + 2048 + col) = y; }
        const f32x4 dec = *(const f32x4*)(DEC + (size_t)itn * 128 + w * 16 + fq * 4);
        const bf16x8 Xk0 = *(const bf16x8*)(KTT + ((size_t)itn * 128 + w * 16 + fr) * 64 + fq * 8), Xk1 = *(const bf16x8*)(KTT + ((size_t)itn * 128 + w * 16 + fr) * 64 + 32 + fq * 8);
#pragma unroll
        for (int eb = 0; eb < 8; ++eb) { const bf16_t* ip = ITT + ((size_t)itn * 128 + eb * 16 + fr) * 64 + fq * 8; const bf16x8 Y0 = *(const bf16x8*)ip, Y1 = *(const bf16x8*)(ip + 32);
            f32x4 a = S[eb] * dec; a = MFMA16(Xk0, Y0, a); a = MFMA16(Xk1, Y1, a); S[eb] = a; }
    }
    float* sp = p.out + O_SP + (size_t)bh * 128 * 128;
#pragma unroll
    for (int eb = 0; eb < 8; ++eb)
#pragma unroll
        for (int j = 0; j < 4; ++j) sp[(size_t)(w * 16 + fq * 4 + j) * 128 + eb * 16 + fr] = S[eb][j];
    __syncthreads();
}

__device__ __forceinline__ void hgrn_state_item(const Params& p, int it) {
    const int tid = threadIdx.x, lane = tid & 63, w = tid >> 6, fr = lane & 15, fq = lane >> 4;
    const int bh = it >> 1, eh = it & 1, b = bh >> 4, h = bh & 15;
    unsigned char* ws = p.ws;
    const bf16_t* KTT = (const bf16_t*)(ws + WS_KTT); const bf16_t* ITT = (const bf16_t*)(ws + WS_ITT); const float* DEC = (const float*)(ws + WS_DEC);
    bf16_t* SN = (bf16_t*)(ws + WS_SN);
    f32x4 S[4];
#pragma unroll
    for (int eb = 0; eb < 4; ++eb) S[eb] = (f32x4){0.f, 0.f, 0.f, 0.f};
    bf16x8 Xk0, Xk1, Y0[4], Y1[4]; f32x4 dec;
    {   const size_t itn = (size_t)(b * 32) * 16 + h;
        dec = *(const f32x4*)(DEC + itn * 128 + w * 16 + fq * 4);
        Xk0 = *(const bf16x8*)(KTT + (itn * 128 + w * 16 + fr) * 64 + fq * 8); Xk1 = *(const bf16x8*)(KTT + (itn * 128 + w * 16 + fr) * 64 + 32 + fq * 8);
#pragma unroll
        for (int eb = 0; eb < 4; ++eb) { const bf16_t* ip = ITT + (itn * 128 + (eh * 4 + eb) * 16 + fr) * 64 + fq * 8; Y0[eb] = *(const bf16x8*)ip; Y1[eb] = *(const bf16x8*)(ip + 32); } }
    for (int n = 0; n < 32; ++n) {
        const size_t itn = (size_t)(b * 32 + n) * 16 + h;
        const int nn = (n < 31) ? n + 1 : 31; const size_t itx = (size_t)(b * 32 + nn) * 16 + h;
        const f32x4 ndec = *(const f32x4*)(DEC + itx * 128 + w * 16 + fq * 4);
        const bf16x8 nXk0 = *(const bf16x8*)(KTT + (itx * 128 + w * 16 + fr) * 64 + fq * 8), nXk1 = *(const bf16x8*)(KTT + (itx * 128 + w * 16 + fr) * 64 + 32 + fq * 8);
        bf16x8 nY0[4], nY1[4];
#pragma unroll
        for (int eb = 0; eb < 4; ++eb) { const bf16_t* ip = ITT + (itx * 128 + (eh * 4 + eb) * 16 + fr) * 64 + fq * 8; nY0[eb] = *(const bf16x8*)ip; nY1[eb] = *(const bf16x8*)(ip + 32); }
#pragma unroll
        for (int eb = 0; eb < 4; ++eb) { u32x2 o; o.x = cvt_pk_bf16(S[eb][0], S[eb][1]); o.y = cvt_pk_bf16(S[eb][2], S[eb][3]); *(u32x2*)(SN + (itn * 128 + (eh * 4 + eb) * 16 + fr) * 128 + w * 16 + fq * 4) = o; }
#pragma unroll
        for (int eb = 0; eb < 4; ++eb) { f32x4 a = S[eb] * dec; a = MFMA16(Xk0, Y0[eb], a); a = MFMA16(Xk1, Y1[eb], a); S[eb] = a; }
        dec = ndec; Xk0 = nXk0; Xk1 = nXk1;
#pragma unroll
        for (int eb = 0; eb < 4; ++eb) { Y0[eb] = nY0[eb]; Y1[eb] = nY1[eb]; }
    }
    float* sp = p.out + O_SP + (size_t)bh * 128 * 128;
#pragma unroll
    for (int eb = 0; eb < 4; ++eb)
#pragma unroll
        for (int j = 0; j < 4; ++j) sp[(size_t)(w * 16 + fq * 4 + j) * 128 + (eh * 4 + eb) * 16 + fr] = S[eb][j];
}

__device__ __forceinline__ void hgrn_out_waveitem(const Params& p, int wi) {
    const int lane = threadIdx.x & 63, fr = lane & 15, fq = lane >> 4;
    const int tb = wi & 3, item = wi >> 2, h = item & 15, n = (item >> 4) & 31, b = item >> 9;
    unsigned char* ws = p.ws;
    const bf16_t* H = (const bf16_t*)(ws + WS_H); bf16_t* YAB = (bf16_t*)(ws + WS_YAB);
    const bf16_t* QT0 = (const bf16_t*)(ws + WS_QT0); const float* OIN = (const float*)(ws + WS_OIN); const bf16_t* SN = (const bf16_t*)(ws + WS_SN);
    const int t = b * 2048 + n * 64 + tb * 16 + fr;
    bf16x8 Yq[4];
#pragma unroll
    for (int ks = 0; ks < 4; ++ks) Yq[ks] = *(const bf16x8*)(QT0 + (size_t)t * EA + h * 128 + ks * 32 + fq * 8);
    f32x4 o[8]; float ss = 0.f;
#pragma unroll
    for (int eb = 0; eb < 8; ++eb) { f32x4 acc = *(const f32x4*)(OIN + (size_t)t * EA + h * 128 + eb * 16 + fq * 4);
        if (n > 0) {
#pragma unroll
            for (int ks = 0; ks < 4; ++ks) { const bf16x8 X = *(const bf16x8*)(SN + ((size_t)item * 128 + eb * 16 + fr) * 128 + ks * 32 + fq * 8); acc = MFMA16(X, Yq[ks], acc); } }
        o[eb] = acc; ss += (acc[0] * acc[0] + acc[1] * acc[1]) + (acc[2] * acc[2] + acc[3] * acc[3]); }
    ss += __shfl_xor(ss, 16); ss += __shfl_xor(ss, 32);
    const float rs = __builtin_amdgcn_rsqf(ss * (1.0f / 128.0f) + EPS);
#pragma unroll
    for (int eb = 0; eb < 8; ++eb) { const int col = h * 128 + eb * 16 + fq * 4; const u32x2 zb = *(const u32x2*)(H + (size_t)t * NC + COL_ZB + col); const f32x4 g = *(const f32x4*)(p.gon + col);
        u32x2 y; y.x = cvt_pk_bf16(o[eb][0] * rs * g[0] * f_lo(zb.x), o[eb][1] * rs * g[1] * f_hi(zb.x)); y.y = cvt_pk_bf16(o[eb][2] * rs * g[2] * f_lo(zb.y), o[eb][3] * rs * g[3] * f_hi(zb.y));
        *(u32x2*)(YAB + (size_t)t * DM + 2048 + col) = y; }
}

__device__ __forceinline__ void amix_item(const Params& p, LAS unsigned char* lds, int item) {
    const int tid = threadIdx.x, lane = tid & 63, w = tid >> 6, fr = lane & 15, fq = lane >> 4;
    const int g = item & 15, n = (item >> 4) & 15, b = item >> 8, t0 = b * 2048 + n * 128;
    unsigned char* ws = p.ws;
    const bf16_t* H = (const bf16_t*)(ws + WS_H); bf16_t* YAB = (bf16_t*)(ws + WS_YAB); const bf16_t* WSM = (const bf16_t*)(ws + WS_WSM); const float* LNP = (const float*)(ws + WS_LNP);
    LAS bf16_t* VT = (LAS bf16_t*)lds;
    LAS float* stats = (LAS float*)(lds + 128 * 136 * 2);
    if (tid < 128) { const f32x4* lp = (const f32x4*)(LNP + (size_t)(t0 + tid) * 64); float s1 = 0.f, s2 = 0.f;
#pragma unroll
        for (int i = 0; i < 16; ++i) { const f32x4 v = lp[i]; s1 += v[0] + v[2]; s2 += v[1] + v[3]; }
        const float mean = s1 * (1.0f / 2048.0f), var = s2 * (1.0f / 2048.0f) - mean * mean;
        stats[tid * 2] = mean; stats[tid * 2 + 1] = __builtin_amdgcn_rsqf(var + EPS); }
    __syncthreads();
#pragma unroll
    for (int i = 0; i < 4; ++i) { const int id = tid + 512 * i, r = id & 127, cc = id >> 7;
        const u32x4 v = *(const u32x4*)(H + (size_t)(t0 + r) * NC + COL_V + g * 128 + cc * 8);
        const float mean = stats[r * 2], rstd = stats[r * 2 + 1];
        const f32x4 g0 = *(const f32x4*)(p.lng + g * 128 + cc * 8), g1 = *(const f32x4*)(p.lng + g * 128 + cc * 8 + 4), b0 = *(const f32x4*)(p.lnb + g * 128 + cc * 8), b1 = *(const f32x4*)(p.lnb + g * 128 + cc * 8 + 4);
        float vn[8];
        vn[0] = (f_lo(v.x) - mean) * rstd * g0[0] + b0[0]; vn[1] = (f_hi(v.x) - mean) * rstd * g0[1] + b0[1]; vn[2] = (f_lo(v.y) - mean) * rstd * g0[2] + b0[2]; vn[3] = (f_hi(v.y) - mean) * rstd * g0[3] + b0[3];
        vn[4] = (f_lo(v.z) - mean) * rstd * g1[0] + b1[0]; vn[5] = (f_hi(v.z) - mean) * rstd * g1[1] + b1[1]; vn[6] = (f_lo(v.w) - mean) * rstd * g1[2] + b1[2]; vn[7] = (f_hi(v.w) - mean) * rstd * g1[3] + b1[3];
        if (n == 15) { float* vp = p.out + O_VP + ((size_t)(b * 128 + r)) * EA + g * 128 + cc * 8; *(f32x4*)vp = (f32x4){vn[0], vn[1], vn[2], vn[3]}; *(f32x4*)(vp + 4) = (f32x4){vn[4], vn[5], vn[6], vn[7]}; }
#pragma unroll
        for (int k = 0; k < 8; k += 2) { const unsigned pk = cvt_pk_bf16(vn[k], vn[k + 1]); VT[(cc * 8 + k) * 136 + r] = (bf16_t)(pk & 0xffffu); VT[(cc * 8 + k + 1) * 136 + r] = (bf16_t)(pk >> 16); }
    }
    __syncthreads();
    {
        const int tb = w, nks = (tb >> 1) + 1, t = t0 + tb * 16 + fr;
        bf16x8 Yw[4];
#pragma unroll
        for (int ks = 0; ks < 4; ++ks) { if (ks < nks) Yw[ks] = *(const bf16x8*)(WSM + ((size_t)(g * 128 + tb * 16 + fr)) * 128 + ks * 32 + fq * 8); else Yw[ks] = (bf16x8){0, 0, 0, 0, 0, 0, 0, 0}; }
        const float bs = p.bsp[g * 128 + tb * 16 + fr];
#pragma unroll
        for (int cb = 0; cb < 8; ++cb) { f32x4 acc = {0.f, 0.f, 0.f, 0.f};
#pragma unroll
            for (int ks = 0; ks < 4; ++ks) { if (ks < nks) { const bf16x8 X = *(const LAS bf16x8*)(VT + (cb * 16 + fr) * 136 + ks * 32 + fq * 8); acc = MFMA16(X, Yw[ks], acc); } }
            const int col = g * 128 + cb * 16 + fq * 4;
            const u32x2 u = *(const u32x2*)(H + (size_t)t * NC + COL_U + col), za = *(const u32x2*)(H + (size_t)t * NC + COL_ZA + col);
            u32x2 y; y.x = cvt_pk_bf16(f_lo(u.x) * (acc[0] + bs) * f_lo(za.x), f_hi(u.x) * (acc[1] + bs) * f_hi(za.x)); y.y = cvt_pk_bf16(f_lo(u.y) * (acc[2] + bs) * f_lo(za.y), f_hi(u.y) * (acc[3] + bs) * f_hi(za.y));
            *(u32x2*)(YAB + (size_t)t * DM + col) = y; }
    }
    __syncthreads();
}

__device__ __forceinline__ void hgrn_sample_item(const Params& p, LAS unsigned char* lds, int item) {
    const int tid = threadIdx.x, lane = tid & 63, w = tid >> 6;
    const int bs = item >> 4, h = item & 15, row = TP + bs, e4 = tid & 31, dg = tid >> 5;
    unsigned char* ws = p.ws;
    const bf16_t* H = (const bf16_t*)(ws + WS_H); bf16_t* YAB = (bf16_t*)(ws + WS_YAB);
    LAS float* red = (LAS float*)lds;
    LAS float* ssw = red + 16 * 128;
    const bf16_t* hr = H + (size_t)row * NC + h * 128;
    const u32x2 ii = *(const u32x2*)(hr + COL_I + e4 * 4);
    const f32x4 i4 = {f_lo(ii.x), f_hi(ii.x), f_lo(ii.y), f_hi(ii.y)};
    const u32x4 q8 = *(const u32x4*)(hr + COL_Q + dg * 8), l8 = *(const u32x4*)(hr + COL_F + dg * 8);
    const float qv[8] = {f_lo(q8.x), f_hi(q8.x), f_lo(q8.y), f_hi(q8.y), f_lo(q8.z), f_hi(q8.z), f_lo(q8.w), f_hi(q8.w)};
    const float lv[8] = {f_lo(l8.x), f_hi(l8.x), f_lo(l8.y), f_hi(l8.y), f_lo(l8.z), f_hi(l8.z), f_lo(l8.w), f_hi(l8.w)};
    const size_t sbase = ((size_t)item * 128 + dg * 8) * 128 + e4 * 4;
    const f32x4* s0 = (const f32x4*)(p.st0 + sbase); f32x4* s1 = (f32x4*)(p.out + O_SS + sbase);
    f32x4 po = {0.f, 0.f, 0.f, 0.f};
#pragma unroll
    for (int j = 0; j < 8; ++j) { const float f = __expf(lv[j]), k = 1.0f - f; const f32x4 sn = s0[j * 32] * f + i4 * k; s1[j * 32] = sn; po += sn * qv[j]; }
    *(LAS f32x4*)(red + dg * 128 + e4 * 4) = po;
    __syncthreads();
    float o = 0.f;
    if (tid < 128) {
#pragma unroll
        for (int k = 0; k < 16; ++k) o += red[k * 128 + tid];
        const float s = wave_sum(o * o);
        if (lane == 0) ssw[w] = s;
    }
    __syncthreads();
    if (tid < 128) { const float rs = __builtin_amdgcn_rsqf((ssw[0] + ssw[1]) * (1.0f / 128.0f) + EPS);
        const float y = o * rs * p.gon[h * 128 + tid] * bf2f(hr[COL_ZB + tid]);
        YAB[(size_t)row * DM + 2048 + h * 128 + tid] = (bf16_t)(cvt_pk_bf16(y, 0.f) & 0xffffu); }
    __syncthreads();
}

__device__ __forceinline__ void amix_sample_item(const Params& p, int bs) {
    const int tid = threadIdx.x, row = TP + bs, c0 = tid * 4, g = c0 >> 7;
    unsigned char* ws = p.ws;
    const bf16_t* H = (const bf16_t*)(ws + WS_H); bf16_t* YAB = (bf16_t*)(ws + WS_YAB); const float* LNP = (const float*)(ws + WS_LNPS);
    const f32x4 lv = *((const f32x4*)(LNP + (size_t)bs * 256) + (tid & 63));
    const float s1 = wave_sum(lv[0] + lv[2]), s2 = wave_sum(lv[1] + lv[3]);
    const float mean = s1 * (1.0f / 2048.0f), rstd = __builtin_amdgcn_rsqf(s2 * (1.0f / 2048.0f) - mean * mean + EPS);
    const bf16_t* hr = H + (size_t)row * NC + c0;
    const u32x2 v = *(const u32x2*)(hr + COL_V), u = *(const u32x2*)(hr + COL_U), za = *(const u32x2*)(hr + COL_ZA);
    const f32x4 lg = *(const f32x4*)(p.lng + c0), lb = *(const f32x4*)(p.lnb + c0);
    f32x4 vn; vn[0] = (f_lo(v.x) - mean) * rstd * lg[0] + lb[0]; vn[1] = (f_hi(v.x) - mean) * rstd * lg[1] + lb[1]; vn[2] = (f_lo(v.y) - mean) * rstd * lg[2] + lb[2]; vn[3] = (f_hi(v.y) - mean) * rstd * lg[3] + lb[3];
    *(f32x4*)(p.out + O_VS + (size_t)bs * EA + c0) = vn;
    const float w00 = p.wsp[(size_t)g * 128 * 128], b0 = p.bsp[g * 128];
    u32x2 y; y.x = cvt_pk_bf16(f_lo(u.x) * (w00 * vn[0] + b0) * f_lo(za.x), f_hi(u.x) * (w00 * vn[1] + b0) * f_hi(za.x)); y.y = cvt_pk_bf16(f_lo(u.y) * (w00 * vn[2] + b0) * f_lo(za.y), f_hi(u.y) * (w00 * vn[3] + b0) * f_hi(za.y));
    *(u32x2*)(YAB + (size_t)row * DM + c0) = y;
}

template <int MODE> __device__ __forceinline__ void skinny_gemm(const Params& p, LAS unsigned char* lds, int g0, int gstride) {
    int tid0 = threadIdx.x; asm volatile("" : "+v"(tid0));
    const int tid = tid0, lane = tid & 63, w = tid >> 6, fr = lane & 15, fq = lane >> 4;
    unsigned char* ws = p.ws;
    const bf16_t* A = (const bf16_t*)(ws + (MODE == 1 ? WS_XN : MODE == 2 ? WS_YAB : WS_MRG)) + (size_t)TP * DM;
    const bf16_t* Bt = (const bf16_t*)(ws + (MODE == 1 ? WS_WTIN : MODE == 2 ? WS_WTAB : WS_WTO));
    bf16_t* H = (bf16_t*)(ws + WS_H);
    constexpr int NG = (MODE == 1 ? NC : DM) / 128, AP = 264;
    LAS bf16_t* As = (LAS bf16_t*)lds;
    const int sr = tid >> 5, sc = (tid & 31) * 8;
    const int wu = __builtin_amdgcn_readfirstlane(w);
    unsigned aoff[8];
#pragma unroll
    for (int i = 0; i < 8; ++i) aoff[i] = (unsigned)(((sr + 16 * i) * DM + sc) * 2);
    const unsigned boff = (unsigned)((fr * DM + fq * 8) * 2);
    for (int g = g0; g < NG; g += gstride) {
        const int n0 = g * 128 + wu * 16, col = n0 + 4 * fq;
        const char* ab = (const char*)A; const char* bb = (const char*)Bt + (size_t)n0 * DM * 2;
        f32x4 acc[8];
#pragma unroll
        for (int mb = 0; mb < 8; ++mb) acc[mb] = (f32x4){0.f, 0.f, 0.f, 0.f};
        u32x4 ar[8]; bf16x8 bc[8];
#pragma unroll
        for (int i = 0; i < 8; ++i) ar[i] = *(const u32x4*)(ab + aoff[i]);
#pragma unroll
        for (int ks = 0; ks < 8; ++ks) bc[ks] = *(const bf16x8*)(bb + boff + ks * 64);
#pragma unroll
        for (int i = 0; i < 8; ++i) *(LAS u32x4*)(As + (sr + 16 * i) * AP + sc) = ar[i];
        __syncthreads();
        for (int kc = 0; kc < 16; ++kc) {
            const int kn = (kc < 15) ? kc + 1 : 15;
#pragma unroll
            for (int i = 0; i < 8; ++i) ar[i] = *(const u32x4*)(ab + kn * 512 + aoff[i]);
#pragma unroll
            for (int ks = 0; ks < 8; ++ks) {
#pragma unroll
                for (int mb = 0; mb < 8; ++mb) { const bf16x8 Y = *(const LAS bf16x8*)(As + (mb * 16 + fr) * AP + ks * 32 + fq * 8); acc[mb] = MFMA16(bc[ks], Y, acc[mb]); }
                bc[ks] = *(const bf16x8*)(bb + kn * 512 + boff + ks * 64);
                __builtin_amdgcn_sched_barrier(0);
            }
            if (MODE == 2 && kc == 7) {
#pragma unroll
                for (int mb = 0; mb < 8; ++mb) { const int row = TP + mb * 16 + fr; const u32x2 ga = *(const u32x2*)(H + (size_t)row * NC + COL_GA + col), gb = *(const u32x2*)(H + (size_t)row * NC + COL_GB + col);
                    acc[mb][0] *= f_lo(ga.x) * __builtin_amdgcn_rcpf(f_lo(gb.x)); acc[mb][1] *= f_hi(ga.x) * __builtin_amdgcn_rcpf(f_hi(gb.x)); acc[mb][2] *= f_lo(ga.y) * __builtin_amdgcn_rcpf(f_lo(gb.y)); acc[mb][3] *= f_hi(ga.y) * __builtin_amdgcn_rcpf(f_hi(gb.y)); if (mb & 1) asm volatile("" ::: "memory"); }
            }
            __syncthreads();
#pragma unroll
            for (int i = 0; i < 8; ++i) *(LAS u32x4*)(As + (sr + 16 * i) * AP + sc) = ar[i];
            __syncthreads();
        }
        if (MODE == 1) {
            const int type = n0 < 2048 ? 0 : n0 < 4096 ? 1 : n0 < 8192 ? 2 : n0 < 10240 ? 3 : n0 < 12288 ? 4 : n0 < 14336 ? 2 : 5;
            float lb[4] = {0.f, 0.f, 0.f, 0.f};
            if (type == 3) { const f32x4 l0 = *(const f32x4*)(p.lbl + col - 8192), l1 = *(const f32x4*)(p.lbl + 2048 + col - 8192);
#pragma unroll
                for (int j = 0; j < 4; ++j) lb[j] = __builtin_amdgcn_rcpf(1.0f + __expf(l1[j] - l0[j])); }
            float* LNPS = (float*)(ws + WS_LNPS);
#pragma unroll
            for (int mb = 0; mb < 8; ++mb) { const int row = TP + mb * 16 + fr; float v[4]; float s1 = 0.f, s2 = 0.f;
#pragma unroll
                for (int j = 0; j < 4; ++j) { float x = acc[mb][j];
                    if (type <= 1) x = pg8::fgelu(x); else if (type == 2) x = pg8::fsilu(x); else if (type == 3) x = __logf(lb[j] + (1.0f - lb[j]) * pg8::fsigmoid(x)); else if (type == 5) x = pg8::fsigmoid(x);
                    v[j] = x; s1 += x; s2 += x * x; }
                u32x2 o; o.x = cvt_pk_bf16(v[0], v[1]); o.y = cvt_pk_bf16(v[2], v[3]); *(u32x2*)(H + (size_t)row * NC + col) = o;
                if (type == 1) { s1 += __shfl_xor(s1, 16); s1 += __shfl_xor(s1, 32); s2 += __shfl_xor(s2, 16); s2 += __shfl_xor(s2, 32);
                    if (fq == 0) { f32x2 q; q.x = s1; q.y = s2; *(f32x2*)(LNPS + (size_t)(row - TP) * 256 + ((n0 - 2048) >> 4) * 2) = q; } } }
        } else if (MODE == 2) {
            bf16_t* MRG = (bf16_t*)(ws + WS_MRG);
#pragma unroll
            for (int mb = 0; mb < 8; ++mb) { const int row = TP + mb * 16 + fr; const u32x2 gb = *(const u32x2*)(H + (size_t)row * NC + COL_GB + col);
                u32x2 o; o.x = cvt_pk_bf16(acc[mb][0] * f_lo(gb.x), acc[mb][1] * f_hi(gb.x)); o.y = cvt_pk_bf16(acc[mb][2] * f_lo(gb.y), acc[mb][3] * f_hi(gb.y)); *(u32x2*)(MRG + (size_t)row * DM + col) = o; }
        } else {
            bf16_t* Z = (bf16_t*)(ws + WS_Z); float* SSPS = (float*)(ws + WS_SSPS);
#pragma unroll
            for (int mb = 0; mb < 8; ++mb) { const int row = TP + mb * 16 + fr; const f32x4 v = acc[mb];
                u32x2 o; o.x = cvt_pk_bf16(v[0], v[1]); o.y = cvt_pk_bf16(v[2], v[3]); *(u32x2*)(Z + (size_t)row * DM + col) = o;
                float ss = (v[0] * v[0] + v[1] * v[1]) + (v[2] * v[2] + v[3] * v[3]); ss += __shfl_xor(ss, 16); ss += __shfl_xor(ss, 32);
                if (fq == 0) SSPS[(size_t)(row - TP) * 256 + (n0 >> 4)] = ss; }
        }
        __syncthreads();
    }
}

__device__ __forceinline__ void phase_final(const Params& p, int m0, int m1, int wg, int nwg) {
    int tid_o = threadIdx.x; asm volatile("" : "+v"(tid_o));
    const int tid = tid_o, lane = tid & 63, wid = tid >> 6;
    const int gw = wg * 8 + wid, NGW = nwg * 8;
    const bf16_t* Z = (const bf16_t*)(p.ws + WS_Z); const float* SSP = (const float*)(p.ws + WS_SSP);
    for (int m = m0 + gw; m < m1; m += NGW) {
        float sq; if (m < TP) sq = SSP[(size_t)m * 64 + lane]; else { const f32x4 q = *((const f32x4*)((const float*)(p.ws + WS_SSPS) + (size_t)(m - TP) * 256) + lane); sq = (q[0] + q[1]) + (q[2] + q[3]); }
        const float rs = __builtin_amdgcn_rsqf(wave_sum(sq) * (1.0f / DM) + EPS);
        const float* xr = (m < TP) ? p.xp + (size_t)m * DM : p.xs + (size_t)(m - TP) * DM;
        float* yr = p.out + (size_t)m * DM;
        const f32x4* x4 = (const f32x4*)xr + lane; const f32x4* g4 = (const f32x4*)p.gpost + lane; const u32x2* z8 = (const u32x2*)(Z + (size_t)m * DM) + lane; f32x4* y4 = (f32x4*)yr + lane;
#pragma unroll
        for (int j = 0; j < 16; ++j) { const f32x4 x = x4[64 * j], g = g4[64 * j]; const u32x2 z = z8[64 * j];
            f32x4 y; y[0] = x[0] + f_lo(z.x) * rs * g[0]; y[1] = x[1] + f_hi(z.x) * rs * g[1]; y[2] = x[2] + f_lo(z.y) * rs * g[2]; y[3] = x[3] + f_hi(z.y) * rs * g[3]; y4[64 * j] = y; }
    }
}

constexpr int NPH = 9;
__global__ void __launch_bounds__(512, 2) mega(Params p) {
    extern __shared__ __attribute__((aligned(16))) unsigned char lds_raw[];
    LAS unsigned char* lds = (LAS unsigned char*)lds_raw;
    cg::grid_group grid = cg::this_grid();
    const int lo = p.lo, hi = p.hi, G = gridDim.x, bid = blockIdx.x;
    unsigned char* ws = p.ws;
    if (threadIdx.x < 64) ((LAS unsigned*)(lds + LDS_STAGE))[threadIdx.x] = 0u;
    __syncthreads();
    XcdBarrier bar = xcd_barrier_post((unsigned*)(ws + 16384), (volatile LAS unsigned*)(lds + LDS_STAGE));
    if (hi - lo > 1) grid.sync();
#define IN(k) (lo <= (k) && (k) < hi)
#define GSYNC() xcd_barrier(bar)
#define SEAM(k) do { if (IN(k) && IN((k) + 1)) GSYNC(); } while (0)
#define REPS(k) (1 + ((MK_REP >> (k)) & 1))
    for (int rep = 0; rep < REPS(0); ++rep) { if (rep) GSYNC(); if (IN(0)) phase0(p, lds); }
    SEAM(0);
    for (int rep = 0; rep < REPS(1); ++rep) { if (rep) GSYNC();
        if (IN(1)) {
            pg8::Gemm g{(const bf16_t*)(ws + WS_XN), (const bf16_t*)(ws + WS_WTIN), TP, NC, DM, DM / 64, 0}; pg8::StaticOrder S; S.init(TP, NC, G, bid);
            pg8::EpiAct E{(bf16_t*)(ws + WS_H), p.lbl, (float*)(ws + WS_LNP)};
            pg8::gemm_phase<pg8::EpiAct, pg8::StaticOrder, true, true>(lds, g, S, E);
            for (int r2 = 0; r2 < 1 + MK_SK; ++r2) skinny_gemm<1>(p, lds, bid, G);
        } }
    SEAM(1);
    for (int rep = 0; rep < REPS(2); ++rep) { if (rep) GSYNC(); if (IN(2)) hgrn_prep_phase(p, lds); }
    SEAM(2);
    for (int rep = 0; rep < REPS(3); ++rep) { if (rep) GSYNC();
        if (IN(3)) {
            constexpr int T_SC = 128, T_AM = 512, T_HS = 256, T_AS = 8, T_TOT = T_SC + T_AM + T_HS + T_AS;
            unsigned* ctr = (unsigned*)ws + 64 * (1 + rep); LAS int* slot = (LAS int*)(lds + LDS_STAGE + 64);
            int it = bid;
            while (it < T_TOT) {
                int nxt = 0; if (threadIdx.x == 0) nxt = G + (int)atomicAdd(ctr, 1u);
                if (it < T_SC) { for (int r2 = 0; r2 < 1 + (MK_SUB & 1); ++r2) hgrn_state_item(p, it); }
                else if (it < T_SC + T_AM) { for (int k = 0; k < 2; ++k) amix_item(p, lds, (it - T_SC) * 2 + k); }
                else if (it < T_SC + T_AM + T_HS) { for (int k = 0; k < 8; ++k) hgrn_sample_item(p, lds, (it - T_SC - T_AM) * 8 + k); }
                else { for (int k = 0; k < 16; ++k) amix_sample_item(p, (it - T_SC - T_AM - T_HS) * 16 + k); }
                if (threadIdx.x == 0) *slot = nxt;
                __syncthreads(); it = *slot; __syncthreads();
            }
        } }
    SEAM(3);
    for (int rep = 0; rep < REPS(4); ++rep) { if (rep) GSYNC();
        if (IN(4)) {
            const int nsk = (G > 64) ? 32 : 0;
            if (bid >= G - nsk) { for (int r2 = 0; r2 < 1 + MK_SK; ++r2) skinny_gemm<2>(p, lds, bid - (G - nsk), nsk); }
            else { for (int wi = bid * 8 + (int)(threadIdx.x >> 6); wi < 8192; wi += (G - nsk) * 8) hgrn_out_waveitem(p, wi); }
            if (nsk == 0) skinny_gemm<2>(p, lds, bid, G);
        } }
    SEAM(4);
    for (int rep = 0; rep < REPS(5); ++rep) { if (rep) GSYNC();
        if (IN(5)) {
            pg8::Gemm g{(const bf16_t*)(ws + WS_YAB), (const bf16_t*)(ws + WS_WTAB), TP, DM, DM, 32, (size_t)2048 * 2}; pg8::PairOrder S; S.init(TP, DM, G, bid);
            pg8::EpiMerge E{(const bf16_t*)(ws + WS_H), (bf16_t*)(ws + WS_MRG)};
            pg8::gemm_phase<pg8::EpiMerge, pg8::PairOrder, true, true>(lds, g, S, E);
        } }
    SEAM(5);
    for (int rep = 0; rep < REPS(6); ++rep) { if (rep) GSYNC();
        if (IN(6)) {
            pg8::Gemm g{(const bf16_t*)(ws + WS_MRG), (const bf16_t*)(ws + WS_WTO), TP, DM, DM, DM / 64, 0}; pg8::StaticOrder S; S.init(TP, DM, G, bid);
            pg8::EpiZ E{(bf16_t*)(ws + WS_Z), (float*)(ws + WS_SSP)};
            pg8::gemm_phase<pg8::EpiZ, pg8::StaticOrder, true, true>(lds, g, S, E);
        } }
    SEAM(6);
    for (int rep = 0; rep < REPS(7); ++rep) { if (rep) GSYNC();
        if (IN(7)) {
            const int nsk = (G > 64) ? 32 : 0;
            if (bid >= G - nsk) { for (int r2 = 0; r2 < 1 + MK_SK; ++r2) skinny_gemm<3>(p, lds, bid - (G - nsk), nsk); }
            else phase_final(p, 0, TP, bid, G - nsk);
            if (nsk == 0) skinny_gemm<3>(p, lds, bid, G);
        } }
    SEAM(7);
    if (IN(8)) phase_final(p, TP, MT, bid, G);
    for (int x = 0; x < MK_XSYNC; ++x) GSYNC();
#undef IN
#undef SEAM
#undef GSYNC
#undef REPS
}

extern "C" void kernel_launch(void* const* d_in, const int* in_sizes, int n_in, void* d_out, int out_size, void* d_ws, size_t ws_size, hipStream_t stream) {
    static int grid = 0;
    if (grid == 0) {
        if (n_in != 15 || (size_t)out_size != O_END || ws_size < WS_END) { fprintf(stderr, "kernel_launch: unexpected shapes: n_in %d out %d ws %zu (need %zu)\n", n_in, out_size, ws_size, (size_t)WS_END); grid = -1; return; }
        int dev = 0, cus = 0, per_cu = 0;
        if (hipGetDevice(&dev) != hipSuccess || hipDeviceGetAttribute(&cus, hipDeviceAttributeMultiprocessorCount, dev) != hipSuccess) { fprintf(stderr, "kernel_launch: device query failed\n"); grid = -1; return; }
        if (hipFuncSetAttribute((const void*)mega, hipFuncAttributeMaxDynamicSharedMemorySize, LDS_BYTES) != hipSuccess) { fprintf(stderr, "kernel_launch: hipFuncSetAttribute failed\n"); grid = -1; return; }
        if (hipOccupancyMaxActiveBlocksPerMultiprocessor(&per_cu, (const void*)mega, 512, LDS_BYTES) != hipSuccess || per_cu < 1) { fprintf(stderr, "kernel_launch: occupancy query says %d\n", per_cu); per_cu = 1; }
        (void)hipGetLastError();
        grid = cus * per_cu;
        fprintf(stderr, "kernel_launch: grid %d (cus %d x %d)\n", grid, cus, per_cu);
    }
    if (grid < 0) return;
    (void)hipMemsetAsync(d_ws, 0, WS_CTLB, stream);
    Params p{};
    p.xp = (const float*)d_in[0]; p.xs = (const float*)d_in[1]; p.st0 = (const float*)d_in[2]; p.lbl = (const float*)d_in[3]; p.gpre = (const float*)d_in[4]; p.win = (const float*)d_in[5];
    p.lng = (const float*)d_in[6]; p.lnb = (const float*)d_in[7]; p.wsp = (const float*)d_in[8]; p.bsp = (const float*)d_in[9]; p.gon = (const float*)d_in[10]; p.wpa = (const float*)d_in[11];
    p.wpb = (const float*)d_in[12]; p.wo = (const float*)d_in[13]; p.gpost = (const float*)d_in[14];
    p.out = (float*)d_out; p.ws = (unsigned char*)d_ws;
#if MK_MULTI
    for (int ph = 0; ph < NPH; ++ph) { p.lo = ph; p.hi = ph + 1; hipLaunchKernelGGL(mega, dim3(grid), dim3(512), LDS_BYTES, stream, p); }
#else
    p.lo = 0; p.hi = NPH;
    void* args[] = {&p};
    hipError_t e = hipLaunchCooperativeKernel((const void*)mega, dim3(grid), dim3(512), args, LDS_BYTES, stream);
    if (e != hipSuccess) fprintf(stderr, "kernel_launch: cooperative launch failed: %s (grid %d)\n", hipGetErrorString(e), grid);
#endif
}
```

```cpp
#include <hip/hip_runtime.h>
#include <hip/hip_cooperative_groups.h>
#include <cstdio>
#include <cstdint>
namespace cg = cooperative_groups;

#ifndef MK_MULTI
#define MK_MULTI 0
#endif

#ifndef G1ORDER
#define G1ORDER StaticOrder
#endif
#ifndef MK_DELAY_US
#define MK_DELAY_US 0
#endif
#ifndef MK_REP
#define MK_REP 0
#endif
#ifndef MK_SUB
#define MK_SUB 0
#endif
#ifndef MK_XSYNC
#define MK_XSYNC 0
#endif
#ifndef MK_SK
#define MK_SK 0
#endif
#ifndef MK_DUMP
#define MK_DUMP 0
#endif

constexpr int DM = 4096, NC = 22528, TP = 8192, TS = 128, MT = TP + TS, MP = 8448, EA = 2048;
constexpr int COL_U = 0, COL_V = 2048, COL_ZA = 4096, COL_Q = 6144, COL_F = 8192, COL_I = 10240, COL_ZB = 12288, COL_GA = 14336, COL_GB = 18432;
constexpr float EPS = 1e-6f;
constexpr size_t WS_CTLB = 65536;
constexpr size_t WS_WTIN = WS_CTLB;
constexpr size_t WS_WTAB = WS_WTIN + (size_t)NC * DM * 2;
constexpr size_t WS_WTO  = WS_WTAB + (size_t)DM * DM * 2;
constexpr size_t WS_XN   = WS_WTO + (size_t)DM * DM * 2;
constexpr size_t WS_H    = WS_XN + (size_t)MP * DM * 2;
constexpr size_t WS_YAB  = WS_H + (size_t)MP * NC * 2;
constexpr size_t WS_MRG  = WS_YAB + (size_t)MP * DM * 2;
constexpr size_t WS_SN   = WS_MRG;
constexpr size_t WS_Z    = WS_MRG + (size_t)MP * DM * 2;
constexpr size_t WS_LNP  = WS_Z + (size_t)MP * DM * 2;
constexpr size_t WS_SSP  = WS_LNP + (size_t)MP * 64 * 4;
constexpr size_t WS_WSM  = WS_SSP + (size_t)MP * 64 * 4;
constexpr size_t WS_QT0  = WS_WSM + (size_t)16 * 128 * 128 * 2;
constexpr size_t WS_KTT  = WS_QT0 + (size_t)TP * EA * 2;
constexpr size_t WS_ITT  = WS_KTT + (size_t)TP * EA * 2;
constexpr size_t WS_OIN  = WS_ITT + (size_t)TP * EA * 2;
constexpr size_t WS_DEC  = WS_OIN + (size_t)TP * EA * 4;
constexpr size_t WS_LNPS = WS_DEC + (size_t)2048 * 128 * 4;
constexpr size_t WS_SSPS = WS_LNPS + (size_t)128 * 256 * 4;
constexpr size_t WS_END  = WS_SSPS + (size_t)128 * 256 * 4;
constexpr size_t O_YP = 0, O_YS = O_YP + (size_t)TP * DM, O_SP = O_YS + (size_t)TS * DM, O_SS = O_SP + (size_t)4 * 16 * 128 * 128,
                 O_VP = O_SS + (size_t)128 * 16 * 128 * 128, O_VS = O_VP + (size_t)4 * 128 * EA, O_END = O_VS + (size_t)128 * EA;
constexpr int LDS_STAGE = 128 * 1024, LDS_BYTES = LDS_STAGE + 256;

#define LAS __attribute__((address_space(3)))
#define XB_TMO      128
#define XB_XCNT(j)  (256  + 64 * (j))
#define XB_XSUB(j)  (1280 + 64 * (j))
#define XB_XGEN(j)  (2304 + 64 * (j))
#define XB_TOP      3328
#define XB_TOPGEN   3392
#define XCD_BAR_WORDS 3456
#define XB_SPIN_CAP (1u << 18)

__device__ __forceinline__ unsigned xb_ld(unsigned* p)              { return __hip_atomic_load(p, __ATOMIC_RELAXED, __HIP_MEMORY_SCOPE_AGENT); }
__device__ __forceinline__ unsigned xb_add(unsigned* p, unsigned v) { return __hip_atomic_fetch_add(p, v, __ATOMIC_RELAXED, __HIP_MEMORY_SCOPE_AGENT); }
__device__ __forceinline__ unsigned xb_xcc_id() { return (unsigned)__builtin_amdgcn_s_getreg((3 << 11) | 20) & 0xFu; }
#define XB_SPIN(cond, bar) do { unsigned _sp = 0; while (cond) { __builtin_amdgcn_s_sleep(1); \
    if ((++_sp & 255u) == 0u) { if (xb_ld(&(bar)[XB_TMO])) break; if (_sp > XB_SPIN_CAP) { atomicAdd(&(bar)[XB_TMO], 1u); break; } } } } while (0)

struct XcdBarrier {
    unsigned* bar; unsigned x;
    volatile LAS unsigned* st;
};

__device__ __forceinline__ XcdBarrier xcd_barrier_post(unsigned* bar, volatile LAS unsigned* st) {
    XcdBarrier b; b.bar = bar; b.x = xb_xcc_id(); b.st = st;
    if (threadIdx.x == 0) (void)xb_add(&bar[XB_XCNT(b.x)], 1u);
    return b;
}
__device__ __forceinline__ void xcd_barrier_complete(unsigned* bar, unsigned x, unsigned& nloc, unsigned& nx) {
    const unsigned G = gridDim.x * gridDim.y * gridDim.z;
    unsigned sum, cnt, mine, sp = 0u;
    for (;;) {
        sum = 0u; cnt = 0u; mine = 0u;
#pragma unroll
        for (unsigned j = 0; j < 16; ++j) { const unsigned c = xb_ld(&bar[XB_XCNT(j)]); sum += c; cnt += (c > 0u) ? 1u : 0u; mine = (j == x) ? c : mine; }
        if (sum == G) break;
        __builtin_amdgcn_s_sleep(1);
        if ((++sp & 255u) == 0u) { if (xb_ld(&bar[XB_TMO])) break; if (sp > XB_SPIN_CAP) { atomicAdd(&bar[XB_TMO], 1u); break; } }
    }
    nloc = mine > 0u ? mine : 1u; nx = cnt > 0u ? cnt : 1u;
}

__device__ __forceinline__ void xcd_barrier(const XcdBarrier& b) {
    asm volatile("s_waitcnt vmcnt(0)" ::: "memory");
    __syncthreads();
    if (threadIdx.x == 0) {
        unsigned* bar = b.bar;
        __builtin_amdgcn_s_waitcnt(0);
        unsigned nloc = b.st[0], nx = b.st[1];
        if (nloc == 0u) { xcd_barrier_complete(bar, b.x, nloc, nx); b.st[0] = nloc; b.st[1] = nx; }
        const unsigned old = xb_add(&bar[XB_XSUB(b.x)], 1u);
        const unsigned gen = old / nloc;
        if (old + 1u == (gen + 1u) * nloc) {
            __builtin_amdgcn_fence(__ATOMIC_RELEASE, "agent");
            asm volatile("s_waitcnt vmcnt(0)" ::: "memory");
            const unsigned og = xb_add(&bar[XB_TOP], 1u);
            const unsigned tg = og / nx;
            if (og + 1u == (tg + 1u) * nx) xb_add(&bar[XB_TOPGEN], 1u);
            else XB_SPIN(xb_ld(&bar[XB_TOPGEN]) == tg, bar);
            __builtin_amdgcn_fence(__ATOMIC_ACQUIRE, "agent");
            xb_add(&bar[XB_XGEN(b.x)], 1u);
            asm volatile("s_waitcnt vmcnt(0)" ::: "memory");
        } else {
            XB_SPIN(xb_ld(&bar[XB_XGEN(b.x)]) == gen, bar);
            __builtin_amdgcn_fence(__ATOMIC_ACQUIRE, "agent");
            asm volatile("s_waitcnt vmcnt(0)" ::: "memory");
        }
    }
    __syncthreads();
}

namespace pg8 {
#define PG8_LAS __attribute__((address_space(3)))
typedef unsigned short bf16_t;
typedef short bf16x8 __attribute__((ext_vector_type(8)));
typedef float f32x4 __attribute__((ext_vector_type(4)));
typedef unsigned u32x4 __attribute__((ext_vector_type(4)));
constexpr int BM = 256, BK = 64, HALF = 128, HTB = HALF * BK * 2  , STAGE_BYTES = 8 * HTB, NXCD = 8, WGM = 8;

__host__ __device__ __forceinline__ int lds_byte(int r, int c) { const int st = (r >> 4) * 2 + (c >> 5), rr = r & 15, cc = c & 31, ob = rr * 64 + cc * 2; return st * 1024 + (ob ^ (((ob >> 9) & 1) << 5)); }
__host__ __device__ __forceinline__ void stage_rc(int b, int& R, int& C) { const int st = b / 1024, sb = b % 1024, swz = sb ^ (((sb >> 9) & 1) << 5); R = (st >> 1) * 16 + swz / 64; C = (st & 1) * 32 + (swz % 64) / 2; }
__host__ __device__ __forceinline__ int perm32(int rho) { const int n = rho >> 4, i = rho & 15; return 8 * (i >> 2) + 4 * n + (i & 3); }

struct Unit { int pm, pn, kh; };
struct Gemm { const bf16_t* A; const bf16_t* Bt; int M, N, K, nt; size_t khoff; };

struct StaticOrder {
    int nM, nN, nwg, G, c;
    __host__ __device__ void init(int M, int N, int G_, int c_) { nM = M / BM; nN = N / BM; nwg = nM * nN; G = G_; c = c_; }
    __host__ __device__ bool next(int i, Unit& u) const {
        const long L = (long)i * G + c; if (L >= nwg) return false;
        int wgid = (int)L; { const int q = nwg / NXCD, r = nwg % NXCD, xcd = wgid % NXCD, off = wgid / NXCD; wgid = (xcd < r ? xcd * (q + 1) : r * (q + 1) + (xcd - r) * q) + off; }
        const int nig = WGM * nN, gid = wgid / nig, fm = gid * WGM, gsz = (nM - fm) < WGM ? (nM - fm) : WGM;
        u.pm = fm + ((wgid % nig) % gsz); u.pn = (wgid % nig) / gsz; u.kh = 0; return true;
    }
    __device__ __forceinline__ void a_ready(const Unit&) const {}
    __device__ __forceinline__ void done(const Unit&) const {}
};

typedef float f32x2 __attribute__((ext_vector_type(2)));
typedef __bf16 bf16x2_t __attribute__((ext_vector_type(2)));
__device__ __forceinline__ unsigned cvt_pk_bf16(float lo, float hi) { const f32x2 v = {lo, hi}; return __builtin_bit_cast(unsigned, __builtin_convertvector(v, bf16x2_t)); }
__device__ __forceinline__ float bf2f(unsigned short b) { return __builtin_bit_cast(float, (unsigned)b << 16); }
__device__ __forceinline__ float f_lo(unsigned w) { return __builtin_bit_cast(float, w << 16); }
__device__ __forceinline__ float f_hi(unsigned w) { return __builtin_bit_cast(float, w & 0xffff0000u); }
__device__ __forceinline__ float fsigmoid(float x) { return __builtin_amdgcn_rcpf(1.0f + __expf(-x)); }
__device__ __forceinline__ float fsilu(float x) { return x * fsigmoid(x); }
__device__ __forceinline__ float fgelu(float x) { return x * fsigmoid(1.5957691216057308f * (x + 0.044715f * x * x * x)); }

struct EpiAct {
    static constexpr bool PERM = true, AFTER_DRAIN = false, CARRY = false;
    bf16_t* H; const float* lbl; float* lnp;
    template <int ACT> __device__ __forceinline__ void run(const f32x4 (&acc)[2][2][4][2], const Unit& u, int wr, int wc, int fr, int fq) const {
        const int row0 = u.pm * BM + wr * 64 + fr, col0 = u.pn * BM + wc * 32 + 8 * fq;
        float lb[2][8];
        if (ACT == 3) {
#pragma unroll
            for (int bj = 0; bj < 2; ++bj) { const float* l0 = lbl + (col0 + bj * HALF - 8192); const f32x4 a0 = *(const f32x4*)l0, a1 = *(const f32x4*)(l0 + 4), b0 = *(const f32x4*)(l0 + 2048), b1 = *(const f32x4*)(l0 + 2052);
#pragma unroll
                for (int k = 0; k < 4; ++k) { lb[bj][k] = __builtin_amdgcn_rcpf(1.0f + __expf(b0[k] - a0[k])); lb[bj][4 + k] = __builtin_amdgcn_rcpf(1.0f + __expf(b1[k] - a1[k])); } }
        }
#pragma unroll
        for (int ai = 0; ai < 2; ++ai)
#pragma unroll
            for (int m = 0; m < 4; ++m) { const int row = row0 + ai * HALF + m * 16; bf16_t* rowp = H + (size_t)row * 22528 + col0; float s1 = 0.f, s2 = 0.f;
#pragma unroll
                for (int bj = 0; bj < 2; ++bj) { float v[8];
#pragma unroll
                    for (int k = 0; k < 4; ++k) { v[k] = acc[ai][bj][m][0][k]; v[4 + k] = acc[ai][bj][m][1][k]; }
#pragma unroll
                    for (int k = 0; k < 8; ++k) {
                        if (ACT == 0 || ACT == 1) v[k] = fgelu(v[k]);
                        if (ACT == 2) v[k] = fsilu(v[k]);
                        if (ACT == 3) v[k] = __logf(lb[bj][k] + (1.0f - lb[bj][k]) * fsigmoid(v[k]));
                        if (ACT == 5) v[k] = fsigmoid(v[k]);
                        if (ACT == 1) { s1 += v[k]; s2 += v[k] * v[k]; }
                    }
                    u32x4 w; w.x = cvt_pk_bf16(v[0], v[1]); w.y = cvt_pk_bf16(v[2], v[3]); w.z = cvt_pk_bf16(v[4], v[5]); w.w = cvt_pk_bf16(v[6], v[7]);
                    *(u32x4*)(rowp + bj * HALF) = w; }
                if (ACT == 1) { s1 += __shfl_xor(s1, 16); s1 += __shfl_xor(s1, 32); s2 += __shfl_xor(s2, 16); s2 += __shfl_xor(s2, 32);
                    if (fq == 0) { f32x2 o; o.x = s1; o.y = s2; *(f32x2*)(lnp + (size_t)row * 64 + ((u.pn - 8) * 4 + wc) * 2) = o; } }
            }
    }
    __device__ __forceinline__ void operator()(const f32x4 (&acc)[2][2][4][2], const Unit& u, int wr, int wc, int fr, int fq) const {
        const int pn = u.pn;
        if (pn < 8) run<0>(acc, u, wr, wc, fr, fq);
        else if (pn < 16) run<1>(acc, u, wr, wc, fr, fq);
        else if (pn < 32) run<2>(acc, u, wr, wc, fr, fq);
        else if (pn < 40) run<3>(acc, u, wr, wc, fr, fq);
        else if (pn < 48) run<4>(acc, u, wr, wc, fr, fq);
        else if (pn < 56) run<2>(acc, u, wr, wc, fr, fq);
        else run<5>(acc, u, wr, wc, fr, fq);
    }
};

struct EpiMerge {
    static constexpr bool PERM = true, AFTER_DRAIN = false, CARRY = true;
    const bf16_t* H; bf16_t* O;
    __device__ __forceinline__ void mid(f32x4 (&acc)[2][2][4][2], const Unit& u, int wr, int wc, int fr, int fq) const {
        const int row0 = u.pm * BM + wr * 64 + fr, col0 = u.pn * BM + wc * 32 + 8 * fq;
#pragma unroll
        for (int ai = 0; ai < 2; ++ai)
#pragma unroll
            for (int m = 0; m < 4; ++m) { const bf16_t* gp = H + (size_t)(row0 + ai * HALF + m * 16) * 22528 + 14336 + col0;
#pragma unroll
                for (int bj = 0; bj < 2; ++bj) { const u32x4 a = *(const u32x4*)(gp + bj * HALF), b = *(const u32x4*)(gp + 4096 + bj * HALF);
                    f32x4 r0, r1;
                    r0[0] = f_lo(a.x) * __builtin_amdgcn_rcpf(f_lo(b.x)); r0[1] = f_hi(a.x) * __builtin_amdgcn_rcpf(f_hi(b.x)); r0[2] = f_lo(a.y) * __builtin_amdgcn_rcpf(f_lo(b.y)); r0[3] = f_hi(a.y) * __builtin_amdgcn_rcpf(f_hi(b.y));
                    r1[0] = f_lo(a.z) * __builtin_amdgcn_rcpf(f_lo(b.z)); r1[1] = f_hi(a.z) * __builtin_amdgcn_rcpf(f_hi(b.z)); r1[2] = f_lo(a.w) * __builtin_amdgcn_rcpf(f_lo(b.w)); r1[3] = f_hi(a.w) * __builtin_amdgcn_rcpf(f_hi(b.w));
                    acc[ai][bj][m][0] *= r0; acc[ai][bj][m][1] *= r1; }
                if (m & 1) asm volatile("" ::: "memory"); }
    }
    __device__ __forceinline__ void operator()(f32x4 (&acc)[2][2][4][2], const Unit& u, int wr, int wc, int fr, int fq) const {
        if (u.kh == 0) { mid(acc, u, wr, wc, fr, fq); return; }
        const int row0 = u.pm * BM + wr * 64 + fr, col0 = u.pn * BM + wc * 32 + 8 * fq;
#pragma unroll
        for (int ai = 0; ai < 2; ++ai)
#pragma unroll
            for (int m = 0; m < 4; ++m) { const int row = row0 + ai * HALF + m * 16; const bf16_t* gp = H + (size_t)row * 22528 + 18432 + col0; bf16_t* rowp = O + (size_t)row * 4096 + col0;
#pragma unroll
                for (int bj = 0; bj < 2; ++bj) { const u32x4 b = *(const u32x4*)(gp + bj * HALF); const f32x4 v0 = acc[ai][bj][m][0], v1 = acc[ai][bj][m][1];
                    u32x4 w; w.x = cvt_pk_bf16(v0[0] * f_lo(b.x), v0[1] * f_hi(b.x)); w.y = cvt_pk_bf16(v0[2] * f_lo(b.y), v0[3] * f_hi(b.y));
                    w.z = cvt_pk_bf16(v1[0] * f_lo(b.z), v1[1] * f_hi(b.z)); w.w = cvt_pk_bf16(v1[2] * f_lo(b.w), v1[3] * f_hi(b.w));
                    *(u32x4*)(rowp + bj * HALF) = w; }
                if (m & 1) asm volatile("" ::: "memory"); }
    }
};

struct EpiZ {
    static constexpr bool PERM = true, AFTER_DRAIN = false, CARRY = false;
    bf16_t* Z; float* ssp;
    __device__ __forceinline__ void operator()(const f32x4 (&acc)[2][2][4][2], const Unit& u, int wr, int wc, int fr, int fq) const {
        const int row0 = u.pm * BM + wr * 64 + fr, col0 = u.pn * BM + wc * 32 + 8 * fq;
#pragma unroll
        for (int ai = 0; ai < 2; ++ai)
#pragma unroll
            for (int m = 0; m < 4; ++m) { const int row = row0 + ai * HALF + m * 16; bf16_t* rowp = Z + (size_t)row * 4096 + col0; float ss = 0.f;
#pragma unroll
                for (int bj = 0; bj < 2; ++bj) { const f32x4 v0 = acc[ai][bj][m][0], v1 = acc[ai][bj][m][1];
                    ss += (v0[0] * v0[0] + v0[1] * v0[1]) + (v0[2] * v0[2] + v0[3] * v0[3]) + (v1[0] * v1[0] + v1[1] * v1[1]) + (v1[2] * v1[2] + v1[3] * v1[3]);
                    u32x4 w; w.x = cvt_pk_bf16(v0[0], v0[1]); w.y = cvt_pk_bf16(v0[2], v0[3]); w.z = cvt_pk_bf16(v1[0], v1[1]); w.w = cvt_pk_bf16(v1[2], v1[3]);
                    *(u32x4*)(rowp + bj * HALF) = w; }
                ss += __shfl_xor(ss, 16); ss += __shfl_xor(ss, 32);
                if (fq == 0) ssp[(size_t)row * 64 + u.pn * 4 + wc] = ss; }
    }
};

struct PairOrder : StaticOrder {
    __device__ bool next(int i, Unit& u) const { if (!StaticOrder::next(i >> 1, u)) return false; u.kh = i & 1; return true; }
};

struct RevOrder : StaticOrder {
    __device__ bool next(int i, Unit& u) const { if (!StaticOrder::next(i, u)) return false; u.pn = nN - 1 - u.pn; return true; }
};

template <class Epi, class Sched, bool ALIGN_EPI = false, bool SP2 = false>
__device__ __forceinline__ void gemm_phase(PG8_LAS unsigned char* lds, const Gemm g, const Sched& S, const Epi& E) {
    int tid_o = threadIdx.x; asm volatile("" : "+v"(tid_o));
    const int tid = tid_o, wid = __builtin_amdgcn_readfirstlane(tid >> 6), lane = tid & 63, wr = wid >> 2, wc = wid & 3, fr = lane & 15, fq = lane >> 4;
    const int K = g.K, nt = g.nt;
    unsigned voffA[2], voffB[2];
#pragma unroll
    for (int i = 0; i < 2; ++i) { int R, C; stage_rc(tid * 16 + i * 8192, R, C); const int Rb = Epi::PERM ? ((R & ~31) + perm32(R & 31)) : R;
        voffA[i] = (unsigned)(R * K + C) * 2u; voffB[i] = (unsigned)(Rb * K + C) * 2u; }
    const size_t kstep = (size_t)(BK * 2);
    const size_t hstep = (size_t)HALF * K * 2;
    const size_t tstep = 2 * hstep;
    const unsigned ldsw = (unsigned)wid * 1024u;
    const int aoff = lds_byte(wr * 64 + fr, fq * 8), boff = lds_byte(wc * 32 + fr, fq * 8);
#define PG8_SA(b, h) (((b) * 2 + (h)) * HTB)
#define PG8_SB(b, h) ((4 + (b) * 2 + (h)) * HTB)
#define PG8_STAGE(bufoff, gbase, voff) do { _Pragma("unroll") for (int _i = 0; _i < 2; ++_i) \
        __builtin_amdgcn_global_load_lds((const unsigned*)((const char*)(gbase) + (voff)[_i]), (PG8_LAS unsigned*)(lds + (bufoff) + ldsw + _i * 8192), 16, 0, 0); } while (0)
#define PG8_LDA(dst, b, h) do { _Pragma("unroll") for (int m = 0; m < 4; ++m) _Pragma("unroll") for (int k = 0; k < 2; ++k) dst[m][k] = *(const PG8_LAS bf16x8*)(lds + PG8_SA(b, h) + aoff + m * 2048 + k * 1024); } while (0)
#define PG8_LDB(dst, b, h) do { _Pragma("unroll") for (int n = 0; n < 2; ++n) _Pragma("unroll") for (int k = 0; k < 2; ++k) dst[n][k] = *(const PG8_LAS bf16x8*)(lds + PG8_SB(b, h) + boff + n * 2048 + k * 1024); } while (0)
#define PG8_MMA(ai, bj, At, Bt) do { __builtin_amdgcn_s_setprio(1); _Pragma("unroll") for (int m = 0; m < 4; ++m) _Pragma("unroll") for (int n = 0; n < 2; ++n) _Pragma("unroll") for (int k = 0; k < 2; ++k) \
        acc[ai][bj][m][n] = __builtin_amdgcn_mfma_f32_16x16x32_bf16(Bt[n][k], At[m][k], acc[ai][bj][m][n], 0, 0, 0); __builtin_amdgcn_s_setprio(0); } while (0)
#define PG8_WAIT_V(n) asm volatile("s_waitcnt vmcnt(" #n ")" ::: "memory")
#define PG8_WAIT_L(n) asm volatile("s_waitcnt lgkmcnt(" #n ")" ::: "memory")
#define PG8_BAR __builtin_amdgcn_s_barrier()
#define PG8_SCHED __builtin_amdgcn_sched_barrier(0)
    Unit cur, nxt; int ui = 0;
    if (!S.next(0, cur)) return;
    f32x4 acc[2][2][4][2];
#pragma unroll
    for (int a = 0; a < 2; ++a)
#pragma unroll
        for (int b = 0; b < 2; ++b)
#pragma unroll
            for (int m = 0; m < 4; ++m)
#pragma unroll
                for (int n = 0; n < 2; ++n) acc[a][b][m][n] = (f32x4){0.f, 0.f, 0.f, 0.f};
    bf16x8 At[4][2], B0[2][2], B1[2][2];
    const char* cA = (const char*)g.A + (size_t)cur.pm * tstep + (size_t)cur.kh * g.khoff; const char* cB = (const char*)g.Bt + (size_t)cur.pn * tstep + (size_t)cur.kh * g.khoff;
    S.a_ready(cur);
    if constexpr (SP2) {
        PG8_STAGE(PG8_SB(0, 0), cB, voffB); PG8_STAGE(PG8_SB(0, 1), cB + hstep, voffB); PG8_STAGE(PG8_SA(0, 0), cA, voffA); PG8_STAGE(PG8_SA(0, 1), cA + hstep, voffA);
        if (wr == 1) PG8_BAR;
        PG8_WAIT_V(2); PG8_BAR;
        PG8_STAGE(PG8_SB(1, 0), cB + kstep, voffB); PG8_STAGE(PG8_SA(1, 0), cA + kstep, voffA); PG8_STAGE(PG8_SB(1, 1), cB + hstep + kstep, voffB);
        PG8_WAIT_V(6); PG8_BAR;
    } else {
        PG8_STAGE(PG8_SB(0, 0), cB, voffB); PG8_STAGE(PG8_SA(0, 0), cA, voffA); PG8_STAGE(PG8_SB(0, 1), cB + hstep, voffB); PG8_STAGE(PG8_SA(0, 1), cA + hstep, voffA);
        if (wr == 1) PG8_BAR;
        PG8_WAIT_V(4); PG8_BAR;
        PG8_STAGE(PG8_SB(1, 0), cB + kstep, voffB); PG8_STAGE(PG8_SA(1, 0), cA + kstep, voffA); PG8_STAGE(PG8_SB(1, 1), cB + hstep + kstep, voffB);
        PG8_WAIT_V(6); PG8_BAR;
    }
    for (;;) {
        const bool has_next = S.next(ui + 1, nxt);
        const char* nA = has_next ? (const char*)g.A + (size_t)nxt.pm * tstep + (size_t)nxt.kh * g.khoff : cA; const char* nB = has_next ? (const char*)g.Bt + (size_t)nxt.pn * tstep + (size_t)nxt.kh * g.khoff : cB;
        for (int t = 0; t < nt; t += 2) {
            const bool last = (t == nt - 2);
            const char* a1 = cA + (size_t)(t + 1) * kstep;
            const char* a2 = last ? nA : cA + (size_t)(t + 2) * kstep; const char* b2 = last ? nB : cB + (size_t)(t + 2) * kstep;
            const char* a3 = a2 + kstep; const char* b3 = b2 + kstep;
            if (last && has_next) S.a_ready(nxt);
            if constexpr (SP2) {
            PG8_LDB(B0, 0, 0); PG8_LDB(B1, 0, 1); PG8_SCHED; PG8_LDA(At, 0, 0); PG8_STAGE(PG8_SA(1, 1), a1 + hstep, voffA);
            PG8_WAIT_V(8); PG8_WAIT_L(0); PG8_BAR; PG8_MMA(0, 0, At, B0); PG8_MMA(0, 1, At, B1); PG8_BAR; PG8_SCHED;
            PG8_LDA(At, 0, 1); PG8_STAGE(PG8_SB(0, 0), b2, voffB); PG8_STAGE(PG8_SB(0, 1), b2 + hstep, voffB); PG8_STAGE(PG8_SA(0, 0), a2, voffA);
            PG8_WAIT_V(8); PG8_WAIT_L(0); PG8_BAR; PG8_MMA(1, 0, At, B0); PG8_MMA(1, 1, At, B1); PG8_BAR; PG8_SCHED;
            PG8_LDB(B0, 1, 0); PG8_LDB(B1, 1, 1); PG8_SCHED; PG8_LDA(At, 1, 0); PG8_STAGE(PG8_SA(0, 1), a2 + hstep, voffA);
            PG8_WAIT_V(8); PG8_WAIT_L(0); PG8_BAR; PG8_MMA(0, 0, At, B0); PG8_MMA(0, 1, At, B1); PG8_BAR; PG8_SCHED;
            PG8_LDA(At, 1, 1); PG8_STAGE(PG8_SB(1, 0), b3, voffB); PG8_STAGE(PG8_SB(1, 1), b3 + hstep, voffB); PG8_STAGE(PG8_SA(1, 0), a3, voffA);
            PG8_WAIT_V(8); PG8_WAIT_L(0); PG8_BAR; PG8_MMA(1, 0, At, B0); PG8_MMA(1, 1, At, B1); PG8_BAR; PG8_SCHED;
            } else {
            PG8_LDB(B0, 0, 0); PG8_SCHED; PG8_LDA(At, 0, 0); PG8_STAGE(PG8_SA(1, 1), a1 + hstep, voffA);
            PG8_WAIT_L(8); PG8_BAR; PG8_WAIT_L(0); PG8_MMA(0, 0, At, B0); PG8_BAR; PG8_SCHED;
            PG8_LDB(B1, 0, 1); PG8_STAGE(PG8_SB(0, 0), b2, voffB);
            PG8_BAR; PG8_WAIT_L(0); PG8_MMA(0, 1, At, B1); PG8_BAR;
            PG8_LDA(At, 0, 1); PG8_STAGE(PG8_SA(0, 0), a2, voffA);
            PG8_BAR; PG8_WAIT_L(0); PG8_MMA(1, 0, At, B0); PG8_BAR; PG8_SCHED;
            PG8_STAGE(PG8_SB(0, 1), b2 + hstep, voffB);
            PG8_WAIT_V(6); PG8_BAR; PG8_MMA(1, 1, At, B1); PG8_BAR;
            PG8_LDB(B0, 1, 0); PG8_SCHED; PG8_LDA(At, 1, 0); PG8_STAGE(PG8_SA(0, 1), a2 + hstep, voffA);
            PG8_WAIT_L(8); PG8_BAR; PG8_WAIT_L(0); PG8_MMA(0, 0, At, B0); PG8_BAR; PG8_SCHED;
            PG8_LDB(B1, 1, 1); PG8_STAGE(PG8_SB(1, 0), b3, voffB);
            PG8_BAR; PG8_WAIT_L(0); PG8_MMA(0, 1, At, B1); PG8_BAR;
            PG8_LDA(At, 1, 1); PG8_STAGE(PG8_SA(1, 0), a3, voffA);
            PG8_BAR; PG8_WAIT_L(0); PG8_MMA(1, 0, At, B0); PG8_BAR; PG8_SCHED;
            PG8_STAGE(PG8_SB(1, 1), b3 + hstep, voffB);
            PG8_WAIT_V(6); PG8_BAR; PG8_MMA(1, 1, At, B1); PG8_BAR;
            }
        }
        if constexpr (ALIGN_EPI) { if (wr == 0) PG8_BAR; }
        if constexpr (!Epi::AFTER_DRAIN) { E(acc, cur, wr, wc, fr, fq); S.done(cur); }
        if (!has_next) break;
        if (!(Epi::CARRY && cur.kh == 0)) {
#pragma unroll
        for (int a = 0; a < 2; ++a)
#pragma unroll
            for (int b = 0; b < 2; ++b)
#pragma unroll
                for (int m = 0; m < 4; ++m)
#pragma unroll
                    for (int n = 0; n < 2; ++n) acc[a][b][m][n] = (f32x4){0.f, 0.f, 0.f, 0.f};
        }
        cur = nxt; cA = nA; cB = nB; ++ui;
        if constexpr (ALIGN_EPI) { if (wr == 1) PG8_BAR; }
    }
    PG8_WAIT_V(0);
    if constexpr (!ALIGN_EPI) { if (wr == 0) PG8_BAR; }
    PG8_BAR;
    if constexpr (Epi::AFTER_DRAIN) { E.fused(acc, cur, wr, wc, fr, fq, lds, wid, lane); S.done(cur); }
#undef PG8_SA
#undef PG8_SB
#undef PG8_STAGE
#undef PG8_LDA
#undef PG8_LDB
#undef PG8_MMA
#undef PG8_WAIT_V
#undef PG8_WAIT_L
#undef PG8_BAR
#undef PG8_SCHED
}
}

using pg8::bf16_t; using pg8::bf16x8; using pg8::f32x4; using pg8::u32x4; using pg8::f32x2; using pg8::cvt_pk_bf16; using pg8::bf2f; using pg8::f_lo; using pg8::f_hi;
typedef unsigned u32x2 __attribute__((ext_vector_type(2)));
#define LDS_WAIT() asm volatile("s_waitcnt lgkmcnt(0)" ::: "memory")
#define MFMA16(X, Y, C) __builtin_amdgcn_mfma_f32_16x16x32_bf16((X), (Y), (C), 0, 0, 0)

struct Params {
    const float *xp, *xs, *st0, *lbl, *gpre, *win, *lng, *lnb, *wsp, *bsp, *gon, *wpa, *wpb, *wo, *gpost;
    float* out; unsigned char* ws; int lo, hi;
};

__device__ __forceinline__ float wave_sum(float v) {
#pragma unroll
    for (int o = 1; o < 64; o <<= 1) v += __shfl_xor(v, o);
    return v;
}

__device__ __forceinline__ void p0_transpose_item(const float* W, int N, bf16_t* WT, int ldd, int koff, LAS float* scr, int kb, int nb, int lane) {
    const int k0 = 64 * kb, n0 = 32 * nb;
    float wv[32];
#pragma unroll
    for (int i = 0; i < 32; ++i) wv[i] = __builtin_nontemporal_load(&W[(size_t)(k0 + 2 * i + (lane >> 5)) * N + n0 + (lane & 31)]);
#pragma unroll
    for (int i = 0; i < 32; ++i) scr[(2 * i + (lane >> 5)) * 33 + (lane & 31)] = wv[i];
    LDS_WAIT(); asm volatile("" ::: "memory");
    const int c = lane & 7;
#pragma unroll
    for (int j = 0; j < 4; ++j) { const int n = (lane >> 3) + 8 * j; const LAS float* s = scr + (8 * c) * 33 + n;
        u32x4 o; o.x = cvt_pk_bf16(s[0 * 33], s[1 * 33]); o.y = cvt_pk_bf16(s[2 * 33], s[3 * 33]); o.z = cvt_pk_bf16(s[4 * 33], s[5 * 33]); o.w = cvt_pk_bf16(s[6 * 33], s[7 * 33]);
        *(u32x4*)(WT + (size_t)(n0 + n) * ldd + koff + k0 + 8 * c) = o; }
    LDS_WAIT(); asm volatile("" ::: "memory");
}

__device__ __forceinline__ void phase0(const Params& p, LAS unsigned char* lds) {
    const int tid = threadIdx.x, lane = tid & 63, wid = tid >> 6;
    const int gw = blockIdx.x * 8 + wid, NGW = gridDim.x * 8;
    unsigned char* ws = p.ws;
    bf16_t* WTIN = (bf16_t*)(ws + WS_WTIN); bf16_t* WTAB = (bf16_t*)(ws + WS_WTAB); bf16_t* WTO = (bf16_t*)(ws + WS_WTO);
    bf16_t* XN = (bf16_t*)(ws + WS_XN); bf16_t* YAB = (bf16_t*)(ws + WS_YAB); bf16_t* WSM = (bf16_t*)(ws + WS_WSM);
    LAS float* scr = (LAS float*)(lds + wid * 8448);
    constexpr int I_IN = 64 * 704, I_PA = 32 * 128, I_O = 64 * 128, NIT = I_IN + 2 * I_PA + I_O;
    for (int it = gw; it < NIT; it += NGW) {
        int r = it;
        if (r < I_IN) { p0_transpose_item(p.win, NC, WTIN, DM, 0, scr, r / 704, r % 704, lane); continue; } r -= I_IN;
        if (r < I_PA) { p0_transpose_item(p.wpa, DM, WTAB, DM, 0, scr, r / 128, r % 128, lane); continue; } r -= I_PA;
        if (r < I_PA) { p0_transpose_item(p.wpb, DM, WTAB, DM, 2048, scr, r / 128, r % 128, lane); continue; } r -= I_PA;
        p0_transpose_item(p.wo, DM, WTO, DM, 0, scr, r / 128, r % 128, lane);
    }
    for (int m = gw; m < MP; m += NGW) {
        u32x2* o8 = (u32x2*)(XN + (size_t)m * DM) + lane;
        if (m < MT) {
            const float* xr = (m < TP) ? p.xp + (size_t)m * DM : p.xs + (size_t)(m - TP) * DM;
            const f32x4* x4 = (const f32x4*)xr + lane; const f32x4* g4 = (const f32x4*)p.gpre + lane;
            f32x4 v[16]; float s = 0.f;
#pragma unroll
            for (int j = 0; j < 16; ++j) { v[j] = __builtin_nontemporal_load(&x4[64 * j]); s += (v[j][0] * v[j][0] + v[j][1] * v[j][1]) + (v[j][2] * v[j][2] + v[j][3] * v[j][3]); }
            const float rs = __builtin_amdgcn_rsqf(wave_sum(s) * (1.0f / DM) + EPS);
#pragma unroll
            for (int j = 0; j < 16; ++j) { const f32x4 g = g4[64 * j]; u32x2 w; w.x = cvt_pk_bf16(v[j][0] * rs * g[0], v[j][1] * rs * g[1]); w.y = cvt_pk_bf16(v[j][2] * rs * g[2], v[j][3] * rs * g[3]); o8[64 * j] = w; }
        } else {
            u32x2* y8 = (u32x2*)(YAB + (size_t)m * DM) + lane; u32x2 z; z.x = 0u; z.y = 0u;
#pragma unroll
            for (int j = 0; j < 16; ++j) { o8[64 * j] = z; y8[64 * j] = z; }
        }
    }
    for (int i = blockIdx.x * 512 + tid; i < 16 * 128 * 128; i += gridDim.x * 512) { const int s = i & 127, t = (i >> 7) & 127; WSM[i] = (s <= t) ? (bf16_t)(cvt_pk_bf16(p.wsp[i], 0.f) & 0xffffu) : (bf16_t)0; }
}

__device__ __forceinline__ void hgrn_prep_phase(const Params& p, LAS unsigned char* lds) {
    int tid_o = threadIdx.x; asm volatile("" : "+v"(tid_o));
    const int tid = tid_o, lane = tid & 63, w = tid >> 6, fr = lane & 15, fq = lane >> 4, d = tid & 127, tq = tid >> 7;
    const int pr = tid >> 4, pc = (tid & 15) * 8;
    u32x4 R[6];
#define PREP_LOAD(item_) do { const int h_ = (item_) & 15, n_ = ((item_) >> 4) & 31, b_ = (item_) >> 9; const bf16_t* g_ = (const bf16_t*)(p.ws + WS_H) + (size_t)(b_ * 2048 + n_ * 64 + pr) * NC + COL_Q + h_ * 128 + pc; \
        R[0] = *(const u32x4*)g_; R[1] = *(const u32x4*)(g_ + (size_t)32 * NC); R[2] = *(const u32x4*)(g_ + (COL_F - COL_Q)); R[3] = *(const u32x4*)(g_ + (size_t)32 * NC + (COL_F - COL_Q)); \
        R[4] = *(const u32x4*)(g_ + (COL_I - COL_Q)); R[5] = *(const u32x4*)(g_ + (size_t)32 * NC + (COL_I - COL_Q)); } while (0)
    if ((int)blockIdx.x < 2048) PREP_LOAD((int)blockIdx.x);
    for (int item = blockIdx.x; item < 2048; item += gridDim.x) {
    const int h = item & 15, n = (item >> 4) & 31, b = item >> 9;
    const int t0 = b * 2048 + n * 64;
    unsigned char* ws = p.ws;
    bf16_t* QT0 = (bf16_t*)(ws + WS_QT0); bf16_t* KTT = (bf16_t*)(ws + WS_KTT); bf16_t* ITT = (bf16_t*)(ws + WS_ITT); float* OIN = (float*)(ws + WS_OIN); float* DEC = (float*)(ws + WS_DEC);
    LAS bf16_t* Qm = (LAS bf16_t*)lds;
    LAS bf16_t* Km = Qm + 64 * 136;
    LAS bf16_t* ITs = Km + 64 * 136;
    LAS bf16_t* Att = ITs + 128 * 72;
    LAS float* tot = (LAS float*)(Att + 64 * 72);
    LAS bf16_t* Lq = (LAS bf16_t*)(tot + 512);
    LAS bf16_t* Lf = Lq + 64 * 136; LAS bf16_t* Li = Lf + 64 * 136;
    *(LAS u32x4*)(Lq + pr * 136 + pc) = R[0]; *(LAS u32x4*)(Lq + (pr + 32) * 136 + pc) = R[1]; *(LAS u32x4*)(Lf + pr * 136 + pc) = R[2]; *(LAS u32x4*)(Lf + (pr + 32) * 136 + pc) = R[3];
    *(LAS u32x4*)(Li + pr * 136 + pc) = R[4]; *(LAS u32x4*)(Li + (pr + 32) * 136 + pc) = R[5];
    __syncthreads();
    { const int nx = item + (int)gridDim.x; if (nx < 2048) PREP_LOAD(nx); }
    float lf[16], qv[16]; unsigned iv[16];
#pragma unroll
    for (int j = 0; j < 16; ++j) { qv[j] = bf2f(Lq[(tq * 16 + j) * 136 + d]); lf[j] = bf2f(Lf[(tq * 16 + j) * 136 + d]); iv[j] = Li[(tq * 16 + j) * 136 + d]; }
    float run = 0.f, cs[16];
#pragma unroll
    for (int j = 0; j < 16; ++j) { run += lf[j]; cs[j] = run; }
    tot[tq * 128 + d] = run;
    __syncthreads();
    const float t0v = tot[d], t1v = tot[128 + d], t2v = tot[256 + d], t3v = tot[384 + d];
    const float off = (tq > 0 ? t0v : 0.f) + (tq > 1 ? t1v : 0.f) + (tq > 2 ? t2v : 0.f);
    const float bmid = t0v + t1v, blast = (t0v + t1v) + (t2v + t3v);
    unsigned kl[8], ip[8];
#pragma unroll
    for (int j = 0; j < 16; j += 2) {
        float q0[2], klv[2];
#pragma unroll
        for (int jj = 0; jj < 2; ++jj) { const int J = j + jj; const float bj = off + cs[J]; const float f = __expf(lf[J]); const float k = 1.0f - f;
            q0[jj] = qv[J] * __expf(bj); klv[jj] = k * __expf(blast - bj);
            const float qm = qv[J] * __expf(bj - bmid), km = k * __expf(bmid - bj);
            const unsigned pk = cvt_pk_bf16(qm, km);
            Qm[(tq * 16 + J) * 136 + d] = (bf16_t)(pk & 0xffffu); Km[(tq * 16 + J) * 136 + d] = (bf16_t)(pk >> 16);
            QT0[(size_t)(t0 + tq * 16 + J) * EA + h * 128 + d] = (bf16_t)(cvt_pk_bf16(q0[jj], 0.f) & 0xffffu); }
        kl[j >> 1] = cvt_pk_bf16(klv[0], klv[1]); ip[j >> 1] = iv[j] | (iv[j + 1] << 16);
    }
    { u32x4 a, c2; a.x = kl[0]; a.y = kl[1]; a.z = kl[2]; a.w = kl[3]; c2.x = kl[4]; c2.y = kl[5]; c2.z = kl[6]; c2.w = kl[7];
      u32x4* kp = (u32x4*)(KTT + ((size_t)item * 128 + d) * 64 + tq * 16); kp[0] = a; kp[1] = c2;
      u32x4 e, f2; e.x = ip[0]; e.y = ip[1]; e.z = ip[2]; e.w = ip[3]; f2.x = ip[4]; f2.y = ip[5]; f2.z = ip[6]; f2.w = ip[7];
      u32x4* ipp = (u32x4*)(ITT + ((size_t)item * 128 + d) * 64 + tq * 16); ipp[0] = e; ipp[1] = f2;
      LAS u32x4* il = (LAS u32x4*)(ITs + d * 72 + tq * 16); il[0] = e; il[1] = f2; }
    if (tq == 0) DEC[(size_t)item * 128 + d] = __expf(blast);
    __syncthreads();
    {
        const int tb = w >> 1;
#pragma unroll
        for (int x = 0; x < 2; ++x) { const int sb = (w & 1) * 2 + x; f32x4 acc = {0.f, 0.f, 0.f, 0.f};
            if (sb <= tb) {
#pragma unroll
                for (int ks = 0; ks < 4; ++ks) { const bf16x8 X = *(const LAS bf16x8*)(Km + (sb * 16 + fr) * 136 + ks * 32 + fq * 8), Y = *(const LAS bf16x8*)(Qm + (tb * 16 + fr) * 136 + ks * 32 + fq * 8); acc = MFMA16(X, Y, acc); }
                const int t = tb * 16 + fr, s0 = sb * 16 + fq * 4;
#pragma unroll
                for (int j = 0; j < 4; ++j) acc[j] = (s0 + j <= t) ? acc[j] : 0.f;
            }
            u32x2 o; o.x = cvt_pk_bf16(acc[0], acc[1]); o.y = cvt_pk_bf16(acc[2], acc[3]);
            *(LAS u32x2*)(Att + (tb * 16 + fr) * 72 + sb * 16 + fq * 4) = o; }
    }
    __syncthreads();
    {
        const int eb = w;
#pragma unroll
        for (int tb = 0; tb < 4; ++tb) { f32x4 acc = {0.f, 0.f, 0.f, 0.f};
#pragma unroll
            for (int ks = 0; ks < 2; ++ks) { if (ks * 32 <= tb * 16 + 15) { const bf16x8 X = *(const LAS bf16x8*)(ITs + (eb * 16 + fr) * 72 + ks * 32 + fq * 8), Y = *(const LAS bf16x8*)(Att + (tb * 16 + fr) * 72 + ks * 32 + fq * 8); acc = MFMA16(X, Y, acc); } }
            *(f32x4*)(OIN + (size_t)(t0 + tb * 16 + fr) * EA + h * 128 + eb * 16 + fq * 4) = acc; }
    }
    __syncthreads();
    }
#undef PREP_LOAD
}

__device__ __forceinline__ void hgrn_scan_item(const Params& p, LAS unsigned char* lds, int bh) {
    const int tid = threadIdx.x, lane = tid & 63, w = tid >> 6, fr = lane & 15, fq = lane >> 4;
    const int b = bh >> 4, h = bh & 15;
    unsigned char* ws = p.ws;
    const bf16_t* H = (const bf16_t*)(ws + WS_H); bf16_t* YAB = (bf16_t*)(ws + WS_YAB);
    const bf16_t* QT0 = (const bf16_t*)(ws + WS_QT0); const bf16_t* KTT = (const bf16_t*)(ws + WS_KTT); const bf16_t* ITT = (const bf16_t*)(ws + WS_ITT);
    const float* OIN = (const float*)(ws + WS_OIN); const float* DEC = (const float*)(ws + WS_DEC);
    LAS bf16_t* ST = (LAS bf16_t*)lds;
    LAS float* ssq = (LAS float*)(lds + 128 * 136 * 2);
    f32x4 S[8];
#pragma unroll
    for (int eb = 0; eb < 8; ++eb) S[eb] = (f32x4){0.f, 0.f, 0.f, 0.f};
    const int tb = w & 3, eh = w >> 2;
    const f32x4 gon[4] = { *(const f32x4*)(p.gon + h * 128 + (eh * 4 + 0) * 16 + fq * 4), *(const f32x4*)(p.gon + h * 128 + (eh * 4 + 1) * 16 + fq * 4),
                           *(const f32x4*)(p.gon + h * 128 + (eh * 4 + 2) * 16 + fq * 4), *(const f32x4*)(p.gon + h * 128 + (eh * 4 + 3) * 16 + fq * 4) };
    for (int n = 0; n < 32; ++n) {
        const int itn = (b * 32 + n) * 16 + h, t = b * 2048 + n * 64 + tb * 16 + fr;
#pragma unroll
        for (int eb = 0; eb < 8; ++eb) { u32x2 o; o.x = cvt_pk_bf16(S[eb][0], S[eb][1]); o.y = cvt_pk_bf16(S[eb][2], S[eb][3]); *(LAS u32x2*)(ST + (eb * 16 + fr) * 136 + w * 16 + fq * 4) = o; }
        __syncthreads();
        bf16x8 Yq[4];
#pragma unroll
        for (int ks = 0; ks < 4; ++ks) Yq[ks] = *(const bf16x8*)(QT0 + (size_t)t * EA + h * 128 + ks * 32 + fq * 8);
        f32x4 o[4]; float ss = 0.f;
#pragma unroll
        for (int el = 0; el < 4; ++el) { f32x4 acc = *(const f32x4*)(OIN + (size_t)t * EA + h * 128 + (eh * 4 + el) * 16 + fq * 4);
#pragma unroll
            for (int ks = 0; ks < 4; ++ks) { const bf16x8 X = *(const LAS bf16x8*)(ST + ((eh * 4 + el) * 16 + fr) * 136 + ks * 32 + fq * 8); acc = MFMA16(X, Yq[ks], acc); }
            o[el] = acc; ss += (acc[0] * acc[0] + acc[1] * acc[1]) + (acc[2] * acc[2] + acc[3] * acc[3]); }
        ss += __shfl_xor(ss, 16); ss += __shfl_xor(ss, 32);
        if (fq == 0) ssq[eh * 64 + tb * 16 + fr] = ss;
        __syncthreads();
        const float rs = __builtin_amdgcn_rsqf((ssq[tb * 16 + fr] + ssq[64 + tb * 16 + fr]) * (1.0f / 128.0f) + EPS);
#pragma unroll
        for (int el = 0; el < 4; ++el) { const int col = h * 128 + (eh * 4 + el) * 16 + fq * 4; const u32x2 zb = *(const u32x2*)(H + (size_t)t * NC + COL_ZB + col);
            u32x2 y; y.x = cvt_pk_bf16(o[el][0] * rs * gon[el][0] * f_lo(zb.x), o[el][1] * rs * gon[el][1] * f_hi(zb.x)); y.y = cvt_pk_bf16(o[el][2] * rs * gon[el][2] * f_lo(zb.y), o[el][3] * rs * gon[el][3] * f_hi(zb.y));
            *(u32x2*)(YAB + (size_t)t * DM + 2048 + col) = y; }
        const f32x4 dec = *(const f32x4*)(DEC + (size_t)itn * 128 + w * 16 + fq * 4);
        const bf16x8 Xk0 = *(const bf16x8*)(KTT + ((size_t)itn * 128 + w * 16 + fr) * 64 + fq * 8), Xk1 = *(const bf16x8*)(KTT + ((size_t)itn * 128 + w * 16 + fr) * 64 + 32 + fq * 8);
#pragma unroll
        for (int eb = 0; eb < 8; ++eb) { const bf16_t* ip = ITT + ((size_t)itn * 128 + eb * 16 + fr) * 64 + fq * 8; const bf16x8 Y0 = *(const bf16x8*)ip, Y1 = *(const bf16x8*)(ip + 32);
            f32x4 a = S[eb] * dec; a = MFMA16(Xk0, Y0, a); a = MFMA16(Xk1, Y1, a); S[eb] = a; }
    }
    float* sp = p.out + O_SP + (size_t)bh * 128 * 128;
#pragma unroll
    for (int eb = 0; eb < 8; ++eb)
#pragma unroll
        for (int j = 0; j < 4; ++j) sp[(size_t)(w * 16 + fq * 4 + j) * 128 + eb * 16 + fr] = S[eb][j];
    __syncthreads();
}

__device__ __forceinline__ void hgrn_state_item(const Params& p, int it) {
    const int tid = threadIdx.x, lane = tid & 63, w = tid >> 6, fr = lane & 15, fq = lane >> 4;
    const int bh = it >> 1, eh = it & 1, b = bh >> 4, h = bh & 15;
    unsigned char* ws = p.ws;
    const bf16_t* KTT = (const bf16_t*)(ws + WS_KTT); const bf16_t* ITT = (const bf16_t*)(ws + WS_ITT); const float* DEC = (const float*)(ws + WS_DEC);
    bf16_t* SN = (bf16_t*)(ws + WS_SN);
    f32x4 S[4];
#pragma unroll
    for (int eb = 0; eb < 4; ++eb) S[eb] = (f32x4){0.f, 0.f, 0.f, 0.f};
    bf16x8 Xk0, Xk1, Y0[4], Y1[4]; f32x4 dec;
    {   const size_t itn = (size_t)(b * 32) * 16 + h;
        dec = *(const f32x4*)(DEC + itn * 128 + w * 16 + fq * 4);
        Xk0 = *(const bf16x8*)(KTT + (itn * 128 + w * 16 + fr) * 64 + fq * 8); Xk1 = *(const bf16x8*)(KTT + (itn * 128 + w * 16 + fr) * 64 + 32 + fq * 8);
#pragma unroll
        for (int eb = 0; eb < 4; ++eb) { const bf16_t* ip = ITT + (itn * 128 + (eh * 4 + eb) * 16 + fr) * 64 + fq * 8; Y0[eb] = *(const bf16x8*)ip; Y1[eb] = *(const bf16x8*)(ip + 32); } }
    for (int n = 0; n < 32; ++n) {
        const size_t itn = (size_t)(b * 32 + n) * 16 + h;
        const int nn = (n < 31) ? n + 1 : 31; const size_t itx = (size_t)(b * 32 + nn) * 16 + h;
        const f32x4 ndec = *(const f32x4*)(DEC + itx * 128 + w * 16 + fq * 4);
        const bf16x8 nXk0 = *(const bf16x8*)(KTT + (itx * 128 + w * 16 + fr) * 64 + fq * 8), nXk1 = *(const bf16x8*)(KTT + (itx * 128 + w * 16 + fr) * 64 + 32 + fq * 8);
        bf16x8 nY0[4], nY1[4];
#pragma unroll
        for (int eb = 0; eb < 4; ++eb) { const bf16_t* ip = ITT + (itx * 128 + (eh * 4 + eb) * 16 + fr) * 64 + fq * 8; nY0[eb] = *(const bf16x8*)ip; nY1[eb] = *(const bf16x8*)(ip + 32); }
#pragma unroll
        for (int eb = 0; eb < 4; ++eb) { u32x2 o; o.x = cvt_pk_bf16(S[eb][0], S[eb][1]); o.y = cvt_pk_bf16(S[eb][2], S[eb][3]); *(u32x2*)(SN + (itn * 128 + (eh * 4 + eb) * 16 + fr) * 128 + w * 16 + fq * 4) = o; }
#pragma unroll
        for (int eb = 0; eb < 4; ++eb) { f32x4 a = S[eb] * dec; a = MFMA16(Xk0, Y0[eb], a); a = MFMA16(Xk1, Y1[eb], a); S[eb] = a; }
        dec = ndec; Xk0 = nXk0; Xk1 = nXk1;
#pragma unroll
        for (int eb = 0; eb < 4; ++eb) { Y0[eb] = nY0[eb]; Y1[eb] = nY1[eb]; }
    }
    float* sp = p.out + O_SP + (size_t)bh * 128 * 128;
#pragma unroll
    for (int eb = 0; eb < 4; ++eb)
#pragma unroll
        for (int j = 0; j < 4; ++j) sp[(size_t)(w * 16 + fq * 4 + j) * 128 + (eh * 4 + eb) * 16 + fr] = S[eb][j];
}

__device__ __forceinline__ void hgrn_out_waveitem(const Params& p, int wi) {
    const int lane = threadIdx.x & 63, fr = lane & 15, fq = lane >> 4;
    const int tb = wi & 3, item = wi >> 2, h = item & 15, n = (item >> 4) & 31, b = item >> 9;
    unsigned char* ws = p.ws;
    const bf16_t* H = (const bf16_t*)(ws + WS_H); bf16_t* YAB = (bf16_t*)(ws + WS_YAB);
    const bf16_t* QT0 = (const bf16_t*)(ws + WS_QT0); const float* OIN = (const float*)(ws + WS_OIN); const bf16_t* SN = (const bf16_t*)(ws + WS_SN);
    const int t = b * 2048 + n * 64 + tb * 16 + fr;
    bf16x8 Yq[4];
#pragma unroll
    for (int ks = 0; ks < 4; ++ks) Yq[ks] = *(const bf16x8*)(QT0 + (size_t)t * EA + h * 128 + ks * 32 + fq * 8);
    f32x4 o[8]; float ss = 0.f;
#pragma unroll
    for (int eb = 0; eb < 8; ++eb) { f32x4 acc = *(const f32x4*)(OIN + (size_t)t * EA + h * 128 + eb * 16 + fq * 4);
        if (n > 0) {
#pragma unroll
            for (int ks = 0; ks < 4; ++ks) { const bf16x8 X = *(const bf16x8*)(SN + ((size_t)item * 128 + eb * 16 + fr) * 128 + ks * 32 + fq * 8); acc = MFMA16(X, Yq[ks], acc); } }
        o[eb] = acc; ss += (acc[0] * acc[0] + acc[1] * acc[1]) + (acc[2] * acc[2] + acc[3] * acc[3]); }
    ss += __shfl_xor(ss, 16); ss += __shfl_xor(ss, 32);
    const float rs = __builtin_amdgcn_rsqf(ss * (1.0f / 128.0f) + EPS);
#pragma unroll
    for (int eb = 0; eb < 8; ++eb) { const int col = h * 128 + eb * 16 + fq * 4; const u32x2 zb = *(const u32x2*)(H + (size_t)t * NC + COL_ZB + col); const f32x4 g = *(const f32x4*)(p.gon + col);
        u32x2 y; y.x = cvt_pk_bf16(o[eb][0] * rs * g[0] * f_lo(zb.x), o[eb][1] * rs * g[1] * f_hi(zb.x)); y.y = cvt_pk_bf16(o[eb][2] * rs * g[2] * f_lo(zb.y), o[eb][3] * rs * g[3] * f_hi(zb.y));
        *(u32x2*)(YAB + (size_t)t * DM + 2048 + col) = y; }
}

__device__ __forceinline__ void amix_ticket(const Params& p, LAS unsigned char* lds, int item0, int cnt) {
    int tid_o = threadIdx.x; asm volatile("" : "+v"(tid_o));
    const int tid = tid_o, lane = tid & 63, w = tid >> 6, fr = lane & 15, fq = lane >> 4;
    unsigned char* ws = p.ws;
    const bf16_t* H = (const bf16_t*)(ws + WS_H); bf16_t* YAB = (bf16_t*)(ws + WS_YAB); const bf16_t* WSM = (const bf16_t*)(ws + WS_WSM); const float* LNP = (const float*)(ws + WS_LNP);
    LAS bf16_t* VT = (LAS bf16_t*)lds;
    LAS float* stats = (LAS float*)(lds + 128 * 136 * 2);
    const int sr = tid >> 2, sq = tid & 3;
    f32x4 P[4]; u32x4 V[4];
#define AMIX_LOAD(item_) do { const int g_ = (item_) & 15, n_ = ((item_) >> 4) & 15, b_ = (item_) >> 8, t0_ = b_ * 2048 + n_ * 128; \
        const f32x4* lp_ = (const f32x4*)(LNP + (size_t)(t0_ + sr) * 64 + sq * 16); P[0] = lp_[0]; P[1] = lp_[1]; P[2] = lp_[2]; P[3] = lp_[3]; \
        _Pragma("unroll") for (int i = 0; i < 4; ++i) { const int id_ = tid + 512 * i; V[i] = *(const u32x4*)(H + (size_t)(t0_ + (id_ & 127)) * NC + COL_V + g_ * 128 + (id_ >> 7) * 8); } } while (0)
    AMIX_LOAD(item0);
    for (int ii = 0; ii < cnt; ++ii) {
        const int item = item0 + ii, g = item & 15, n = (item >> 4) & 15, b = item >> 8, t0 = b * 2048 + n * 128;
        const int tb = w, nks = (tb >> 1) + 1, t = t0 + tb * 16 + fr;
        u32x2 uu[8], zz[8];
#pragma unroll
        for (int cb = 0; cb < 8; ++cb) { const int col = g * 128 + cb * 16 + fq * 4; uu[cb] = *(const u32x2*)(H + (size_t)t * NC + COL_U + col); zz[cb] = *(const u32x2*)(H + (size_t)t * NC + COL_ZA + col); }
        { float s1 = (P[0][0] + P[0][2]) + (P[1][0] + P[1][2]) + (P[2][0] + P[2][2]) + (P[3][0] + P[3][2]), s2 = (P[0][1] + P[0][3]) + (P[1][1] + P[1][3]) + (P[2][1] + P[2][3]) + (P[3][1] + P[3][3]);
          s1 += __shfl_xor(s1, 1); s1 += __shfl_xor(s1, 2); s2 += __shfl_xor(s2, 1); s2 += __shfl_xor(s2, 2);
          if (sq == 0) { const float mean = s1 * (1.0f / 2048.0f), var = s2 * (1.0f / 2048.0f) - mean * mean; stats[sr * 2] = mean; stats[sr * 2 + 1] = __builtin_amdgcn_rsqf(var + EPS); } }
        __syncthreads();
#pragma unroll
        for (int i = 0; i < 4; ++i) { const int id = tid + 512 * i, r = id & 127, cc = id >> 7; const u32x4 v = V[i];
            const float mean = stats[r * 2], rstd = stats[r * 2 + 1];
            const f32x4 g0 = *(const f32x4*)(p.lng + g * 128 + cc * 8), g1 = *(const f32x4*)(p.lng + g * 128 + cc * 8 + 4), b0 = *(const f32x4*)(p.lnb + g * 128 + cc * 8), b1 = *(const f32x4*)(p.lnb + g * 128 + cc * 8 + 4);
            float vn[8];
            vn[0] = (f_lo(v.x) - mean) * rstd * g0[0] + b0[0]; vn[1] = (f_hi(v.x) - mean) * rstd * g0[1] + b0[1]; vn[2] = (f_lo(v.y) - mean) * rstd * g0[2] + b0[2]; vn[3] = (f_hi(v.y) - mean) * rstd * g0[3] + b0[3];
            vn[4] = (f_lo(v.z) - mean) * rstd * g1[0] + b1[0]; vn[5] = (f_hi(v.z) - mean) * rstd * g1[1] + b1[1]; vn[6] = (f_lo(v.w) - mean) * rstd * g1[2] + b1[2]; vn[7] = (f_hi(v.w) - mean) * rstd * g1[3] + b1[3];
            if (n == 15) { float* vp = p.out + O_VP + ((size_t)(b * 128 + r)) * EA + g * 128 + cc * 8; *(f32x4*)vp = (f32x4){vn[0], vn[1], vn[2], vn[3]}; *(f32x4*)(vp + 4) = (f32x4){vn[4], vn[5], vn[6], vn[7]}; }
#pragma unroll
            for (int k = 0; k < 8; k += 2) { const unsigned pk = cvt_pk_bf16(vn[k], vn[k + 1]); VT[(cc * 8 + k) * 136 + r] = (bf16_t)(pk & 0xffffu); VT[(cc * 8 + k + 1) * 136 + r] = (bf16_t)(pk >> 16); }
        }
        if (ii + 1 < cnt) AMIX_LOAD(item + 1);
        __syncthreads();
        {
            bf16x8 Yw[4];
#pragma unroll
            for (int ks = 0; ks < 4; ++ks) { if (ks < nks) Yw[ks] = *(const bf16x8*)(WSM + ((size_t)(g * 128 + tb * 16 + fr)) * 128 + ks * 32 + fq * 8); else Yw[ks] = (bf16x8){0, 0, 0, 0, 0, 0, 0, 0}; }
            const float bs = p.bsp[g * 128 + tb * 16 + fr];
#pragma unroll
            for (int cb = 0; cb < 8; ++cb) { f32x4 acc = {0.f, 0.f, 0.f, 0.f};
#pragma unroll
                for (int ks = 0; ks < 4; ++ks) { if (ks < nks) { const bf16x8 X = *(const LAS bf16x8*)(VT + (cb * 16 + fr) * 136 + ks * 32 + fq * 8); acc = MFMA16(X, Yw[ks], acc); } }
                const int col = g * 128 + cb * 16 + fq * 4; const u32x2 u = uu[cb], za = zz[cb];
                u32x2 y; y.x = cvt_pk_bf16(f_lo(u.x) * (acc[0] + bs) * f_lo(za.x), f_hi(u.x) * (acc[1] + bs) * f_hi(za.x)); y.y = cvt_pk_bf16(f_lo(u.y) * (acc[2] + bs) * f_lo(za.y), f_hi(u.y) * (acc[3] + bs) * f_hi(za.y));
                *(u32x2*)(YAB + (size_t)t * DM + col) = y; }
        }
        __syncthreads();
    }
#undef AMIX_LOAD
}

__device__ __forceinline__ void hgrn_sample_item(const Params& p, LAS unsigned char* lds, int item) {
    const int tid = threadIdx.x, lane = tid & 63, w = tid >> 6;
    const int bs = item >> 4, h = item & 15, row = TP + bs, e4 = tid & 31, dg = tid >> 5;
    unsigned char* ws = p.ws;
    const bf16_t* H = (const bf16_t*)(ws + WS_H); bf16_t* YAB = (bf16_t*)(ws + WS_YAB);
    LAS float* red = (LAS float*)lds;
    LAS float* ssw = red + 16 * 128;
    const bf16_t* hr = H + (size_t)row * NC + h * 128;
    const u32x2 ii = *(const u32x2*)(hr + COL_I + e4 * 4);
    const f32x4 i4 = {f_lo(ii.x), f_hi(ii.x), f_lo(ii.y), f_hi(ii.y)};
    const u32x4 q8 = *(const u32x4*)(hr + COL_Q + dg * 8), l8 = *(const u32x4*)(hr + COL_F + dg * 8);
    const float qv[8] = {f_lo(q8.x), f_hi(q8.x), f_lo(q8.y), f_hi(q8.y), f_lo(q8.z), f_hi(q8.z), f_lo(q8.w), f_hi(q8.w)};
    const float lv[8] = {f_lo(l8.x), f_hi(l8.x), f_lo(l8.y), f_hi(l8.y), f_lo(l8.z), f_hi(l8.z), f_lo(l8.w), f_hi(l8.w)};
    const size_t sbase = ((size_t)item * 128 + dg * 8) * 128 + e4 * 4;
    const f32x4* s0 = (const f32x4*)(p.st0 + sbase); f32x4* s1 = (f32x4*)(p.out + O_SS + sbase);
    f32x4 po = {0.f, 0.f, 0.f, 0.f};
#pragma unroll
    for (int j = 0; j < 8; ++j) { const float f = __expf(lv[j]), k = 1.0f - f; const f32x4 sn = __builtin_nontemporal_load(&s0[j * 32]) * f + i4 * k; __builtin_nontemporal_store(sn, &s1[j * 32]); po += sn * qv[j]; }
    *(LAS f32x4*)(red + dg * 128 + e4 * 4) = po;
    __syncthreads();
    float o = 0.f;
    if (tid < 128) {
#pragma unroll
        for (int k = 0; k < 16; ++k) o += red[k * 128 + tid];
        const float s = wave_sum(o * o);
        if (lane == 0) ssw[w] = s;
    }
    __syncthreads();
    if (tid < 128) { const float rs = __builtin_amdgcn_rsqf((ssw[0] + ssw[1]) * (1.0f / 128.0f) + EPS);
        const float y = o * rs * p.gon[h * 128 + tid] * bf2f(hr[COL_ZB + tid]);
        YAB[(size_t)row * DM + 2048 + h * 128 + tid] = (bf16_t)(cvt_pk_bf16(y, 0.f) & 0xffffu); }
    __syncthreads();
}

__device__ __forceinline__ void amix_sample_item(const Params& p, int bs) {
    const int tid = threadIdx.x, row = TP + bs, c0 = tid * 4, g = c0 >> 7;
    unsigned char* ws = p.ws;
    const bf16_t* H = (const bf16_t*)(ws + WS_H); bf16_t* YAB = (bf16_t*)(ws + WS_YAB); const float* LNP = (const float*)(ws + WS_LNPS);
    const f32x4 lv = *((const f32x4*)(LNP + (size_t)bs * 256) + (tid & 63));
    const float s1 = wave_sum(lv[0] + lv[2]), s2 = wave_sum(lv[1] + lv[3]);
    const float mean = s1 * (1.0f / 2048.0f), rstd = __builtin_amdgcn_rsqf(s2 * (1.0f / 2048.0f) - mean * mean + EPS);
    const bf16_t* hr = H + (size_t)row * NC + c0;
    const u32x2 v = *(const u32x2*)(hr + COL_V), u = *(const u32x2*)(hr + COL_U), za = *(const u32x2*)(hr + COL_ZA);
    const f32x4 lg = *(const f32x4*)(p.lng + c0), lb = *(const f32x4*)(p.lnb + c0);
    f32x4 vn; vn[0] = (f_lo(v.x) - mean) * rstd * lg[0] + lb[0]; vn[1] = (f_hi(v.x) - mean) * rstd * lg[1] + lb[1]; vn[2] = (f_lo(v.y) - mean) * rstd * lg[2] + lb[2]; vn[3] = (f_hi(v.y) - mean) * rstd * lg[3] + lb[3];
    *(f32x4*)(p.out + O_VS + (size_t)bs * EA + c0) = vn;
    const float w00 = p.wsp[(size_t)g * 128 * 128], b0 = p.bsp[g * 128];
    u32x2 y; y.x = cvt_pk_bf16(f_lo(u.x) * (w00 * vn[0] + b0) * f_lo(za.x), f_hi(u.x) * (w00 * vn[1] + b0) * f_hi(za.x)); y.y = cvt_pk_bf16(f_lo(u.y) * (w00 * vn[2] + b0) * f_lo(za.y), f_hi(u.y) * (w00 * vn[3] + b0) * f_hi(za.y));
    *(u32x2*)(YAB + (size_t)row * DM + c0) = y;
}

template <int MODE> __device__ __forceinline__ void skinny_gemm(const Params& p, LAS unsigned char* lds, int g0, int gstride) {
    int tid0 = threadIdx.x; asm volatile("" : "+v"(tid0));
    const int tid = tid0, lane = tid & 63, w = tid >> 6, fr = lane & 15, fq = lane >> 4;
    unsigned char* ws = p.ws;
    const bf16_t* A = (const bf16_t*)(ws + (MODE == 1 ? WS_XN : MODE == 2 ? WS_YAB : WS_MRG)) + (size_t)TP * DM;
    const bf16_t* Bt = (const bf16_t*)(ws + (MODE == 1 ? WS_WTIN : MODE == 2 ? WS_WTAB : WS_WTO));
    bf16_t* H = (bf16_t*)(ws + WS_H);
    constexpr int NG = (MODE == 1 ? NC : DM) / 128, AP = 264;
    LAS bf16_t* As = (LAS bf16_t*)lds;
    const int sr = tid >> 5, sc = (tid & 31) * 8;
    const int wu = __builtin_amdgcn_readfirstlane(w);
    unsigned aoff[8];
#pragma unroll
    for (int i = 0; i < 8; ++i) aoff[i] = (unsigned)(((sr + 16 * i) * DM + sc) * 2);
    const unsigned boff = (unsigned)((fr * DM + fq * 8) * 2);
    for (int g = g0; g < NG; g += gstride) {
        const int n0 = g * 128 + wu * 16, col = n0 + 4 * fq;
        const char* ab = (const char*)A; const char* bb = (const char*)Bt + (size_t)n0 * DM * 2;
        f32x4 acc[8];
#pragma unroll
        for (int mb = 0; mb < 8; ++mb) acc[mb] = (f32x4){0.f, 0.f, 0.f, 0.f};
        u32x4 ar[8]; bf16x8 bc[8];
#pragma unroll
        for (int i = 0; i < 8; ++i) ar[i] = *(const u32x4*)(ab + aoff[i]);
#pragma unroll
        for (int ks = 0; ks < 8; ++ks) bc[ks] = *(const bf16x8*)(bb + boff + ks * 64);
#pragma unroll
        for (int i = 0; i < 8; ++i) *(LAS u32x4*)(As + (sr + 16 * i) * AP + sc) = ar[i];
        __syncthreads();
        for (int kc = 0; kc < 16; ++kc) {
            const int kn = (kc < 15) ? kc + 1 : 15;
#pragma unroll
            for (int i = 0; i < 8; ++i) ar[i] = *(const u32x4*)(ab + kn * 512 + aoff[i]);
#pragma unroll
            for (int ks = 0; ks < 8; ++ks) {
#pragma unroll
                for (int mb = 0; mb < 8; ++mb) { const bf16x8 Y = *(const LAS bf16x8*)(As + (mb * 16 + fr) * AP + ks * 32 + fq * 8); acc[mb] = MFMA16(bc[ks], Y, acc[mb]); }
                bc[ks] = *(const bf16x8*)(bb + kn * 512 + boff + ks * 64);
                __builtin_amdgcn_sched_barrier(0);
            }
            if (MODE == 2 && kc == 7) {
#pragma unroll
                for (int mb = 0; mb < 8; ++mb) { const int row = TP + mb * 16 + fr; const u32x2 ga = *(const u32x2*)(H + (size_t)row * NC + COL_GA + col), gb = *(const u32x2*)(H + (size_t)row * NC + COL_GB + col);
                    acc[mb][0] *= f_lo(ga.x) * __builtin_amdgcn_rcpf(f_lo(gb.x)); acc[mb][1] *= f_hi(ga.x) * __builtin_amdgcn_rcpf(f_hi(gb.x)); acc[mb][2] *= f_lo(ga.y) * __builtin_amdgcn_rcpf(f_lo(gb.y)); acc[mb][3] *= f_hi(ga.y) * __builtin_amdgcn_rcpf(f_hi(gb.y)); if (mb & 1) asm volatile("" ::: "memory"); }
            }
            __syncthreads();
#pragma unroll
            for (int i = 0; i < 8; ++i) *(LAS u32x4*)(As + (sr + 16 * i) * AP + sc) = ar[i];
            __syncthreads();
        }
        if (MODE == 1) {
            const int type = n0 < 2048 ? 0 : n0 < 4096 ? 1 : n0 < 8192 ? 2 : n0 < 10240 ? 3 : n0 < 12288 ? 4 : n0 < 14336 ? 2 : 5;
            float lb[4] = {0.f, 0.f, 0.f, 0.f};
            if (type == 3) { const f32x4 l0 = *(const f32x4*)(p.lbl + col - 8192), l1 = *(const f32x4*)(p.lbl + 2048 + col - 8192);
#pragma unroll
                for (int j = 0; j < 4; ++j) lb[j] = __builtin_amdgcn_rcpf(1.0f + __expf(l1[j] - l0[j])); }
            float* LNPS = (float*)(ws + WS_LNPS);
#pragma unroll
            for (int mb = 0; mb < 8; ++mb) { const int row = TP + mb * 16 + fr; float v[4]; float s1 = 0.f, s2 = 0.f;
#pragma unroll
                for (int j = 0; j < 4; ++j) { float x = acc[mb][j];
                    if (type <= 1) x = pg8::fgelu(x); else if (type == 2) x = pg8::fsilu(x); else if (type == 3) x = __logf(lb[j] + (1.0f - lb[j]) * pg8::fsigmoid(x)); else if (type == 5) x = pg8::fsigmoid(x);
                    v[j] = x; s1 += x; s2 += x * x; }
                u32x2 o; o.x = cvt_pk_bf16(v[0], v[1]); o.y = cvt_pk_bf16(v[2], v[3]); *(u32x2*)(H + (size_t)row * NC + col) = o;
                if (type == 1) { s1 += __shfl_xor(s1, 16); s1 += __shfl_xor(s1, 32); s2 += __shfl_xor(s2, 16); s2 += __shfl_xor(s2, 32);
                    if (fq == 0) { f32x2 q; q.x = s1; q.y = s2; *(f32x2*)(LNPS + (size_t)(row - TP) * 256 + ((n0 - 2048) >> 4) * 2) = q; } } }
        } else if (MODE == 2) {
            bf16_t* MRG = (bf16_t*)(ws + WS_MRG);
#pragma unroll
            for (int mb = 0; mb < 8; ++mb) { const int row = TP + mb * 16 + fr; const u32x2 gb = *(const u32x2*)(H + (size_t)row * NC + COL_GB + col);
                u32x2 o; o.x = cvt_pk_bf16(acc[mb][0] * f_lo(gb.x), acc[mb][1] * f_hi(gb.x)); o.y = cvt_pk_bf16(acc[mb][2] * f_lo(gb.y), acc[mb][3] * f_hi(gb.y)); *(u32x2*)(MRG + (size_t)row * DM + col) = o; }
        } else {
            bf16_t* Z = (bf16_t*)(ws + WS_Z); float* SSPS = (float*)(ws + WS_SSPS);
#pragma unroll
            for (int mb = 0; mb < 8; ++mb) { const int row = TP + mb * 16 + fr; const f32x4 v = acc[mb];
                u32x2 o; o.x = cvt_pk_bf16(v[0], v[1]); o.y = cvt_pk_bf16(v[2], v[3]); *(u32x2*)(Z + (size_t)row * DM + col) = o;
                float ss = (v[0] * v[0] + v[1] * v[1]) + (v[2] * v[2] + v[3] * v[3]); ss += __shfl_xor(ss, 16); ss += __shfl_xor(ss, 32);
                if (fq == 0) SSPS[(size_t)(row - TP) * 256 + (n0 >> 4)] = ss; }
        }
        __syncthreads();
    }
}

__device__ __forceinline__ void phase_final(const Params& p, int m0, int m1, int wg, int nwg) {
    int tid_o = threadIdx.x; asm volatile("" : "+v"(tid_o));
    const int tid = tid_o, lane = tid & 63, wid = tid >> 6;
    const int gw = wg * 8 + wid, NGW = nwg * 8;
    const bf16_t* Z = (const bf16_t*)(p.ws + WS_Z); const float* SSP = (const float*)(p.ws + WS_SSP);
    for (int m = m0 + gw; m < m1; m += NGW) {
        float sq; if (m < TP) sq = SSP[(size_t)m * 64 + lane]; else { const f32x4 q = *((const f32x4*)((const float*)(p.ws + WS_SSPS) + (size_t)(m - TP) * 256) + lane); sq = (q[0] + q[1]) + (q[2] + q[3]); }
        const float rs = __builtin_amdgcn_rsqf(wave_sum(sq) * (1.0f / DM) + EPS);
        const float* xr = (m < TP) ? p.xp + (size_t)m * DM : p.xs + (size_t)(m - TP) * DM;
        float* yr = p.out + (size_t)m * DM;
        const f32x4* x4 = (const f32x4*)xr + lane; const f32x4* g4 = (const f32x4*)p.gpost + lane; const u32x2* z8 = (const u32x2*)(Z + (size_t)m * DM) + lane; f32x4* y4 = (f32x4*)yr + lane;
#pragma unroll
        for (int j = 0; j < 16; ++j) { const f32x4 x = __builtin_nontemporal_load(&x4[64 * j]), g = g4[64 * j]; const u32x2 z = __builtin_nontemporal_load(&z8[64 * j]);
            f32x4 y; y[0] = x[0] + f_lo(z.x) * rs * g[0]; y[1] = x[1] + f_hi(z.x) * rs * g[1]; y[2] = x[2] + f_lo(z.y) * rs * g[2]; y[3] = x[3] + f_hi(z.y) * rs * g[3]; __builtin_nontemporal_store(y, &y4[64 * j]); }
    }
}

constexpr int NPH = 9;
__global__ void __launch_bounds__(512, 2) mega(Params p) {
    extern __shared__ __attribute__((aligned(16))) unsigned char lds_raw[];
    LAS unsigned char* lds = (LAS unsigned char*)lds_raw;
    cg::grid_group grid = cg::this_grid();
    const int lo = p.lo, hi = p.hi, G = gridDim.x, bid = blockIdx.x;
    unsigned char* ws = p.ws;
    if (threadIdx.x < 64) ((LAS unsigned*)(lds + LDS_STAGE))[threadIdx.x] = 0u;
    __syncthreads();
    XcdBarrier bar = xcd_barrier_post((unsigned*)(ws + 16384), (volatile LAS unsigned*)(lds + LDS_STAGE));
    if (hi - lo > 1) grid.sync();
#define IN(k) (lo <= (k) && (k) < hi)
#define GSYNC() xcd_barrier(bar)
#define SEAM(k) do { if (IN(k) && IN((k) + 1)) GSYNC(); } while (0)
#define REPS(k) (1 + ((MK_REP >> (k)) & 1))
    for (int rep = 0; rep < REPS(0); ++rep) { if (rep) GSYNC(); if (IN(0)) phase0(p, lds); }
    SEAM(0);
    for (int rep = 0; rep < REPS(1); ++rep) { if (rep) GSYNC();
        if (IN(1)) {
            pg8::Gemm g{(const bf16_t*)(ws + WS_XN), (const bf16_t*)(ws + WS_WTIN), TP, NC, DM, DM / 64, 0}; pg8::StaticOrder S; S.init(TP, NC, G, bid);
            pg8::EpiAct E{(bf16_t*)(ws + WS_H), p.lbl, (float*)(ws + WS_LNP)};
            pg8::gemm_phase<pg8::EpiAct, pg8::StaticOrder, true, true>(lds, g, S, E);
            for (int r2 = 0; r2 < 1 + MK_SK; ++r2) skinny_gemm<1>(p, lds, bid, G);
        } }
    SEAM(1);
    for (int rep = 0; rep < REPS(2); ++rep) { if (rep) GSYNC(); if (IN(2)) hgrn_prep_phase(p, lds); }
    SEAM(2);
    for (int rep = 0; rep < REPS(3); ++rep) { if (rep) GSYNC();
        if (IN(3)) {
            constexpr int T_SC = 128, T_AM = 256, T_HS = 256, T_AS = 8, T_TOT = T_SC + T_AM + T_HS + T_AS;
            unsigned* ctr = (unsigned*)ws + 64 * (1 + rep); LAS int* slot = (LAS int*)(lds + LDS_STAGE + 64);
            int it = bid;
            while (it < T_TOT) {
                int nxt = 0; if (threadIdx.x == 0) nxt = G + (int)atomicAdd(ctr, 1u);
                if (it < T_SC) { for (int r2 = 0; r2 < 1 + (MK_SUB & 1); ++r2) hgrn_state_item(p, it); }
                else if (it < T_SC + T_AM) amix_ticket(p, lds, (it - T_SC) * 4, 4);
                else if (it < T_SC + T_AM + T_HS) { for (int k = 0; k < 8; ++k) hgrn_sample_item(p, lds, (it - T_SC - T_AM) * 8 + k); }
                else { for (int k = 0; k < 16; ++k) amix_sample_item(p, (it - T_SC - T_AM - T_HS) * 16 + k); }
                if (threadIdx.x == 0) *slot = nxt;
                __syncthreads(); it = *slot; __syncthreads();
            }
        } }
    SEAM(3);
    for (int rep = 0; rep < REPS(4); ++rep) { if (rep) GSYNC();
        if (IN(4)) {
            const int nsk = (G > 64) ? 32 : 0;
            if (bid >= G - nsk) { for (int r2 = 0; r2 < 1 + MK_SK; ++r2) skinny_gemm<2>(p, lds, bid - (G - nsk), nsk); }
            else { for (int wi = bid * 8 + (int)(threadIdx.x >> 6); wi < 8192; wi += (G - nsk) * 8) hgrn_out_waveitem(p, wi); }
            if (nsk == 0) skinny_gemm<2>(p, lds, bid, G);
        } }
    SEAM(4);
    for (int rep = 0; rep < REPS(5); ++rep) { if (rep) GSYNC();
        if (IN(5)) {
            pg8::Gemm g{(const bf16_t*)(ws + WS_YAB), (const bf16_t*)(ws + WS_WTAB), TP, DM, DM, 32, (size_t)2048 * 2}; pg8::PairOrder S; S.init(TP, DM, G, bid);
            pg8::EpiMerge E{(const bf16_t*)(ws + WS_H), (bf16_t*)(ws + WS_MRG)};
            pg8::gemm_phase<pg8::EpiMerge, pg8::PairOrder, true, true>(lds, g, S, E);
        } }
    SEAM(5);
    for (int rep = 0; rep < REPS(6); ++rep) { if (rep) GSYNC();
        if (IN(6)) {
            pg8::Gemm g{(const bf16_t*)(ws + WS_MRG), (const bf16_t*)(ws + WS_WTO), TP, DM, DM, DM / 64, 0}; pg8::StaticOrder S; S.init(TP, DM, G, bid);
            pg8::EpiZ E{(bf16_t*)(ws + WS_Z), (float*)(ws + WS_SSP)};
            pg8::gemm_phase<pg8::EpiZ, pg8::StaticOrder, true, true>(lds, g, S, E);
        } }
    SEAM(6);
    for (int rep = 0; rep < REPS(7); ++rep) { if (rep) GSYNC();
        if (IN(7)) {
            const int nsk = (G > 64) ? 32 : 0;
            if (bid >= G - nsk) { for (int r2 = 0; r2 < 1 + MK_SK; ++r2) skinny_gemm<3>(p, lds, bid - (G - nsk), nsk); }
            else phase_final(p, 0, TP, bid, G - nsk);
            if (nsk == 0) skinny_gemm<3>(p, lds, bid, G);
        } }
    SEAM(7);
    if (IN(8)) phase_final(p, TP, MT, bid, G);
    for (int x = 0; x < MK_XSYNC; ++x) GSYNC();
#undef IN
#undef SEAM
#undef GSYNC
#undef REPS
}

extern "C" void kernel_launch(void* const* d_in, const int* in_sizes, int n_in, void* d_out, int out_size, void* d_ws, size_t ws_size, hipStream_t stream) {
    static int grid = 0;
    if (grid == 0) {
        if (n_in != 15 || (size_t)out_size != O_END || ws_size < WS_END) { fprintf(stderr, "kernel_launch: unexpected shapes: n_in %d out %d ws %zu (need %zu)\n", n_in, out_size, ws_size, (size_t)WS_END); grid = -1; return; }
        int dev = 0, cus = 0, per_cu = 0;
        if (hipGetDevice(&dev) != hipSuccess || hipDeviceGetAttribute(&cus, hipDeviceAttributeMultiprocessorCount, dev) != hipSuccess) { fprintf(stderr, "kernel_launch: device query failed\n"); grid = -1; return; }
        if (hipFuncSetAttribute((const void*)mega, hipFuncAttributeMaxDynamicSharedMemorySize, LDS_BYTES) != hipSuccess) { fprintf(stderr, "kernel_launch: hipFuncSetAttribute failed\n"); grid = -1; return; }
        if (hipOccupancyMaxActiveBlocksPerMultiprocessor(&per_cu, (const void*)mega, 512, LDS_BYTES) != hipSuccess || per_cu < 1) { fprintf(stderr, "kernel_launch: occupancy query says %d\n", per_cu); per_cu = 1; }
        (void)hipGetLastError();
        grid = cus * per_cu;
        fprintf(stderr, "kernel_launch: grid %d (cus %d x %d)\n", grid, cus, per_cu);
    }
    if (grid < 0) return;
    (void)hipMemsetAsync(d_ws, 0, WS_CTLB, stream);
    Params p{};
    p.xp = (const float*)d_in[0]; p.xs = (const float*)d_in[1]; p.st0 = (const float*)d_in[2]; p.lbl = (const float*)d_in[3]; p.gpre = (const float*)d_in[4]; p.win = (const float*)d_in[5];
    p.lng = (const float*)d_in[6]; p.lnb = (const float*)d_in[7]; p.wsp = (const float*)d_in[8]; p.bsp = (const float*)d_in[9]; p.gon = (const float*)d_in[10]; p.wpa = (const float*)d_in[11];
    p.wpb = (const float*)d_in[12]; p.wo = (const float*)d_in[13]; p.gpost = (const float*)d_in[14];
    p.out = (float*)d_out; p.ws = (unsigned char*)d_ws;
#if MK_MULTI
    for (int ph = 0; ph < NPH; ++ph) { p.lo = ph; p.hi = ph + 1; hipLaunchKernelGGL(mega, dim3(grid), dim3(512), LDS_BYTES, stream, p); }
#else
    p.lo = 0; p.hi = NPH;
    void* args[] = {&p};
    hipError_t e = hipLaunchCooperativeKernel((const void*)mega, dim3(grid), dim3(512), args, LDS_BYTES, stream);
    if (e != hipSuccess) fprintf(stderr, "kernel_launch: cooperative launch failed: %s (grid %d)\n", hipGetErrorString(e), grid);
#endif
}
```

```cpp
#include <hip/hip_runtime.h>
#include <hip/hip_cooperative_groups.h>
#include <cstdio>
#include <cstdint>
namespace cg = cooperative_groups;

#ifndef MK_MULTI
#define MK_MULTI 0
#endif

#ifndef G1ORDER
#define G1ORDER StaticOrder
#endif
#ifndef MK_DELAY_US
#define MK_DELAY_US 0
#endif
#ifndef MK_REP
#define MK_REP 0
#endif
#ifndef MK_SUB
#define MK_SUB 0
#endif
#ifndef MK_XSYNC
#define MK_XSYNC 0
#endif
#ifndef MK_SK
#define MK_SK 0
#endif
#ifndef MK_DUMP
#define MK_DUMP 0
#endif

constexpr int DM = 4096, NC = 22528, TP = 8192, TS = 128, MT = TP + TS, MP = 8448, EA = 2048;
constexpr int COL_U = 0, COL_V = 2048, COL_ZA = 4096, COL_Q = 6144, COL_F = 8192, COL_I = 10240, COL_ZB = 12288, COL_GA = 14336, COL_GB = 18432;
constexpr float EPS = 1e-6f;
constexpr size_t WS_CTLB = 65536;
constexpr size_t WS_WTIN = WS_CTLB;
constexpr size_t WS_WTAB = WS_WTIN + (size_t)NC * DM * 2;
constexpr size_t WS_WTO  = WS_WTAB + (size_t)DM * DM * 2;
constexpr size_t WS_XN   = WS_WTO + (size_t)DM * DM * 2;
constexpr size_t WS_H    = WS_XN + (size_t)MP * DM * 2;
constexpr size_t WS_YAB  = WS_H + (size_t)MP * NC * 2;
constexpr size_t WS_MRG  = WS_YAB + (size_t)MP * DM * 2;
constexpr size_t WS_SN   = WS_MRG;
constexpr size_t WS_Z    = WS_MRG + (size_t)MP * DM * 2;
constexpr size_t WS_LNP  = WS_Z + (size_t)MP * DM * 2;
constexpr size_t WS_SSP  = WS_LNP + (size_t)MP * 64 * 4;
constexpr size_t WS_WSM  = WS_SSP + (size_t)MP * 64 * 4;
constexpr size_t WS_QT0  = WS_WSM + (size_t)16 * 128 * 128 * 2;
constexpr size_t WS_KTT  = WS_QT0 + (size_t)TP * EA * 2;
constexpr size_t WS_ITT  = WS_KTT + (size_t)TP * EA * 2;
constexpr size_t WS_OIN  = WS_ITT + (size_t)TP * EA * 2;
constexpr size_t WS_DEC  = WS_OIN + (size_t)TP * EA * 4;
constexpr size_t WS_LNPS = WS_DEC + (size_t)2048 * 128 * 4;
constexpr size_t WS_SSPS = WS_LNPS + (size_t)128 * 256 * 4;
constexpr size_t WS_END  = WS_SSPS + (size_t)128 * 256 * 4;
constexpr size_t O_YP = 0, O_YS = O_YP + (size_t)TP * DM, O_SP = O_YS + (size_t)TS * DM, O_SS = O_SP + (size_t)4 * 16 * 128 * 128,
                 O_VP = O_SS + (size_t)128 * 16 * 128 * 128, O_VS = O_VP + (size_t)4 * 128 * EA, O_END = O_VS + (size_t)128 * EA;
constexpr int LDS_STAGE = 128 * 1024, LDS_BYTES = LDS_STAGE + 256;

#define LAS __attribute__((address_space(3)))
#define XB_TMO      128
#define XB_XCNT(j)  (256  + 64 * (j))
#define XB_XSUB(j)  (1280 + 64 * (j))
#define XB_XGEN(j)  (2304 + 64 * (j))
#define XB_TOP      3328
#define XB_TOPGEN   3392
#define XCD_BAR_WORDS 3456
#define XB_SPIN_CAP (1u << 18)

__device__ __forceinline__ unsigned xb_ld(unsigned* p)              { return __hip_atomic_load(p, __ATOMIC_RELAXED, __HIP_MEMORY_SCOPE_AGENT); }
__device__ __forceinline__ unsigned xb_add(unsigned* p, unsigned v) { return __hip_atomic_fetch_add(p, v, __ATOMIC_RELAXED, __HIP_MEMORY_SCOPE_AGENT); }
__device__ __forceinline__ unsigned xb_xcc_id() { return (unsigned)__builtin_amdgcn_s_getreg((3 << 11) | 20) & 0xFu; }
#define XB_SPIN(cond, bar) do { unsigned _sp = 0; while (cond) { __builtin_amdgcn_s_sleep(1); \
    if ((++_sp & 255u) == 0u) { if (xb_ld(&(bar)[XB_TMO])) break; if (_sp > XB_SPIN_CAP) { atomicAdd(&(bar)[XB_TMO], 1u); break; } } } } while (0)

struct XcdBarrier {
    unsigned* bar; unsigned x;
    volatile LAS unsigned* st;
};

__device__ __forceinline__ XcdBarrier xcd_barrier_post(unsigned* bar, volatile LAS unsigned* st) {
    XcdBarrier b; b.bar = bar; b.x = xb_xcc_id(); b.st = st;
    if (threadIdx.x == 0) (void)xb_add(&bar[XB_XCNT(b.x)], 1u);
    return b;
}
__device__ __forceinline__ void xcd_barrier_complete(unsigned* bar, unsigned x, unsigned& nloc, unsigned& nx) {
    const unsigned G = gridDim.x * gridDim.y * gridDim.z;
    unsigned sum, cnt, mine, sp = 0u;
    for (;;) {
        sum = 0u; cnt = 0u; mine = 0u;
#pragma unroll
        for (unsigned j = 0; j < 16; ++j) { const unsigned c = xb_ld(&bar[XB_XCNT(j)]); sum += c; cnt += (c > 0u) ? 1u : 0u; mine = (j == x) ? c : mine; }
        if (sum == G) break;
        __builtin_amdgcn_s_sleep(1);
        if ((++sp & 255u) == 0u) { if (xb_ld(&bar[XB_TMO])) break; if (sp > XB_SPIN_CAP) { atomicAdd(&bar[XB_TMO], 1u); break; } }
    }
    nloc = mine > 0u ? mine : 1u; nx = cnt > 0u ? cnt : 1u;
}

__device__ __forceinline__ void xcd_barrier(const XcdBarrier& b) {
    asm volatile("s_waitcnt vmcnt(0)" ::: "memory");
    __syncthreads();
    if (threadIdx.x == 0) {
        unsigned* bar = b.bar;
        __builtin_amdgcn_s_waitcnt(0);
        unsigned nloc = b.st[0], nx = b.st[1];
        if (nloc == 0u) { xcd_barrier_complete(bar, b.x, nloc, nx); b.st[0] = nloc; b.st[1] = nx; }
        const unsigned old = xb_add(&bar[XB_XSUB(b.x)], 1u);
        const unsigned gen = old / nloc;
        if (old + 1u == (gen + 1u) * nloc) {
            __builtin_amdgcn_fence(__ATOMIC_RELEASE, "agent");
            asm volatile("s_waitcnt vmcnt(0)" ::: "memory");
            const unsigned og = xb_add(&bar[XB_TOP], 1u);
            const unsigned tg = og / nx;
            if (og + 1u == (tg + 1u) * nx) xb_add(&bar[XB_TOPGEN], 1u);
            else XB_SPIN(xb_ld(&bar[XB_TOPGEN]) == tg, bar);
            __builtin_amdgcn_fence(__ATOMIC_ACQUIRE, "agent");
            xb_add(&bar[XB_XGEN(b.x)], 1u);
            asm volatile("s_waitcnt vmcnt(0)" ::: "memory");
        } else {
            XB_SPIN(xb_ld(&bar[XB_XGEN(b.x)]) == gen, bar);
            __builtin_amdgcn_fence(__ATOMIC_ACQUIRE, "agent");
            asm volatile("s_waitcnt vmcnt(0)" ::: "memory");
        }
    }
    __syncthreads();
}

namespace pg8 {
#define PG8_LAS __attribute__((address_space(3)))
typedef unsigned short bf16_t;
typedef short bf16x8 __attribute__((ext_vector_type(8)));
typedef float f32x4 __attribute__((ext_vector_type(4)));
typedef unsigned u32x4 __attribute__((ext_vector_type(4)));
constexpr int BM = 256, BK = 64, HALF = 128, HTB = HALF * BK * 2  , STAGE_BYTES = 8 * HTB, NXCD = 8, WGM = 8;

__host__ __device__ __forceinline__ int lds_byte(int r, int c) { const int st = (r >> 4) * 2 + (c >> 5), rr = r & 15, cc = c & 31, ob = rr * 64 + cc * 2; return st * 1024 + (ob ^ (((ob >> 9) & 1) << 5)); }
__host__ __device__ __forceinline__ void stage_rc(int b, int& R, int& C) { const int st = b / 1024, sb = b % 1024, swz = sb ^ (((sb >> 9) & 1) << 5); R = (st >> 1) * 16 + swz / 64; C = (st & 1) * 32 + (swz % 64) / 2; }
__host__ __device__ __forceinline__ int perm32(int rho) { const int n = rho >> 4, i = rho & 15; return 8 * (i >> 2) + 4 * n + (i & 3); }

struct Unit { int pm, pn, kh; };
struct Gemm { const bf16_t* A; const bf16_t* Bt; int M, N, K, nt; size_t khoff; };

struct StaticOrder {
    int nM, nN, nwg, G, c;
    __host__ __device__ void init(int M, int N, int G_, int c_) { nM = M / BM; nN = N / BM; nwg = nM * nN; G = G_; c = c_; }
    __host__ __device__ bool next(int i, Unit& u) const {
        const long L = (long)i * G + c; if (L >= nwg) return false;
        int wgid = (int)L; { const int q = nwg / NXCD, r = nwg % NXCD, xcd = wgid % NXCD, off = wgid / NXCD; wgid = (xcd < r ? xcd * (q + 1) : r * (q + 1) + (xcd - r) * q) + off; }
        const int nig = WGM * nN, gid = wgid / nig, fm = gid * WGM, gsz = (nM - fm) < WGM ? (nM - fm) : WGM;
        u.pm = fm + ((wgid % nig) % gsz); u.pn = (wgid % nig) / gsz; u.kh = 0; return true;
    }
    __device__ __forceinline__ void a_ready(const Unit&) const {}
    __device__ __forceinline__ void done(const Unit&) const {}
};

typedef float f32x2 __attribute__((ext_vector_type(2)));
typedef __bf16 bf16x2_t __attribute__((ext_vector_type(2)));
__device__ __forceinline__ unsigned cvt_pk_bf16(float lo, float hi) { const f32x2 v = {lo, hi}; return __builtin_bit_cast(unsigned, __builtin_convertvector(v, bf16x2_t)); }
__device__ __forceinline__ float bf2f(unsigned short b) { return __builtin_bit_cast(float, (unsigned)b << 16); }
__device__ __forceinline__ float f_lo(unsigned w) { return __builtin_bit_cast(float, w << 16); }
__device__ __forceinline__ float f_hi(unsigned w) { return __builtin_bit_cast(float, w & 0xffff0000u); }
__device__ __forceinline__ float fsigmoid(float x) { return __builtin_amdgcn_rcpf(1.0f + __expf(-x)); }
__device__ __forceinline__ float fsilu(float x) { return x * fsigmoid(x); }
__device__ __forceinline__ float fgelu(float x) { return x * fsigmoid(1.5957691216057308f * (x + 0.044715f * x * x * x)); }

struct EpiAct {
    static constexpr bool PERM = true, AFTER_DRAIN = false, CARRY = false;
    bf16_t* H; const float* lbl; float* lnp;
    template <int ACT> __device__ __forceinline__ void run(const f32x4 (&acc)[2][2][4][2], const Unit& u, int wr, int wc, int fr, int fq) const {
        const int row0 = u.pm * BM + wr * 64 + fr, col0 = u.pn * BM + wc * 32 + 8 * fq;
        float lb[2][8];
        if (ACT == 3) {
#pragma unroll
            for (int bj = 0; bj < 2; ++bj) { const float* l0 = lbl + (col0 + bj * HALF - 8192); const f32x4 a0 = *(const f32x4*)l0, a1 = *(const f32x4*)(l0 + 4), b0 = *(const f32x4*)(l0 + 2048), b1 = *(const f32x4*)(l0 + 2052);
#pragma unroll
                for (int k = 0; k < 4; ++k) { lb[bj][k] = __builtin_amdgcn_rcpf(1.0f + __expf(b0[k] - a0[k])); lb[bj][4 + k] = __builtin_amdgcn_rcpf(1.0f + __expf(b1[k] - a1[k])); } }
        }
#pragma unroll
        for (int ai = 0; ai < 2; ++ai)
#pragma unroll
            for (int m = 0; m < 4; ++m) { const int row = row0 + ai * HALF + m * 16; bf16_t* rowp = H + (size_t)row * 22528 + col0; float s1 = 0.f, s2 = 0.f;
#pragma unroll
                for (int bj = 0; bj < 2; ++bj) { float v[8];
#pragma unroll
                    for (int k = 0; k < 4; ++k) { v[k] = acc[ai][bj][m][0][k]; v[4 + k] = acc[ai][bj][m][1][k]; }
#pragma unroll
                    for (int k = 0; k < 8; ++k) {
                        if (ACT == 0 || ACT == 1) v[k] = fgelu(v[k]);
                        if (ACT == 2) v[k] = fsilu(v[k]);
                        if (ACT == 3) v[k] = __logf(lb[bj][k] + (1.0f - lb[bj][k]) * fsigmoid(v[k]));
                        if (ACT == 5) v[k] = fsigmoid(v[k]);
                        if (ACT == 1) { s1 += v[k]; s2 += v[k] * v[k]; }
                    }
                    u32x4 w; w.x = cvt_pk_bf16(v[0], v[1]); w.y = cvt_pk_bf16(v[2], v[3]); w.z = cvt_pk_bf16(v[4], v[5]); w.w = cvt_pk_bf16(v[6], v[7]);
                    *(u32x4*)(rowp + bj * HALF) = w; }
                if (ACT == 1) { s1 += __shfl_xor(s1, 16); s1 += __shfl_xor(s1, 32); s2 += __shfl_xor(s2, 16); s2 += __shfl_xor(s2, 32);
                    if (fq == 0) { f32x2 o; o.x = s1; o.y = s2; *(f32x2*)(lnp + (size_t)row * 64 + ((u.pn - 8) * 4 + wc) * 2) = o; } }
            }
    }
    __device__ __forceinline__ void operator()(const f32x4 (&acc)[2][2][4][2], const Unit& u, int wr, int wc, int fr, int fq) const {
        const int pn = u.pn;
        if (pn < 8) run<0>(acc, u, wr, wc, fr, fq);
        else if (pn < 16) run<1>(acc, u, wr, wc, fr, fq);
        else if (pn < 32) run<2>(acc, u, wr, wc, fr, fq);
        else if (pn < 40) run<3>(acc, u, wr, wc, fr, fq);
        else if (pn < 48) run<4>(acc, u, wr, wc, fr, fq);
        else if (pn < 56) run<2>(acc, u, wr, wc, fr, fq);
        else run<5>(acc, u, wr, wc, fr, fq);
    }
};

struct EpiMerge {
    static constexpr bool PERM = true, AFTER_DRAIN = false, CARRY = true;
    const bf16_t* H; bf16_t* O;
    __device__ __forceinline__ void mid(f32x4 (&acc)[2][2][4][2], const Unit& u, int wr, int wc, int fr, int fq) const {
        const int row0 = u.pm * BM + wr * 64 + fr, col0 = u.pn * BM + wc * 32 + 8 * fq;
#pragma unroll
        for (int ai = 0; ai < 2; ++ai)
#pragma unroll
            for (int m = 0; m < 4; ++m) { const bf16_t* gp = H + (size_t)(row0 + ai * HALF + m * 16) * 22528 + 14336 + col0;
#pragma unroll
                for (int bj = 0; bj < 2; ++bj) { const u32x4 a = *(const u32x4*)(gp + bj * HALF), b = *(const u32x4*)(gp + 4096 + bj * HALF);
                    f32x4 r0, r1;
                    r0[0] = f_lo(a.x) * __builtin_amdgcn_rcpf(f_lo(b.x)); r0[1] = f_hi(a.x) * __builtin_amdgcn_rcpf(f_hi(b.x)); r0[2] = f_lo(a.y) * __builtin_amdgcn_rcpf(f_lo(b.y)); r0[3] = f_hi(a.y) * __builtin_amdgcn_rcpf(f_hi(b.y));
                    r1[0] = f_lo(a.z) * __builtin_amdgcn_rcpf(f_lo(b.z)); r1[1] = f_hi(a.z) * __builtin_amdgcn_rcpf(f_hi(b.z)); r1[2] = f_lo(a.w) * __builtin_amdgcn_rcpf(f_lo(b.w)); r1[3] = f_hi(a.w) * __builtin_amdgcn_rcpf(f_hi(b.w));
                    acc[ai][bj][m][0] *= r0; acc[ai][bj][m][1] *= r1; }
                if (m & 1) asm volatile("" ::: "memory"); }
    }
    __device__ __forceinline__ void operator()(f32x4 (&acc)[2][2][4][2], const Unit& u, int wr, int wc, int fr, int fq) const {
        if (u.kh == 0) { mid(acc, u, wr, wc, fr, fq); return; }
        const int row0 = u.pm * BM + wr * 64 + fr, col0 = u.pn * BM + wc * 32 + 8 * fq;
#pragma unroll
        for (int ai = 0; ai < 2; ++ai)
#pragma unroll
            for (int m = 0; m < 4; ++m) { const int row = row0 + ai * HALF + m * 16; const bf16_t* gp = H + (size_t)row * 22528 + 18432 + col0; bf16_t* rowp = O + (size_t)row * 4096 + col0;
#pragma unroll
                for (int bj = 0; bj < 2; ++bj) { const u32x4 b = *(const u32x4*)(gp + bj * HALF); const f32x4 v0 = acc[ai][bj][m][0], v1 = acc[ai][bj][m][1];
                    u32x4 w; w.x = cvt_pk_bf16(v0[0] * f_lo(b.x), v0[1] * f_hi(b.x)); w.y = cvt_pk_bf16(v0[2] * f_lo(b.y), v0[3] * f_hi(b.y));
                    w.z = cvt_pk_bf16(v1[0] * f_lo(b.z), v1[1] * f_hi(b.z)); w.w = cvt_pk_bf16(v1[2] * f_lo(b.w), v1[3] * f_hi(b.w));
                    *(u32x4*)(rowp + bj * HALF) = w; }
                if (m & 1) asm volatile("" ::: "memory"); }
    }
};

struct EpiZ {
    static constexpr bool PERM = true, AFTER_DRAIN = false, CARRY = false;
    bf16_t* Z; float* ssp;
    __device__ __forceinline__ void operator()(const f32x4 (&acc)[2][2][4][2], const Unit& u, int wr, int wc, int fr, int fq) const {
        const int row0 = u.pm * BM + wr * 64 + fr, col0 = u.pn * BM + wc * 32 + 8 * fq;
#pragma unroll
        for (int ai = 0; ai < 2; ++ai)
#pragma unroll
            for (int m = 0; m < 4; ++m) { const int row = row0 + ai * HALF + m * 16; bf16_t* rowp = Z + (size_t)row * 4096 + col0; float ss = 0.f;
#pragma unroll
                for (int bj = 0; bj < 2; ++bj) { const f32x4 v0 = acc[ai][bj][m][0], v1 = acc[ai][bj][m][1];
                    ss += (v0[0] * v0[0] + v0[1] * v0[1]) + (v0[2] * v0[2] + v0[3] * v0[3]) + (v1[0] * v1[0] + v1[1] * v1[1]) + (v1[2] * v1[2] + v1[3] * v1[3]);
                    u32x4 w; w.x = cvt_pk_bf16(v0[0], v0[1]); w.y = cvt_pk_bf16(v0[2], v0[3]); w.z = cvt_pk_bf16(v1[0], v1[1]); w.w = cvt_pk_bf16(v1[2], v1[3]);
                    *(u32x4*)(rowp + bj * HALF) = w; }
                ss += __shfl_xor(ss, 16); ss += __shfl_xor(ss, 32);
                if (fq == 0) ssp[(size_t)row * 64 + u.pn * 4 + wc] = ss; }
    }
};

struct PairOrder : StaticOrder {
    __device__ bool next(int i, Unit& u) const { if (!StaticOrder::next(i >> 1, u)) return false; u.kh = i & 1; return true; }
};

struct RevOrder : StaticOrder {
    __device__ bool next(int i, Unit& u) const { if (!StaticOrder::next(i, u)) return false; u.pn = nN - 1 - u.pn; return true; }
};

template <class Epi, class Sched, bool ALIGN_EPI = false, bool SP2 = false>
__device__ __forceinline__ void gemm_phase(PG8_LAS unsigned char* lds, const Gemm g, const Sched& S, const Epi& E) {
    int tid_o = threadIdx.x; asm volatile("" : "+v"(tid_o));
    const int tid = tid_o, wid = __builtin_amdgcn_readfirstlane(tid >> 6), lane = tid & 63, wr = wid >> 2, wc = wid & 3, fr = lane & 15, fq = lane >> 4;
    const int K = g.K, nt = g.nt;
    unsigned voffA[2], voffB[2];
#pragma unroll
    for (int i = 0; i < 2; ++i) { int R, C; stage_rc(tid * 16 + i * 8192, R, C); const int Rb = Epi::PERM ? ((R & ~31) + perm32(R & 31)) : R;
        voffA[i] = (unsigned)(R * K + C) * 2u; voffB[i] = (unsigned)(Rb * K + C) * 2u; }
    const size_t kstep = (size_t)(BK * 2);
    const size_t hstep = (size_t)HALF * K * 2;
    const size_t tstep = 2 * hstep;
    const unsigned ldsw = (unsigned)wid * 1024u;
    const int aoff = lds_byte(wr * 64 + fr, fq * 8), boff = lds_byte(wc * 32 + fr, fq * 8);
#define PG8_SA(b, h) (((b) * 2 + (h)) * HTB)
#define PG8_SB(b, h) ((4 + (b) * 2 + (h)) * HTB)
#define PG8_STAGE(bufoff, gbase, voff) do { _Pragma("unroll") for (int _i = 0; _i < 2; ++_i) \
        __builtin_amdgcn_global_load_lds((const unsigned*)((const char*)(gbase) + (voff)[_i]), (PG8_LAS unsigned*)(lds + (bufoff) + ldsw + _i * 8192), 16, 0, 0); } while (0)
#define PG8_LDA(dst, b, h) do { _Pragma("unroll") for (int m = 0; m < 4; ++m) _Pragma("unroll") for (int k = 0; k < 2; ++k) dst[m][k] = *(const PG8_LAS bf16x8*)(lds + PG8_SA(b, h) + aoff + m * 2048 + k * 1024); } while (0)
#define PG8_LDB(dst, b, h) do { _Pragma("unroll") for (int n = 0; n < 2; ++n) _Pragma("unroll") for (int k = 0; k < 2; ++k) dst[n][k] = *(const PG8_LAS bf16x8*)(lds + PG8_SB(b, h) + boff + n * 2048 + k * 1024); } while (0)
#define PG8_MMA(ai, bj, At, Bt) do { __builtin_amdgcn_s_setprio(1); _Pragma("unroll") for (int m = 0; m < 4; ++m) _Pragma("unroll") for (int n = 0; n < 2; ++n) _Pragma("unroll") for (int k = 0; k < 2; ++k) \
        acc[ai][bj][m][n] = __builtin_amdgcn_mfma_f32_16x16x32_bf16(Bt[n][k], At[m][k], acc[ai][bj][m][n], 0, 0, 0); __builtin_amdgcn_s_setprio(0); } while (0)
#define PG8_WAIT_V(n) asm volatile("s_waitcnt vmcnt(" #n ")" ::: "memory")
#define PG8_WAIT_L(n) asm volatile("s_waitcnt lgkmcnt(" #n ")" ::: "memory")
#define PG8_BAR __builtin_amdgcn_s_barrier()
#define PG8_SCHED __builtin_amdgcn_sched_barrier(0)
    Unit cur, nxt; int ui = 0;
    if (!S.next(0, cur)) return;
    f32x4 acc[2][2][4][2];
#pragma unroll
    for (int a = 0; a < 2; ++a)
#pragma unroll
        for (int b = 0; b < 2; ++b)
#pragma unroll
            for (int m = 0; m < 4; ++m)
#pragma unroll
                for (int n = 0; n < 2; ++n) acc[a][b][m][n] = (f32x4){0.f, 0.f, 0.f, 0.f};
    bf16x8 At[4][2], B0[2][2], B1[2][2];
    const char* cA = (const char*)g.A + (size_t)cur.pm * tstep + (size_t)cur.kh * g.khoff; const char* cB = (const char*)g.Bt + (size_t)cur.pn * tstep + (size_t)cur.kh * g.khoff;
    S.a_ready(cur);
    if constexpr (SP2) {
        PG8_STAGE(PG8_SB(0, 0), cB, voffB); PG8_STAGE(PG8_SB(0, 1), cB + hstep, voffB); PG8_STAGE(PG8_SA(0, 0), cA, voffA); PG8_STAGE(PG8_SA(0, 1), cA + hstep, voffA);
        if (wr == 1) PG8_BAR;
        PG8_WAIT_V(2); PG8_BAR;
        PG8_STAGE(PG8_SB(1, 0), cB + kstep, voffB); PG8_STAGE(PG8_SA(1, 0), cA + kstep, voffA); PG8_STAGE(PG8_SB(1, 1), cB + hstep + kstep, voffB);
        PG8_WAIT_V(6); PG8_BAR;
    } else {
        PG8_STAGE(PG8_SB(0, 0), cB, voffB); PG8_STAGE(PG8_SA(0, 0), cA, voffA); PG8_STAGE(PG8_SB(0, 1), cB + hstep, voffB); PG8_STAGE(PG8_SA(0, 1), cA + hstep, voffA);
        if (wr == 1) PG8_BAR;
        PG8_WAIT_V(4); PG8_BAR;
        PG8_STAGE(PG8_SB(1, 0), cB + kstep, voffB); PG8_STAGE(PG8_SA(1, 0), cA + kstep, voffA); PG8_STAGE(PG8_SB(1, 1), cB + hstep + kstep, voffB);
        PG8_WAIT_V(6); PG8_BAR;
    }
    for (;;) {
        const bool has_next = S.next(ui + 1, nxt);
        const char* nA = has_next ? (const char*)g.A + (size_t)nxt.pm * tstep + (size_t)nxt.kh * g.khoff : cA; const char* nB = has_next ? (const char*)g.Bt + (size_t)nxt.pn * tstep + (size_t)nxt.kh * g.khoff : cB;
        for (int t = 0; t < nt; t += 2) {
            const bool last = (t == nt - 2);
            const char* a1 = cA + (size_t)(t + 1) * kstep;
            const char* a2 = last ? nA : cA + (size_t)(t + 2) * kstep; const char* b2 = last ? nB : cB + (size_t)(t + 2) * kstep;
            const char* a3 = a2 + kstep; const char* b3 = b2 + kstep;
            if (last && has_next) S.a_ready(nxt);
            if constexpr (SP2) {
            PG8_LDB(B0, 0, 0); PG8_LDB(B1, 0, 1); PG8_SCHED; PG8_LDA(At, 0, 0); PG8_STAGE(PG8_SA(1, 1), a1 + hstep, voffA);
            PG8_WAIT_V(8); PG8_WAIT_L(0); PG8_BAR; PG8_MMA(0, 0, At, B0); PG8_MMA(0, 1, At, B1); PG8_BAR; PG8_SCHED;
            PG8_LDA(At, 0, 1); PG8_STAGE(PG8_SB(0, 0), b2, voffB); PG8_STAGE(PG8_SB(0, 1), b2 + hstep, voffB); PG8_STAGE(PG8_SA(0, 0), a2, voffA);
            PG8_WAIT_V(8); PG8_WAIT_L(0); PG8_BAR; PG8_MMA(1, 0, At, B0); PG8_MMA(1, 1, At, B1); PG8_BAR; PG8_SCHED;
            PG8_LDB(B0, 1, 0); PG8_LDB(B1, 1, 1); PG8_SCHED; PG8_LDA(At, 1, 0); PG8_STAGE(PG8_SA(0, 1), a2 + hstep, voffA);
            PG8_WAIT_V(8); PG8_WAIT_L(0); PG8_BAR; PG8_MMA(0, 0, At, B0); PG8_MMA(0, 1, At, B1); PG8_BAR; PG8_SCHED;
            PG8_LDA(At, 1, 1); PG8_STAGE(PG8_SB(1, 0), b3, voffB); PG8_STAGE(PG8_SB(1, 1), b3 + hstep, voffB); PG8_STAGE(PG8_SA(1, 0), a3, voffA);
            PG8_WAIT_V(8); PG8_WAIT_L(0); PG8_BAR; PG8_MMA(1, 0, At, B0); PG8_MMA(1, 1, At, B1); PG8_BAR; PG8_SCHED;
            } else {
            PG8_LDB(B0, 0, 0); PG8_SCHED; PG8_LDA(At, 0, 0); PG8_STAGE(PG8_SA(1, 1), a1 + hstep, voffA);
            PG8_WAIT_L(8); PG8_BAR; PG8_WAIT_L(0); PG8_MMA(0, 0, At, B0); PG8_BAR; PG8_SCHED;
            PG8_LDB(B1, 0, 1); PG8_STAGE(PG8_SB(0, 0), b2, voffB);
            PG8_BAR; PG8_WAIT_L(0); PG8_MMA(0, 1, At, B1); PG8_BAR;
            PG8_LDA(At, 0, 1); PG8_STAGE(PG8_SA(0, 0), a2, voffA);
            PG8_BAR; PG8_WAIT_L(0); PG8_MMA(1, 0, At, B0); PG8_BAR; PG8_SCHED;
            PG8_STAGE(PG8_SB(0, 1), b2 + hstep, voffB);
            PG8_WAIT_V(6); PG8_BAR; PG8_MMA(1, 1, At, B1); PG8_BAR;
            PG8_LDB(B0, 1, 0); PG8_SCHED; PG8_LDA(At, 1, 0); PG8_STAGE(PG8_SA(0, 1), a2 + hstep, voffA);
            PG8_WAIT_L(8); PG8_BAR; PG8_WAIT_L(0); PG8_MMA(0, 0, At, B0); PG8_BAR; PG8_SCHED;
            PG8_LDB(B1, 1, 1); PG8_STAGE(PG8_SB(1, 0), b3, voffB);
            PG8_BAR; PG8_WAIT_L(0); PG8_MMA(0, 1, At, B1); PG8_BAR;
            PG8_LDA(At, 1, 1); PG8_STAGE(PG8_SA(1, 0), a3, voffA);
            PG8_BAR; PG8_WAIT_L(0); PG8_MMA(1, 0, At, B0); PG8_BAR; PG8_SCHED;
            PG8_STAGE(PG8_SB(1, 1), b3 + hstep, voffB);
            PG8_WAIT_V(6); PG8_BAR; PG8_MMA(1, 1, At, B1); PG8_BAR;
            }
        }
        if constexpr (ALIGN_EPI) { if (wr == 0) PG8_BAR; }
        if constexpr (!Epi::AFTER_DRAIN) { E(acc, cur, wr, wc, fr, fq); S.done(cur); }
        if (!has_next) break;
        if (!(Epi::CARRY && cur.kh == 0)) {
#pragma unroll
        for (int a = 0; a < 2; ++a)
#pragma unroll
            for (int b = 0; b < 2; ++b)
#pragma unroll
                for (int m = 0; m < 4; ++m)
#pragma unroll
                    for (int n = 0; n < 2; ++n) acc[a][b][m][n] = (f32x4){0.f, 0.f, 0.f, 0.f};
        }
        cur = nxt; cA = nA; cB = nB; ++ui;
        if constexpr (ALIGN_EPI) { if (wr == 1) PG8_BAR; }
    }
    PG8_WAIT_V(0);
    if constexpr (!ALIGN_EPI) { if (wr == 0) PG8_BAR; }
    PG8_BAR;
    if constexpr (Epi::AFTER_DRAIN) { E.fused(acc, cur, wr, wc, fr, fq, lds, wid, lane); S.done(cur); }
#undef PG8_SA
#undef PG8_SB
#undef PG8_STAGE
#undef PG8_LDA
#undef PG8_LDB
#undef PG8_MMA
#undef PG8_WAIT_V
#undef PG8_WAIT_L
#undef PG8_BAR
#undef PG8_SCHED
}
}

using pg8::bf16_t; using pg8::bf16x8; using pg8::f32x4; using pg8::u32x4; using pg8::f32x2; using pg8::cvt_pk_bf16; using pg8::bf2f; using pg8::f_lo; using pg8::f_hi;
typedef unsigned u32x2 __attribute__((ext_vector_type(2)));
#define LDS_WAIT() asm volatile("s_waitcnt lgkmcnt(0)" ::: "memory")
#define MFMA16(X, Y, C) __builtin_amdgcn_mfma_f32_16x16x32_bf16((X), (Y), (C), 0, 0, 0)

struct Params {
    const float *xp, *xs, *st0, *lbl, *gpre, *win, *lng, *lnb, *wsp, *bsp, *gon, *wpa, *wpb, *wo, *gpost;
    float* out; unsigned char* ws; int lo, hi;
};

__device__ __forceinline__ float wave_sum(float v) {
#pragma unroll
    for (int o = 1; o < 64; o <<= 1) v += __shfl_xor(v, o);
    return v;
}

__device__ __forceinline__ void p0_transpose_item(const float* W, int N, bf16_t* WT, int ldd, int koff, LAS float* scr, int kb, int nb, int lane) {
    const int k0 = 64 * kb, n0 = 32 * nb;
    float wv[32];
#pragma unroll
    for (int i = 0; i < 32; ++i) wv[i] = __builtin_nontemporal_load(&W[(size_t)(k0 + 2 * i + (lane >> 5)) * N + n0 + (lane & 31)]);
#pragma unroll
    for (int i = 0; i < 32; ++i) scr[(2 * i + (lane >> 5)) * 33 + (lane & 31)] = wv[i];
    LDS_WAIT(); asm volatile("" ::: "memory");
    const int c = lane & 7;
#pragma unroll
    for (int j = 0; j < 4; ++j) { const int n = (lane >> 3) + 8 * j; const LAS float* s = scr + (8 * c) * 33 + n;
        u32x4 o; o.x = cvt_pk_bf16(s[0 * 33], s[1 * 33]); o.y = cvt_pk_bf16(s[2 * 33], s[3 * 33]); o.z = cvt_pk_bf16(s[4 * 33], s[5 * 33]); o.w = cvt_pk_bf16(s[6 * 33], s[7 * 33]);
        *(u32x4*)(WT + (size_t)(n0 + n) * ldd + koff + k0 + 8 * c) = o; }
    LDS_WAIT(); asm volatile("" ::: "memory");
}

__device__ __forceinline__ void phase0(const Params& p, LAS unsigned char* lds) {
    const int tid = threadIdx.x, lane = tid & 63, wid = tid >> 6;
    const int gw = blockIdx.x * 8 + wid, NGW = gridDim.x * 8;
    unsigned char* ws = p.ws;
    bf16_t* WTIN = (bf16_t*)(ws + WS_WTIN); bf16_t* WTAB = (bf16_t*)(ws + WS_WTAB); bf16_t* WTO = (bf16_t*)(ws + WS_WTO);
    bf16_t* XN = (bf16_t*)(ws + WS_XN); bf16_t* YAB = (bf16_t*)(ws + WS_YAB); bf16_t* WSM = (bf16_t*)(ws + WS_WSM);
    LAS float* scr = (LAS float*)(lds + wid * 8448);
    constexpr int I_IN = 64 * 704, I_PA = 32 * 128, I_O = 64 * 128, NIT = I_IN + 2 * I_PA + I_O;
    for (int it = gw; it < NIT; it += NGW) {
        int r = it;
        if (r < I_IN) { p0_transpose_item(p.win, NC, WTIN, DM, 0, scr, r / 704, r % 704, lane); continue; } r -= I_IN;
        if (r < I_PA) { p0_transpose_item(p.wpa, DM, WTAB, DM, 0, scr, r / 128, r % 128, lane); continue; } r -= I_PA;
        if (r < I_PA) { p0_transpose_item(p.wpb, DM, WTAB, DM, 2048, scr, r / 128, r % 128, lane); continue; } r -= I_PA;
        p0_transpose_item(p.wo, DM, WTO, DM, 0, scr, r / 128, r % 128, lane);
    }
    for (int m = gw; m < MP; m += NGW) {
        u32x2* o8 = (u32x2*)(XN + (size_t)m * DM) + lane;
        if (m < MT) {
            const float* xr = (m < TP) ? p.xp + (size_t)m * DM : p.xs + (size_t)(m - TP) * DM;
            const f32x4* x4 = (const f32x4*)xr + lane; const f32x4* g4 = (const f32x4*)p.gpre + lane;
            f32x4 v[16]; float s = 0.f;
#pragma unroll
            for (int j = 0; j < 16; ++j) { v[j] = __builtin_nontemporal_load(&x4[64 * j]); s += (v[j][0] * v[j][0] + v[j][1] * v[j][1]) + (v[j][2] * v[j][2] + v[j][3] * v[j][3]); }
            const float rs = __builtin_amdgcn_rsqf(wave_sum(s) * (1.0f / DM) + EPS);
#pragma unroll
            for (int j = 0; j < 16; ++j) { const f32x4 g = g4[64 * j]; u32x2 w; w.x = cvt_pk_bf16(v[j][0] * rs * g[0], v[j][1] * rs * g[1]); w.y = cvt_pk_bf16(v[j][2] * rs * g[2], v[j][3] * rs * g[3]); o8[64 * j] = w; }
        } else {
            u32x2* y8 = (u32x2*)(YAB + (size_t)m * DM) + lane; u32x2 z; z.x = 0u; z.y = 0u;
#pragma unroll
            for (int j = 0; j < 16; ++j) { o8[64 * j] = z; y8[64 * j] = z; }
        }
    }
    for (int i = blockIdx.x * 512 + tid; i < 16 * 128 * 128; i += gridDim.x * 512) { const int s = i & 127, t = (i >> 7) & 127; WSM[i] = (s <= t) ? (bf16_t)(cvt_pk_bf16(p.wsp[i], 0.f) & 0xffffu) : (bf16_t)0; }
}

__device__ __forceinline__ void hgrn_prep_phase(const Params& p, LAS unsigned char* lds, int first, int stride, int end) {
    int tid_o = threadIdx.x; asm volatile("" : "+v"(tid_o));
    const int tid = tid_o, lane = tid & 63, w = tid >> 6, fr = lane & 15, fq = lane >> 4, d = tid & 127, tq = tid >> 7;
    const int pr = tid >> 4, pc = (tid & 15) * 8;
    u32x4 R[6];
#define PREP_LOAD(item_) do { const int h_ = (item_) & 15, n_ = ((item_) >> 4) & 31, b_ = (item_) >> 9; const bf16_t* g_ = (const bf16_t*)(p.ws + WS_H) + (size_t)(b_ * 2048 + n_ * 64 + pr) * NC + COL_Q + h_ * 128 + pc; \
        R[0] = *(const u32x4*)g_; R[1] = *(const u32x4*)(g_ + (size_t)32 * NC); R[2] = *(const u32x4*)(g_ + (COL_F - COL_Q)); R[3] = *(const u32x4*)(g_ + (size_t)32 * NC + (COL_F - COL_Q)); \
        R[4] = *(const u32x4*)(g_ + (COL_I - COL_Q)); R[5] = *(const u32x4*)(g_ + (size_t)32 * NC + (COL_I - COL_Q)); } while (0)
    if (first < end) PREP_LOAD(first);
    for (int item = first; item < end; item += stride) {
    const int h = item & 15, n = (item >> 4) & 31, b = item >> 9;
    const int t0 = b * 2048 + n * 64;
    unsigned char* ws = p.ws;
    bf16_t* QT0 = (bf16_t*)(ws + WS_QT0); bf16_t* KTT = (bf16_t*)(ws + WS_KTT); bf16_t* ITT = (bf16_t*)(ws + WS_ITT); float* OIN = (float*)(ws + WS_OIN); float* DEC = (float*)(ws + WS_DEC);
    LAS bf16_t* Qm = (LAS bf16_t*)lds;
    LAS bf16_t* Km = Qm + 64 * 136;
    LAS bf16_t* ITs = Km + 64 * 136;
    LAS bf16_t* Att = ITs + 128 * 72;
    LAS float* tot = (LAS float*)(Att + 64 * 72);
    LAS bf16_t* Lq = (LAS bf16_t*)(tot + 512);
    LAS bf16_t* Lf = Lq + 64 * 136; LAS bf16_t* Li = Lf + 64 * 136;
    *(LAS u32x4*)(Lq + pr * 136 + pc) = R[0]; *(LAS u32x4*)(Lq + (pr + 32) * 136 + pc) = R[1]; *(LAS u32x4*)(Lf + pr * 136 + pc) = R[2]; *(LAS u32x4*)(Lf + (pr + 32) * 136 + pc) = R[3];
    *(LAS u32x4*)(Li + pr * 136 + pc) = R[4]; *(LAS u32x4*)(Li + (pr + 32) * 136 + pc) = R[5];
    __syncthreads();
    { const int nx = item + stride; if (nx < end) PREP_LOAD(nx); }
    float lf[16], qv[16]; unsigned iv[16];
#pragma unroll
    for (int j = 0; j < 16; ++j) { qv[j] = bf2f(Lq[(tq * 16 + j) * 136 + d]); lf[j] = bf2f(Lf[(tq * 16 + j) * 136 + d]); iv[j] = Li[(tq * 16 + j) * 136 + d]; }
    float run = 0.f, cs[16];
#pragma unroll
    for (int j = 0; j < 16; ++j) { run += lf[j]; cs[j] = run; }
    tot[tq * 128 + d] = run;
    __syncthreads();
    const float t0v = tot[d], t1v = tot[128 + d], t2v = tot[256 + d], t3v = tot[384 + d];
    const float off = (tq > 0 ? t0v : 0.f) + (tq > 1 ? t1v : 0.f) + (tq > 2 ? t2v : 0.f);
    const float bmid = t0v + t1v, blast = (t0v + t1v) + (t2v + t3v);
    unsigned kl[8], ip[8];
#pragma unroll
    for (int j = 0; j < 16; j += 2) {
        float q0[2], klv[2];
#pragma unroll
        for (int jj = 0; jj < 2; ++jj) { const int J = j + jj; const float bj = off + cs[J]; const float f = __expf(lf[J]); const float k = 1.0f - f;
            q0[jj] = qv[J] * __expf(bj); klv[jj] = k * __expf(blast - bj);
            const float qm = qv[J] * __expf(bj - bmid), km = k * __expf(bmid - bj);
            const unsigned pk = cvt_pk_bf16(qm, km);
            Qm[(tq * 16 + J) * 136 + d] = (bf16_t)(pk & 0xffffu); Km[(tq * 16 + J) * 136 + d] = (bf16_t)(pk >> 16);
            QT0[(size_t)(t0 + tq * 16 + J) * EA + h * 128 + d] = (bf16_t)(cvt_pk_bf16(q0[jj], 0.f) & 0xffffu); }
        kl[j >> 1] = cvt_pk_bf16(klv[0], klv[1]); ip[j >> 1] = iv[j] | (iv[j + 1] << 16);
    }
    { u32x4 a, c2; a.x = kl[0]; a.y = kl[1]; a.z = kl[2]; a.w = kl[3]; c2.x = kl[4]; c2.y = kl[5]; c2.z = kl[6]; c2.w = kl[7];
      u32x4* kp = (u32x4*)(KTT + ((size_t)item * 128 + d) * 64 + tq * 16); kp[0] = a; kp[1] = c2;
      u32x4 e, f2; e.x = ip[0]; e.y = ip[1]; e.z = ip[2]; e.w = ip[3]; f2.x = ip[4]; f2.y = ip[5]; f2.z = ip[6]; f2.w = ip[7];
      u32x4* ipp = (u32x4*)(ITT + ((size_t)item * 128 + d) * 64 + tq * 16); ipp[0] = e; ipp[1] = f2;
      LAS u32x4* il = (LAS u32x4*)(ITs + d * 72 + tq * 16); il[0] = e; il[1] = f2; }
    if (tq == 0) DEC[(size_t)item * 128 + d] = __expf(blast);
    __syncthreads();
    {
        const int tb = w >> 1;
#pragma unroll
        for (int x = 0; x < 2; ++x) { const int sb = (w & 1) * 2 + x; f32x4 acc = {0.f, 0.f, 0.f, 0.f};
            if (sb <= tb) {
#pragma unroll
                for (int ks = 0; ks < 4; ++ks) { const bf16x8 X = *(const LAS bf16x8*)(Km + (sb * 16 + fr) * 136 + ks * 32 + fq * 8), Y = *(const LAS bf16x8*)(Qm + (tb * 16 + fr) * 136 + ks * 32 + fq * 8); acc = MFMA16(X, Y, acc); }
                const int t = tb * 16 + fr, s0 = sb * 16 + fq * 4;
#pragma unroll
                for (int j = 0; j < 4; ++j) acc[j] = (s0 + j <= t) ? acc[j] : 0.f;
            }
            u32x2 o; o.x = cvt_pk_bf16(acc[0], acc[1]); o.y = cvt_pk_bf16(acc[2], acc[3]);
            *(LAS u32x2*)(Att + (tb * 16 + fr) * 72 + sb * 16 + fq * 4) = o; }
    }
    __syncthreads();
    {
        const int eb = w;
#pragma unroll
        for (int tb = 0; tb < 4; ++tb) { f32x4 acc = {0.f, 0.f, 0.f, 0.f};
#pragma unroll
            for (int ks = 0; ks < 2; ++ks) { if (ks * 32 <= tb * 16 + 15) { const bf16x8 X = *(const LAS bf16x8*)(ITs + (eb * 16 + fr) * 72 + ks * 32 + fq * 8), Y = *(const LAS bf16x8*)(Att + (tb * 16 + fr) * 72 + ks * 32 + fq * 8); acc = MFMA16(X, Y, acc); } }
            *(f32x4*)(OIN + (size_t)(t0 + tb * 16 + fr) * EA + h * 128 + eb * 16 + fq * 4) = acc; }
    }
    __syncthreads();
    }
#undef PREP_LOAD
}

__device__ __forceinline__ void hgrn_scan_item(const Params& p, LAS unsigned char* lds, int bh) {
    const int tid = threadIdx.x, lane = tid & 63, w = tid >> 6, fr = lane & 15, fq = lane >> 4;
    const int b = bh >> 4, h = bh & 15;
    unsigned char* ws = p.ws;
    const bf16_t* H = (const bf16_t*)(ws + WS_H); bf16_t* YAB = (bf16_t*)(ws + WS_YAB);
    const bf16_t* QT0 = (const bf16_t*)(ws + WS_QT0); const bf16_t* KTT = (const bf16_t*)(ws + WS_KTT); const bf16_t* ITT = (const bf16_t*)(ws + WS_ITT);
    const float* OIN = (const float*)(ws + WS_OIN); const float* DEC = (const float*)(ws + WS_DEC);
    LAS bf16_t* ST = (LAS bf16_t*)lds;
    LAS float* ssq = (LAS float*)(lds + 128 * 136 * 2);
    f32x4 S[8];
#pragma unroll
    for (int eb = 0; eb < 8; ++eb) S[eb] = (f32x4){0.f, 0.f, 0.f, 0.f};
    const int tb = w & 3, eh = w >> 2;
    const f32x4 gon[4] = { *(const f32x4*)(p.gon + h * 128 + (eh * 4 + 0) * 16 + fq * 4), *(const f32x4*)(p.gon + h * 128 + (eh * 4 + 1) * 16 + fq * 4),
                           *(const f32x4*)(p.gon + h * 128 + (eh * 4 + 2) * 16 + fq * 4), *(const f32x4*)(p.gon + h * 128 + (eh * 4 + 3) * 16 + fq * 4) };
    for (int n = 0; n < 32; ++n) {
        const int itn = (b * 32 + n) * 16 + h, t = b * 2048 + n * 64 + tb * 16 + fr;
#pragma unroll
        for (int eb = 0; eb < 8; ++eb) { u32x2 o; o.x = cvt_pk_bf16(S[eb][0], S[eb][1]); o.y = cvt_pk_bf16(S[eb][2], S[eb][3]); *(LAS u32x2*)(ST + (eb * 16 + fr) * 136 + w * 16 + fq * 4) = o; }
        __syncthreads();
        bf16x8 Yq[4];
#pragma unroll
        for (int ks = 0; ks < 4; ++ks) Yq[ks] = *(const bf16x8*)(QT0 + (size_t)t * EA + h * 128 + ks * 32 + fq * 8);
        f32x4 o[4]; float ss = 0.f;
#pragma unroll
        for (int el = 0; el < 4; ++el) { f32x4 acc = *(const f32x4*)(OIN + (size_t)t * EA + h * 128 + (eh * 4 + el) * 16 + fq * 4);
#pragma unroll
            for (int ks = 0; ks < 4; ++ks) { const bf16x8 X = *(const LAS bf16x8*)(ST + ((eh * 4 + el) * 16 + fr) * 136 + ks * 32 + fq * 8); acc = MFMA16(X, Yq[ks], acc); }
            o[el] = acc; ss += (acc[0] * acc[0] + acc[1] * acc[1]) + (acc[2] * acc[2] + acc[3] * acc[3]); }
        ss += __shfl_xor(ss, 16); ss += __shfl_xor(ss, 32);
        if (fq == 0) ssq[eh * 64 + tb * 16 + fr] = ss;
        __syncthreads();
        const float rs = __builtin_amdgcn_rsqf((ssq[tb * 16 + fr] + ssq[64 + tb * 16 + fr]) * (1.0f / 128.0f) + EPS);
#pragma unroll
        for (int el = 0; el < 4; ++el) { const int col = h * 128 + (eh * 4 + el) * 16 + fq * 4; const u32x2 zb = *(const u32x2*)(H + (size_t)t * NC + COL_ZB + col);
            u32x2 y; y.x = cvt_pk_bf16(o[el][0] * rs * gon[el][0] * f_lo(zb.x), o[el][1] * rs * gon[el][1] * f_hi(zb.x)); y.y = cvt_pk_bf16(o[el][2] * rs * gon[el][2] * f_lo(zb.y), o[el][3] * rs * gon[el][3] * f_hi(zb.y));
            *(u32x2*)(YAB + (size_t)t * DM + 2048 + col) = y; }
        const f32x4 dec = *(const f32x4*)(DEC + (size_t)itn * 128 + w * 16 + fq * 4);
        const bf16x8 Xk0 = *(const bf16x8*)(KTT + ((size_t)itn * 128 + w * 16 + fr) * 64 + fq * 8), Xk1 = *(const bf16x8*)(KTT + ((size_t)itn * 128 + w * 16 + fr) * 64 + 32 + fq * 8);
#pragma unroll
        for (int eb = 0; eb < 8; ++eb) { const bf16_t* ip = ITT + ((size_t)itn * 128 + eb * 16 + fr) * 64 + fq * 8; const bf16x8 Y0 = *(const bf16x8*)ip, Y1 = *(const bf16x8*)(ip + 32);
            f32x4 a = S[eb] * dec; a = MFMA16(Xk0, Y0, a); a = MFMA16(Xk1, Y1, a); S[eb] = a; }
    }
    float* sp = p.out + O_SP + (size_t)bh * 128 * 128;
#pragma unroll
    for (int eb = 0; eb < 8; ++eb)
#pragma unroll
        for (int j = 0; j < 4; ++j) sp[(size_t)(w * 16 + fq * 4 + j) * 128 + eb * 16 + fr] = S[eb][j];
    __syncthreads();
}

__device__ __forceinline__ void hgrn_state_item(const Params& p, int it) {
    const int tid = threadIdx.x, lane = tid & 63, w = tid >> 6, fr = lane & 15, fq = lane >> 4;
    const int bh = it >> 1, eh = it & 1, b = bh >> 4, h = bh & 15;
    unsigned char* ws = p.ws;
    const bf16_t* KTT = (const bf16_t*)(ws + WS_KTT); const bf16_t* ITT = (const bf16_t*)(ws + WS_ITT); const float* DEC = (const float*)(ws + WS_DEC);
    bf16_t* SN = (bf16_t*)(ws + WS_SN);
    f32x4 S[4];
#pragma unroll
    for (int eb = 0; eb < 4; ++eb) S[eb] = (f32x4){0.f, 0.f, 0.f, 0.f};
    bf16x8 Xk0, Xk1, Y0[4], Y1[4]; f32x4 dec;
    {   const size_t itn = (size_t)(b * 32) * 16 + h;
        dec = *(const f32x4*)(DEC + itn * 128 + w * 16 + fq * 4);
        Xk0 = *(const bf16x8*)(KTT + (itn * 128 + w * 16 + fr) * 64 + fq * 8); Xk1 = *(const bf16x8*)(KTT + (itn * 128 + w * 16 + fr) * 64 + 32 + fq * 8);
#pragma unroll
        for (int eb = 0; eb < 4; ++eb) { const bf16_t* ip = ITT + (itn * 128 + (eh * 4 + eb) * 16 + fr) * 64 + fq * 8; Y0[eb] = *(const bf16x8*)ip; Y1[eb] = *(const bf16x8*)(ip + 32); } }
    for (int n = 0; n < 32; ++n) {
        const size_t itn = (size_t)(b * 32 + n) * 16 + h;
        const int nn = (n < 31) ? n + 1 : 31; const size_t itx = (size_t)(b * 32 + nn) * 16 + h;
        const f32x4 ndec = *(const f32x4*)(DEC + itx * 128 + w * 16 + fq * 4);
        const bf16x8 nXk0 = *(const bf16x8*)(KTT + (itx * 128 + w * 16 + fr) * 64 + fq * 8), nXk1 = *(const bf16x8*)(KTT + (itx * 128 + w * 16 + fr) * 64 + 32 + fq * 8);
        bf16x8 nY0[4], nY1[4];
#pragma unroll
        for (int eb = 0; eb < 4; ++eb) { const bf16_t* ip = ITT + (itx * 128 + (eh * 4 + eb) * 16 + fr) * 64 + fq * 8; nY0[eb] = *(const bf16x8*)ip; nY1[eb] = *(const bf16x8*)(ip + 32); }
#pragma unroll
        for (int eb = 0; eb < 4; ++eb) { u32x2 o; o.x = cvt_pk_bf16(S[eb][0], S[eb][1]); o.y = cvt_pk_bf16(S[eb][2], S[eb][3]); *(u32x2*)(SN + (itn * 128 + (eh * 4 + eb) * 16 + fr) * 128 + w * 16 + fq * 4) = o; }
#pragma unroll
        for (int eb = 0; eb < 4; ++eb) { f32x4 a = S[eb] * dec; a = MFMA16(Xk0, Y0[eb], a); a = MFMA16(Xk1, Y1[eb], a); S[eb] = a; }
        dec = ndec; Xk0 = nXk0; Xk1 = nXk1;
#pragma unroll
        for (int eb = 0; eb < 4; ++eb) { Y0[eb] = nY0[eb]; Y1[eb] = nY1[eb]; }
    }
    float* sp = p.out + O_SP + (size_t)bh * 128 * 128;
#pragma unroll
    for (int eb = 0; eb < 4; ++eb)
#pragma unroll
        for (int j = 0; j < 4; ++j) sp[(size_t)(w * 16 + fq * 4 + j) * 128 + (eh * 4 + eb) * 16 + fr] = S[eb][j];
}

__device__ __forceinline__ void hgrn_out_waveitem(const Params& p, int wi) {
    const int lane = threadIdx.x & 63, fr = lane & 15, fq = lane >> 4;
    const int tb = wi & 3, item = wi >> 2, h = item & 15, n = (item >> 4) & 31, b = item >> 9;
    unsigned char* ws = p.ws;
    const bf16_t* H = (const bf16_t*)(ws + WS_H); bf16_t* YAB = (bf16_t*)(ws + WS_YAB);
    const bf16_t* QT0 = (const bf16_t*)(ws + WS_QT0); const float* OIN = (const float*)(ws + WS_OIN); const bf16_t* SN = (const bf16_t*)(ws + WS_SN);
    const int t = b * 2048 + n * 64 + tb * 16 + fr;
    bf16x8 Yq[4];
#pragma unroll
    for (int ks = 0; ks < 4; ++ks) Yq[ks] = *(const bf16x8*)(QT0 + (size_t)t * EA + h * 128 + ks * 32 + fq * 8);
    f32x4 o[8]; float ss = 0.f;
#pragma unroll
    for (int eb = 0; eb < 8; ++eb) { f32x4 acc = *(const f32x4*)(OIN + (size_t)t * EA + h * 128 + eb * 16 + fq * 4);
        if (n > 0) {
#pragma unroll
            for (int ks = 0; ks < 4; ++ks) { const bf16x8 X = *(const bf16x8*)(SN + ((size_t)item * 128 + eb * 16 + fr) * 128 + ks * 32 + fq * 8); acc = MFMA16(X, Yq[ks], acc); } }
        o[eb] = acc; ss += (acc[0] * acc[0] + acc[1] * acc[1]) + (acc[2] * acc[2] + acc[3] * acc[3]); }
    ss += __shfl_xor(ss, 16); ss += __shfl_xor(ss, 32);
    const float rs = __builtin_amdgcn_rsqf(ss * (1.0f / 128.0f) + EPS);
#pragma unroll
    for (int eb = 0; eb < 8; ++eb) { const int col = h * 128 + eb * 16 + fq * 4; const u32x2 zb = *(const u32x2*)(H + (size_t)t * NC + COL_ZB + col); const f32x4 g = *(const f32x4*)(p.gon + col);
        u32x2 y; y.x = cvt_pk_bf16(o[eb][0] * rs * g[0] * f_lo(zb.x), o[eb][1] * rs * g[1] * f_hi(zb.x)); y.y = cvt_pk_bf16(o[eb][2] * rs * g[2] * f_lo(zb.y), o[eb][3] * rs * g[3] * f_hi(zb.y));
        *(u32x2*)(YAB + (size_t)t * DM + 2048 + col) = y; }
}

__device__ __forceinline__ void amix_ticket(const Params& p, LAS unsigned char* lds, int item0, int cnt) {
    int tid_o = threadIdx.x; asm volatile("" : "+v"(tid_o));
    const int tid = tid_o, lane = tid & 63, w = tid >> 6, fr = lane & 15, fq = lane >> 4;
    unsigned char* ws = p.ws;
    const bf16_t* H = (const bf16_t*)(ws + WS_H); bf16_t* YAB = (bf16_t*)(ws + WS_YAB); const bf16_t* WSM = (const bf16_t*)(ws + WS_WSM); const float* LNP = (const float*)(ws + WS_LNP);
    LAS bf16_t* VT = (LAS bf16_t*)lds;
    LAS float* stats = (LAS float*)(lds + 128 * 136 * 2);
    const int sr = tid >> 2, sq = tid & 3;
    f32x4 P[4]; u32x4 V[4];
#define AMIX_LOAD(item_) do { const int g_ = (item_) & 15, n_ = ((item_) >> 4) & 15, b_ = (item_) >> 8, t0_ = b_ * 2048 + n_ * 128; \
        const f32x4* lp_ = (const f32x4*)(LNP + (size_t)(t0_ + sr) * 64 + sq * 16); P[0] = lp_[0]; P[1] = lp_[1]; P[2] = lp_[2]; P[3] = lp_[3]; \
        _Pragma("unroll") for (int i = 0; i < 4; ++i) { const int id_ = tid + 512 * i; V[i] = *(const u32x4*)(H + (size_t)(t0_ + (id_ & 127)) * NC + COL_V + g_ * 128 + (id_ >> 7) * 8); } } while (0)
    AMIX_LOAD(item0);
    for (int ii = 0; ii < cnt; ++ii) {
        const int item = item0 + ii, g = item & 15, n = (item >> 4) & 15, b = item >> 8, t0 = b * 2048 + n * 128;
        const int tb = w, nks = (tb >> 1) + 1, t = t0 + tb * 16 + fr;
        u32x2 uu[8], zz[8];
#pragma unroll
        for (int cb = 0; cb < 8; ++cb) { const int col = g * 128 + cb * 16 + fq * 4; uu[cb] = *(const u32x2*)(H + (size_t)t * NC + COL_U + col); zz[cb] = *(const u32x2*)(H + (size_t)t * NC + COL_ZA + col); }
        { float s1 = (P[0][0] + P[0][2]) + (P[1][0] + P[1][2]) + (P[2][0] + P[2][2]) + (P[3][0] + P[3][2]), s2 = (P[0][1] + P[0][3]) + (P[1][1] + P[1][3]) + (P[2][1] + P[2][3]) + (P[3][1] + P[3][3]);
          s1 += __shfl_xor(s1, 1); s1 += __shfl_xor(s1, 2); s2 += __shfl_xor(s2, 1); s2 += __shfl_xor(s2, 2);
          if (sq == 0) { const float mean = s1 * (1.0f / 2048.0f), var = s2 * (1.0f / 2048.0f) - mean * mean; stats[sr * 2] = mean; stats[sr * 2 + 1] = __builtin_amdgcn_rsqf(var + EPS); } }
        __syncthreads();
#pragma unroll
        for (int i = 0; i < 4; ++i) { const int id = tid + 512 * i, r = id & 127, cc = id >> 7; const u32x4 v = V[i];
            const float mean = stats[r * 2], rstd = stats[r * 2 + 1];
            const f32x4 g0 = *(const f32x4*)(p.lng + g * 128 + cc * 8), g1 = *(const f32x4*)(p.lng + g * 128 + cc * 8 + 4), b0 = *(const f32x4*)(p.lnb + g * 128 + cc * 8), b1 = *(const f32x4*)(p.lnb + g * 128 + cc * 8 + 4);
            float vn[8];
            vn[0] = (f_lo(v.x) - mean) * rstd * g0[0] + b0[0]; vn[1] = (f_hi(v.x) - mean) * rstd * g0[1] + b0[1]; vn[2] = (f_lo(v.y) - mean) * rstd * g0[2] + b0[2]; vn[3] = (f_hi(v.y) - mean) * rstd * g0[3] + b0[3];
            vn[4] = (f_lo(v.z) - mean) * rstd * g1[0] + b1[0]; vn[5] = (f_hi(v.z) - mean) * rstd * g1[1] + b1[1]; vn[6] = (f_lo(v.w) - mean) * rstd * g1[2] + b1[2]; vn[7] = (f_hi(v.w) - mean) * rstd * g1[3] + b1[3];
            if (n == 15) { float* vp = p.out + O_VP + ((size_t)(b * 128 + r)) * EA + g * 128 + cc * 8; *(f32x4*)vp = (f32x4){vn[0], vn[1], vn[2], vn[3]}; *(f32x4*)(vp + 4) = (f32x4){vn[4], vn[5], vn[6], vn[7]}; }
#pragma unroll
            for (int k = 0; k < 8; k += 2) { const unsigned pk = cvt_pk_bf16(vn[k], vn[k + 1]); VT[(cc * 8 + k) * 136 + r] = (bf16_t)(pk & 0xffffu); VT[(cc * 8 + k + 1) * 136 + r] = (bf16_t)(pk >> 16); }
        }
        if (ii + 1 < cnt) AMIX_LOAD(item + 1);
        __syncthreads();
        {
            bf16x8 Yw[4];
#pragma unroll
            for (int ks = 0; ks < 4; ++ks) { if (ks < nks) Yw[ks] = *(const bf16x8*)(WSM + ((size_t)(g * 128 + tb * 16 + fr)) * 128 + ks * 32 + fq * 8); else Yw[ks] = (bf16x8){0, 0, 0, 0, 0, 0, 0, 0}; }
            const float bs = p.bsp[g * 128 + tb * 16 + fr];
#pragma unroll
            for (int cb = 0; cb < 8; ++cb) { f32x4 acc = {0.f, 0.f, 0.f, 0.f};
#pragma unroll
                for (int ks = 0; ks < 4; ++ks) { if (ks < nks) { const bf16x8 X = *(const LAS bf16x8*)(VT + (cb * 16 + fr) * 136 + ks * 32 + fq * 8); acc = MFMA16(X, Yw[ks], acc); } }
                const int col = g * 128 + cb * 16 + fq * 4; const u32x2 u = uu[cb], za = zz[cb];
                u32x2 y; y.x = cvt_pk_bf16(f_lo(u.x) * (acc[0] + bs) * f_lo(za.x), f_hi(u.x) * (acc[1] + bs) * f_hi(za.x)); y.y = cvt_pk_bf16(f_lo(u.y) * (acc[2] + bs) * f_lo(za.y), f_hi(u.y) * (acc[3] + bs) * f_hi(za.y));
                *(u32x2*)(YAB + (size_t)t * DM + col) = y; }
        }
        __syncthreads();
    }
#undef AMIX_LOAD
}

__device__ __forceinline__ void hgrn_sample_item(const Params& p, LAS unsigned char* lds, int item) {
    const int tid = threadIdx.x, lane = tid & 63, w = tid >> 6;
    const int bs = item >> 4, h = item & 15, row = TP + bs, e4 = tid & 31, dg = tid >> 5;
    unsigned char* ws = p.ws;
    const bf16_t* H = (const bf16_t*)(ws + WS_H); bf16_t* YAB = (bf16_t*)(ws + WS_YAB);
    LAS float* red = (LAS float*)lds;
    LAS float* ssw = red + 16 * 128;
    const bf16_t* hr = H + (size_t)row * NC + h * 128;
    const u32x2 ii = *(const u32x2*)(hr + COL_I + e4 * 4);
    const f32x4 i4 = {f_lo(ii.x), f_hi(ii.x), f_lo(ii.y), f_hi(ii.y)};
    const u32x4 q8 = *(const u32x4*)(hr + COL_Q + dg * 8), l8 = *(const u32x4*)(hr + COL_F + dg * 8);
    const float qv[8] = {f_lo(q8.x), f_hi(q8.x), f_lo(q8.y), f_hi(q8.y), f_lo(q8.z), f_hi(q8.z), f_lo(q8.w), f_hi(q8.w)};
    const float lv[8] = {f_lo(l8.x), f_hi(l8.x), f_lo(l8.y), f_hi(l8.y), f_lo(l8.z), f_hi(l8.z), f_lo(l8.w), f_hi(l8.w)};
    const size_t sbase = ((size_t)item * 128 + dg * 8) * 128 + e4 * 4;
    const f32x4* s0 = (const f32x4*)(p.st0 + sbase); f32x4* s1 = (f32x4*)(p.out + O_SS + sbase);
    f32x4 po = {0.f, 0.f, 0.f, 0.f};
#pragma unroll
    for (int j = 0; j < 8; ++j) { const float f = __expf(lv[j]), k = 1.0f - f; const f32x4 sn = __builtin_nontemporal_load(&s0[j * 32]) * f + i4 * k; __builtin_nontemporal_store(sn, &s1[j * 32]); po += sn * qv[j]; }
    *(LAS f32x4*)(red + dg * 128 + e4 * 4) = po;
    __syncthreads();
    float o = 0.f;
    if (tid < 128) {
#pragma unroll
        for (int k = 0; k < 16; ++k) o += red[k * 128 + tid];
        const float s = wave_sum(o * o);
        if (lane == 0) ssw[w] = s;
    }
    __syncthreads();
    if (tid < 128) { const float rs = __builtin_amdgcn_rsqf((ssw[0] + ssw[1]) * (1.0f / 128.0f) + EPS);
        const float y = o * rs * p.gon[h * 128 + tid] * bf2f(hr[COL_ZB + tid]);
        YAB[(size_t)row * DM + 2048 + h * 128 + tid] = (bf16_t)(cvt_pk_bf16(y, 0.f) & 0xffffu); }
    __syncthreads();
}

__device__ __forceinline__ void amix_sample_item(const Params& p, int bs) {
    const int tid = threadIdx.x, row = TP + bs, c0 = tid * 4, g = c0 >> 7;
    unsigned char* ws = p.ws;
    const bf16_t* H = (const bf16_t*)(ws + WS_H); bf16_t* YAB = (bf16_t*)(ws + WS_YAB); const float* LNP = (const float*)(ws + WS_LNPS);
    const f32x4 lv = *((const f32x4*)(LNP + (size_t)bs * 256) + (tid & 63));
    const float s1 = wave_sum(lv[0] + lv[2]), s2 = wave_sum(lv[1] + lv[3]);
    const float mean = s1 * (1.0f / 2048.0f), rstd = __builtin_amdgcn_rsqf(s2 * (1.0f / 2048.0f) - mean * mean + EPS);
    const bf16_t* hr = H + (size_t)row * NC + c0;
    const u32x2 v = *(const u32x2*)(hr + COL_V), u = *(const u32x2*)(hr + COL_U), za = *(const u32x2*)(hr + COL_ZA);
    const f32x4 lg = *(const f32x4*)(p.lng + c0), lb = *(const f32x4*)(p.lnb + c0);
    f32x4 vn; vn[0] = (f_lo(v.x) - mean) * rstd * lg[0] + lb[0]; vn[1] = (f_hi(v.x) - mean) * rstd * lg[1] + lb[1]; vn[2] = (f_lo(v.y) - mean) * rstd * lg[2] + lb[2]; vn[3] = (f_hi(v.y) - mean) * rstd * lg[3] + lb[3];
    *(f32x4*)(p.out + O_VS + (size_t)bs * EA + c0) = vn;
    const float w00 = p.wsp[(size_t)g * 128 * 128], b0 = p.bsp[g * 128];
    u32x2 y; y.x = cvt_pk_bf16(f_lo(u.x) * (w00 * vn[0] + b0) * f_lo(za.x), f_hi(u.x) * (w00 * vn[1] + b0) * f_hi(za.x)); y.y = cvt_pk_bf16(f_lo(u.y) * (w00 * vn[2] + b0) * f_lo(za.y), f_hi(u.y) * (w00 * vn[3] + b0) * f_hi(za.y));
    *(u32x2*)(YAB + (size_t)row * DM + c0) = y;
}

template <int MODE> __device__ __forceinline__ void skinny_gemm(const Params& p, LAS unsigned char* lds, int g0, int gstride) {
    int tid0 = threadIdx.x; asm volatile("" : "+v"(tid0));
    const int tid = tid0, lane = tid & 63, w = tid >> 6, fr = lane & 15, fq = lane >> 4;
    unsigned char* ws = p.ws;
    const bf16_t* A = (const bf16_t*)(ws + (MODE == 1 ? WS_XN : MODE == 2 ? WS_YAB : WS_MRG)) + (size_t)TP * DM;
    const bf16_t* Bt = (const bf16_t*)(ws + (MODE == 1 ? WS_WTIN : MODE == 2 ? WS_WTAB : WS_WTO));
    bf16_t* H = (bf16_t*)(ws + WS_H);
    constexpr int NG = (MODE == 1 ? NC : DM) / 128, AP = 264;
    LAS bf16_t* As = (LAS bf16_t*)lds;
    const int sr = tid >> 5, sc = (tid & 31) * 8;
    const int wu = __builtin_amdgcn_readfirstlane(w);
    unsigned aoff[8];
#pragma unroll
    for (int i = 0; i < 8; ++i) aoff[i] = (unsigned)(((sr + 16 * i) * DM + sc) * 2);
    const unsigned boff = (unsigned)((fr * DM + fq * 8) * 2);
    for (int g = g0; g < NG; g += gstride) {
        const int n0 = g * 128 + wu * 16, col = n0 + 4 * fq;
        const char* ab = (const char*)A; const char* bb = (const char*)Bt + (size_t)n0 * DM * 2;
        f32x4 acc[8];
#pragma unroll
        for (int mb = 0; mb < 8; ++mb) acc[mb] = (f32x4){0.f, 0.f, 0.f, 0.f};
        u32x4 ar[8]; bf16x8 bc[8];
#pragma unroll
        for (int i = 0; i < 8; ++i) ar[i] = *(const u32x4*)(ab + aoff[i]);
#pragma unroll
        for (int ks = 0; ks < 8; ++ks) bc[ks] = *(const bf16x8*)(bb + boff + ks * 64);
#pragma unroll
        for (int i = 0; i < 8; ++i) *(LAS u32x4*)(As + (sr + 16 * i) * AP + sc) = ar[i];
        __syncthreads();
        for (int kc = 0; kc < 16; ++kc) {
            const int kn = (kc < 15) ? kc + 1 : 15;
#pragma unroll
            for (int i = 0; i < 8; ++i) ar[i] = *(const u32x4*)(ab + kn * 512 + aoff[i]);
#pragma unroll
            for (int ks = 0; ks < 8; ++ks) {
#pragma unroll
                for (int mb = 0; mb < 8; ++mb) { const bf16x8 Y = *(const LAS bf16x8*)(As + (mb * 16 + fr) * AP + ks * 32 + fq * 8); acc[mb] = MFMA16(bc[ks], Y, acc[mb]); }
                bc[ks] = *(const bf16x8*)(bb + kn * 512 + boff + ks * 64);
                __builtin_amdgcn_sched_barrier(0);
            }
            if (MODE == 2 && kc == 7) {
#pragma unroll
                for (int mb = 0; mb < 8; ++mb) { const int row = TP + mb * 16 + fr; const u32x2 ga = *(const u32x2*)(H + (size_t)row * NC + COL_GA + col), gb = *(const u32x2*)(H + (size_t)row * NC + COL_GB + col);
                    acc[mb][0] *= f_lo(ga.x) * __builtin_amdgcn_rcpf(f_lo(gb.x)); acc[mb][1] *= f_hi(ga.x) * __builtin_amdgcn_rcpf(f_hi(gb.x)); acc[mb][2] *= f_lo(ga.y) * __builtin_amdgcn_rcpf(f_lo(gb.y)); acc[mb][3] *= f_hi(ga.y) * __builtin_amdgcn_rcpf(f_hi(gb.y)); if (mb & 1) asm volatile("" ::: "memory"); }
            }
            __syncthreads();
#pragma unroll
            for (int i = 0; i < 8; ++i) *(LAS u32x4*)(As + (sr + 16 * i) * AP + sc) = ar[i];
            __syncthreads();
        }
        if (MODE == 1) {
            const int type = n0 < 2048 ? 0 : n0 < 4096 ? 1 : n0 < 8192 ? 2 : n0 < 10240 ? 3 : n0 < 12288 ? 4 : n0 < 14336 ? 2 : 5;
            float lb[4] = {0.f, 0.f, 0.f, 0.f};
            if (type == 3) { const f32x4 l0 = *(const f32x4*)(p.lbl + col - 8192), l1 = *(const f32x4*)(p.lbl + 2048 + col - 8192);
#pragma unroll
                for (int j = 0; j < 4; ++j) lb[j] = __builtin_amdgcn_rcpf(1.0f + __expf(l1[j] - l0[j])); }
            float* LNPS = (float*)(ws + WS_LNPS);
#pragma unroll
            for (int mb = 0; mb < 8; ++mb) { const int row = TP + mb * 16 + fr; float v[4]; float s1 = 0.f, s2 = 0.f;
#pragma unroll
                for (int j = 0; j < 4; ++j) { float x = acc[mb][j];
                    if (type <= 1) x = pg8::fgelu(x); else if (type == 2) x = pg8::fsilu(x); else if (type == 3) x = __logf(lb[j] + (1.0f - lb[j]) * pg8::fsigmoid(x)); else if (type == 5) x = pg8::fsigmoid(x);
                    v[j] = x; s1 += x; s2 += x * x; }
                u32x2 o; o.x = cvt_pk_bf16(v[0], v[1]); o.y = cvt_pk_bf16(v[2], v[3]); *(u32x2*)(H + (size_t)row * NC + col) = o;
                if (type == 1) { s1 += __shfl_xor(s1, 16); s1 += __shfl_xor(s1, 32); s2 += __shfl_xor(s2, 16); s2 += __shfl_xor(s2, 32);
                    if (fq == 0) { f32x2 q; q.x = s1; q.y = s2; *(f32x2*)(LNPS + (size_t)(row - TP) * 256 + ((n0 - 2048) >> 4) * 2) = q; } } }
        } else if (MODE == 2) {
            bf16_t* MRG = (bf16_t*)(ws + WS_MRG);
#pragma unroll
            for (int mb = 0; mb < 8; ++mb) { const int row = TP + mb * 16 + fr; const u32x2 gb = *(const u32x2*)(H + (size_t)row * NC + COL_GB + col);
                u32x2 o; o.x = cvt_pk_bf16(acc[mb][0] * f_lo(gb.x), acc[mb][1] * f_hi(gb.x)); o.y = cvt_pk_bf16(acc[mb][2] * f_lo(gb.y), acc[mb][3] * f_hi(gb.y)); *(u32x2*)(MRG + (size_t)row * DM + col) = o; }
        } else {
            bf16_t* Z = (bf16_t*)(ws + WS_Z); float* SSPS = (float*)(ws + WS_SSPS);
#pragma unroll
            for (int mb = 0; mb < 8; ++mb) { const int row = TP + mb * 16 + fr; const f32x4 v = acc[mb];
                u32x2 o; o.x = cvt_pk_bf16(v[0], v[1]); o.y = cvt_pk_bf16(v[2], v[3]); *(u32x2*)(Z + (size_t)row * DM + col) = o;
                float ss = (v[0] * v[0] + v[1] * v[1]) + (v[2] * v[2] + v[3] * v[3]); ss += __shfl_xor(ss, 16); ss += __shfl_xor(ss, 32);
                if (fq == 0) SSPS[(size_t)(row - TP) * 256 + (n0 >> 4)] = ss; }
        }
        __syncthreads();
    }
}

__device__ __forceinline__ void phase_final(const Params& p, int m0, int m1, int wg, int nwg) {
    int tid_o = threadIdx.x; asm volatile("" : "+v"(tid_o));
    const int tid = tid_o, lane = tid & 63, wid = tid >> 6;
    const int gw = wg * 8 + wid, NGW = nwg * 8;
    const bf16_t* Z = (const bf16_t*)(p.ws + WS_Z); const float* SSP = (const float*)(p.ws + WS_SSP);
    for (int m = m0 + gw; m < m1; m += NGW) {
        float sq; if (m < TP) sq = SSP[(size_t)m * 64 + lane]; else { const f32x4 q = *((const f32x4*)((const float*)(p.ws + WS_SSPS) + (size_t)(m - TP) * 256) + lane); sq = (q[0] + q[1]) + (q[2] + q[3]); }
        const float rs = __builtin_amdgcn_rsqf(wave_sum(sq) * (1.0f / DM) + EPS);
        const float* xr = (m < TP) ? p.xp + (size_t)m * DM : p.xs + (size_t)(m - TP) * DM;
        float* yr = p.out + (size_t)m * DM;
        const f32x4* x4 = (const f32x4*)xr + lane; const f32x4* g4 = (const f32x4*)p.gpost + lane; const u32x2* z8 = (const u32x2*)(Z + (size_t)m * DM) + lane; f32x4* y4 = (f32x4*)yr + lane;
#pragma unroll
        for (int j = 0; j < 16; ++j) { const f32x4 x = __builtin_nontemporal_load(&x4[64 * j]), g = g4[64 * j]; const u32x2 z = __builtin_nontemporal_load(&z8[64 * j]);
            f32x4 y; y[0] = x[0] + f_lo(z.x) * rs * g[0]; y[1] = x[1] + f_hi(z.x) * rs * g[1]; y[2] = x[2] + f_lo(z.y) * rs * g[2]; y[3] = x[3] + f_hi(z.y) * rs * g[3]; __builtin_nontemporal_store(y, &y4[64 * j]); }
    }
}

constexpr int NPH = 9;
__global__ void __launch_bounds__(512, 2) mega(Params p) {
    extern __shared__ __attribute__((aligned(16))) unsigned char lds_raw[];
    LAS unsigned char* lds = (LAS unsigned char*)lds_raw;
    cg::grid_group grid = cg::this_grid();
    const int lo = p.lo, hi = p.hi, G = gridDim.x, bid = blockIdx.x;
    unsigned char* ws = p.ws;
    if (threadIdx.x < 64) ((LAS unsigned*)(lds + LDS_STAGE))[threadIdx.x] = 0u;
    __syncthreads();
    XcdBarrier bar = xcd_barrier_post((unsigned*)(ws + 16384), (volatile LAS unsigned*)(lds + LDS_STAGE));
    if (hi - lo > 1) grid.sync();
#define IN(k) (lo <= (k) && (k) < hi)
#define GSYNC() xcd_barrier(bar)
#define SEAM(k) do { if (IN(k) && IN((k) + 1)) GSYNC(); } while (0)
#define REPS(k) (1 + ((MK_REP >> (k)) & 1))
    for (int rep = 0; rep < REPS(0); ++rep) { if (rep) GSYNC(); if (IN(0)) phase0(p, lds); }
    SEAM(0);
    for (int rep = 0; rep < REPS(1); ++rep) { if (rep) GSYNC();
        if (IN(1)) {
            pg8::Gemm g{(const bf16_t*)(ws + WS_XN), (const bf16_t*)(ws + WS_WTIN), TP, NC, DM, DM / 64, 0}; pg8::StaticOrder S; S.init(TP, NC, G, bid);
            pg8::EpiAct E{(bf16_t*)(ws + WS_H), p.lbl, (float*)(ws + WS_LNP)};
            pg8::gemm_phase<pg8::EpiAct, pg8::StaticOrder, true, true>(lds, g, S, E);
        } }
    SEAM(1);
    for (int rep = 0; rep < REPS(2); ++rep) { if (rep) GSYNC();
        if (IN(2)) {
            if (G == 256) {
                if (bid < 176) { for (int r2 = 0; r2 < 1 + MK_SK; ++r2) skinny_gemm<1>(p, lds, bid, 176); hgrn_prep_phase(p, lds, bid, 176, 704); }
                else hgrn_prep_phase(p, lds, 704 + (bid - 176), 80, 2048);
            } else { skinny_gemm<1>(p, lds, bid, G); hgrn_prep_phase(p, lds, bid, G, 2048); }
        } }
    SEAM(2);
    for (int rep = 0; rep < REPS(3); ++rep) { if (rep) GSYNC();
        if (IN(3)) {
            constexpr int T_SC = 128, T_AM = 256, T_HS = 256, T_AS = 8, T_TOT = T_SC + T_AM + T_HS + T_AS;
            unsigned* ctr = (unsigned*)ws + 64 * (1 + rep); LAS int* slot = (LAS int*)(lds + LDS_STAGE + 64);
            int it = bid;
            while (it < T_TOT) {
                int nxt = 0; if (threadIdx.x == 0) nxt = G + (int)atomicAdd(ctr, 1u);
                if (it < T_SC) { for (int r2 = 0; r2 < 1 + (MK_SUB & 1); ++r2) hgrn_state_item(p, it); }
                else if (it < T_SC + T_AM) amix_ticket(p, lds, (it - T_SC) * 4, 4);
                else if (it < T_SC + T_AM + T_HS) { for (int k = 0; k < 8; ++k) hgrn_sample_item(p, lds, (it - T_SC - T_AM) * 8 + k); }
                else { for (int k = 0; k < 16; ++k) amix_sample_item(p, (it - T_SC - T_AM - T_HS) * 16 + k); }
                if (threadIdx.x == 0) *slot = nxt;
                __syncthreads(); it = *slot; __syncthreads();
            }
        } }
    SEAM(3);
    for (int rep = 0; rep < REPS(4); ++rep) { if (rep) GSYNC();
        if (IN(4)) {
            const int nsk = (G > 64) ? 32 : 0;
            if (bid >= G - nsk) { for (int r2 = 0; r2 < 1 + MK_SK; ++r2) skinny_gemm<2>(p, lds, bid - (G - nsk), nsk); }
            else { for (int wi = bid * 8 + (int)(threadIdx.x >> 6); wi < 8192; wi += (G - nsk) * 8) hgrn_out_waveitem(p, wi); }
            if (nsk == 0) skinny_gemm<2>(p, lds, bid, G);
        } }
    SEAM(4);
    for (int rep = 0; rep < REPS(5); ++rep) { if (rep) GSYNC();
        if (IN(5)) {
            pg8::Gemm g{(const bf16_t*)(ws + WS_YAB), (const bf16_t*)(ws + WS_WTAB), TP, DM, DM, 32, (size_t)2048 * 2}; pg8::PairOrder S; S.init(TP, DM, G, bid);
            pg8::EpiMerge E{(const bf16_t*)(ws + WS_H), (bf16_t*)(ws + WS_MRG)};
            pg8::gemm_phase<pg8::EpiMerge, pg8::PairOrder, true, true>(lds, g, S, E);
        } }
    SEAM(5);
    for (int rep = 0; rep < REPS(6); ++rep) { if (rep) GSYNC();
        if (IN(6)) {
            pg8::Gemm g{(const bf16_t*)(ws + WS_MRG), (const bf16_t*)(ws + WS_WTO), TP, DM, DM, DM / 64, 0}; pg8::StaticOrder S; S.init(TP, DM, G, bid);
            pg8::EpiZ E{(bf16_t*)(ws + WS_Z), (float*)(ws + WS_SSP)};
            pg8::gemm_phase<pg8::EpiZ, pg8::StaticOrder, true, true>(lds, g, S, E);
        } }
    SEAM(6);
    for (int rep = 0; rep < REPS(7); ++rep) { if (rep) GSYNC();
        if (IN(7)) {
            const int nsk = (G > 64) ? 32 : 0;
            if (bid >= G - nsk) { for (int r2 = 0; r2 < 1 + MK_SK; ++r2) skinny_gemm<3>(p, lds, bid - (G - nsk), nsk); }
            else phase_final(p, 0, TP, bid, G - nsk);
            if (nsk == 0) skinny_gemm<3>(p, lds, bid, G);
        } }
    SEAM(7);
    if (IN(8)) phase_final(p, TP, MT, bid, G);
    for (int x = 0; x < MK_XSYNC; ++x) GSYNC();
#undef IN
#undef SEAM
#undef GSYNC
#undef REPS
}

extern "C" void kernel_launch(void* const* d_in, const int* in_sizes, int n_in, void* d_out, int out_size, void* d_ws, size_t ws_size, hipStream_t stream) {
    static int grid = 0;
    if (grid == 0) {
        if (n_in != 15 || (size_t)out_size != O_END || ws_size < WS_END) { fprintf(stderr, "kernel_launch: unexpected shapes: n_in %d out %d ws %zu (need %zu)\n", n_in, out_size, ws_size, (size_t)WS_END); grid = -1; return; }
        int dev = 0, cus = 0, per_cu = 0;
        if (hipGetDevice(&dev) != hipSuccess || hipDeviceGetAttribute(&cus, hipDeviceAttributeMultiprocessorCount, dev) != hipSuccess) { fprintf(stderr, "kernel_launch: device query failed\n"); grid = -1; return; }
        if (hipFuncSetAttribute((const void*)mega, hipFuncAttributeMaxDynamicSharedMemorySize, LDS_BYTES) != hipSuccess) { fprintf(stderr, "kernel_launch: hipFuncSetAttribute failed\n"); grid = -1; return; }
        if (hipOccupancyMaxActiveBlocksPerMultiprocessor(&per_cu, (const void*)mega, 512, LDS_BYTES) != hipSuccess || per_cu < 1) { fprintf(stderr, "kernel_launch: occupancy query says %d\n", per_cu); per_cu = 1; }
        (void)hipGetLastError();
        grid = cus * per_cu;
        fprintf(stderr, "kernel_launch: grid %d (cus %d x %d)\n", grid, cus, per_cu);
    }
    if (grid < 0) return;
    (void)hipMemsetAsync(d_ws, 0, WS_CTLB, stream);
    Params p{};
    p.xp = (const float*)d_in[0]; p.xs = (const float*)d_in[1]; p.st0 = (const float*)d_in[2]; p.lbl = (const float*)d_in[3]; p.gpre = (const float*)d_in[4]; p.win = (const float*)d_in[5];
    p.lng = (const float*)d_in[6]; p.lnb = (const float*)d_in[7]; p.wsp = (const float*)d_in[8]; p.bsp = (const float*)d_in[9]; p.gon = (const float*)d_in[10]; p.wpa = (const float*)d_in[11];
    p.wpb = (const float*)d_in[12]; p.wo = (const float*)d_in[13]; p.gpost = (const float*)d_in[14];
    p.out = (float*)d_out; p.ws = (unsigned char*)d_ws;
#if MK_MULTI
    for (int ph = 0; ph < NPH; ++ph) { p.lo = ph; p.hi = ph + 1; hipLaunchKernelGGL(mega, dim3(grid), dim3(512), LDS_BYTES, stream, p); }
#else
    p.lo = 0; p.hi = NPH;
    void* args[] = {&p};
    hipError_t e = hipLaunchCooperativeKernel((const void*)mega, dim3(grid), dim3(512), args, LDS_BYTES, stream);
    if (e != hipSuccess) fprintf(stderr, "kernel_launch: cooperative launch failed: %s (grid %d)\n", hipGetErrorString(e), grid);
#endif
}
```

```cpp
#include <hip/hip_runtime.h>
#include <hip/hip_cooperative_groups.h>
#include <cstdio>
#include <cstdint>
namespace cg = cooperative_groups;

#ifndef MK_MULTI
#define MK_MULTI 0
#endif

#ifndef G1ORDER
#define G1ORDER StaticOrder
#endif
#ifndef MK_DELAY_US
#define MK_DELAY_US 0
#endif
#ifndef MK_REP
#define MK_REP 0
#endif
#ifndef MK_SUB
#define MK_SUB 0
#endif
#ifndef MK_XSYNC
#define MK_XSYNC 0
#endif
#ifndef MK_SK
#define MK_SK 0
#endif
#ifndef MK_DUMP
#define MK_DUMP 0
#endif

constexpr int DM = 4096, NC = 22528, TP = 8192, TS = 128, MT = TP + TS, MP = 8448, EA = 2048;
constexpr int COL_U = 0, COL_V = 2048, COL_ZA = 4096, COL_Q = 6144, COL_F = 8192, COL_I = 10240, COL_ZB = 12288, COL_GA = 14336, COL_GB = 18432;
constexpr float EPS = 1e-6f;
constexpr size_t WS_CTLB = 65536;
constexpr size_t WS_WTIN = WS_CTLB;
constexpr size_t WS_WTAB = WS_WTIN + (size_t)NC * DM * 2;
constexpr size_t WS_WTO  = WS_WTAB + (size_t)DM * DM * 2;
constexpr size_t WS_XN   = WS_WTO + (size_t)DM * DM * 2;
constexpr size_t WS_H    = WS_XN + (size_t)MP * DM * 2;
constexpr size_t WS_YAB  = WS_H + (size_t)MP * NC * 2;
constexpr size_t WS_MRG  = WS_YAB + (size_t)MP * DM * 2;
constexpr size_t WS_SN   = WS_MRG;
constexpr size_t WS_Z    = WS_MRG + (size_t)MP * DM * 2;
constexpr size_t WS_LNP  = WS_Z + (size_t)MP * DM * 2;
constexpr size_t WS_SSP  = WS_LNP + (size_t)MP * 64 * 4;
constexpr size_t WS_WSM  = WS_SSP + (size_t)MP * 64 * 4;
constexpr size_t WS_QT0  = WS_WSM + (size_t)16 * 128 * 128 * 2;
constexpr size_t WS_KTT  = WS_QT0 + (size_t)TP * EA * 2;
constexpr size_t WS_ITT  = WS_KTT + (size_t)TP * EA * 2;
constexpr size_t WS_OIN  = WS_ITT + (size_t)TP * EA * 2;
constexpr size_t WS_DEC  = WS_OIN + (size_t)TP * EA * 4;
constexpr size_t WS_LNPS = WS_DEC + (size_t)2048 * 128 * 4;
constexpr size_t WS_SSPS = WS_LNPS + (size_t)128 * 256 * 4;
constexpr size_t WS_END  = WS_SSPS + (size_t)128 * 256 * 4;
constexpr size_t O_YP = 0, O_YS = O_YP + (size_t)TP * DM, O_SP = O_YS + (size_t)TS * DM, O_SS = O_SP + (size_t)4 * 16 * 128 * 128,
                 O_VP = O_SS + (size_t)128 * 16 * 128 * 128, O_VS = O_VP + (size_t)4 * 128 * EA, O_END = O_VS + (size_t)128 * EA;
constexpr int LDS_STAGE = 128 * 1024, LDS_BYTES = LDS_STAGE + 256;

#define LAS __attribute__((address_space(3)))
#define XB_TMO      128
#define XB_XCNT(j)  (256  + 64 * (j))
#define XB_XSUB(j)  (1280 + 64 * (j))
#define XB_XGEN(j)  (2304 + 64 * (j))
#define XB_TOP      3328
#define XB_TOPGEN   3392
#define XCD_BAR_WORDS 3456
#define XB_SPIN_CAP (1u << 18)

__device__ __forceinline__ unsigned xb_ld(unsigned* p)              { return __hip_atomic_load(p, __ATOMIC_RELAXED, __HIP_MEMORY_SCOPE_AGENT); }
__device__ __forceinline__ unsigned xb_add(unsigned* p, unsigned v) { return __hip_atomic_fetch_add(p, v, __ATOMIC_RELAXED, __HIP_MEMORY_SCOPE_AGENT); }
__device__ __forceinline__ unsigned xb_xcc_id() { return (unsigned)__builtin_amdgcn_s_getreg((3 << 11) | 20) & 0xFu; }
#define XB_SPIN(cond, bar) do { unsigned _sp = 0; while (cond) { __builtin_amdgcn_s_sleep(1); \
    if ((++_sp & 255u) == 0u) { if (xb_ld(&(bar)[XB_TMO])) break; if (_sp > XB_SPIN_CAP) { atomicAdd(&(bar)[XB_TMO], 1u); break; } } } } while (0)

struct XcdBarrier {
    unsigned* bar; unsigned x;
    volatile LAS unsigned* st;
};

__device__ __forceinline__ XcdBarrier xcd_barrier_post(unsigned* bar, volatile LAS unsigned* st) {
    XcdBarrier b; b.bar = bar; b.x = xb_xcc_id(); b.st = st;
    if (threadIdx.x == 0) (void)xb_add(&bar[XB_XCNT(b.x)], 1u);
    return b;
}
__device__ __forceinline__ void xcd_barrier_complete(unsigned* bar, unsigned x, unsigned& nloc, unsigned& nx) {
    const unsigned G = gridDim.x * gridDim.y * gridDim.z;
    unsigned sum, cnt, mine, sp = 0u;
    for (;;) {
        sum = 0u; cnt = 0u; mine = 0u;
#pragma unroll
        for (unsigned j = 0; j < 16; ++j) { const unsigned c = xb_ld(&bar[XB_XCNT(j)]); sum += c; cnt += (c > 0u) ? 1u : 0u; mine = (j == x) ? c : mine; }
        if (sum == G) break;
        __builtin_amdgcn_s_sleep(1);
        if ((++sp & 255u) == 0u) { if (xb_ld(&bar[XB_TMO])) break; if (sp > XB_SPIN_CAP) { atomicAdd(&bar[XB_TMO], 1u); break; } }
    }
    nloc = mine > 0u ? mine : 1u; nx = cnt > 0u ? cnt : 1u;
}

__device__ __forceinline__ void xcd_barrier(const XcdBarrier& b) {
    asm volatile("s_waitcnt vmcnt(0)" ::: "memory");
    __syncthreads();
    if (threadIdx.x == 0) {
        unsigned* bar = b.bar;
        __builtin_amdgcn_s_waitcnt(0);
        unsigned nloc = b.st[0], nx = b.st[1];
        if (nloc == 0u) { xcd_barrier_complete(bar, b.x, nloc, nx); b.st[0] = nloc; b.st[1] = nx; }
        const unsigned old = xb_add(&bar[XB_XSUB(b.x)], 1u);
        const unsigned gen = old / nloc;
        if (old + 1u == (gen + 1u) * nloc) {
            __builtin_amdgcn_fence(__ATOMIC_RELEASE, "agent");
            asm volatile("s_waitcnt vmcnt(0)" ::: "memory");
            const unsigned og = xb_add(&bar[XB_TOP], 1u);
            const unsigned tg = og / nx;
            if (og + 1u == (tg + 1u) * nx) xb_add(&bar[XB_TOPGEN], 1u);
            else XB_SPIN(xb_ld(&bar[XB_TOPGEN]) == tg, bar);
            __builtin_amdgcn_fence(__ATOMIC_ACQUIRE, "agent");
            xb_add(&bar[XB_XGEN(b.x)], 1u);
            asm volatile("s_waitcnt vmcnt(0)" ::: "memory");
        } else {
            XB_SPIN(xb_ld(&bar[XB_XGEN(b.x)]) == gen, bar);
            __builtin_amdgcn_fence(__ATOMIC_ACQUIRE, "agent");
            asm volatile("s_waitcnt vmcnt(0)" ::: "memory");
        }
    }
    __syncthreads();
}

namespace pg8 {
#define PG8_LAS __attribute__((address_space(3)))
typedef unsigned short bf16_t;
typedef short bf16x8 __attribute__((ext_vector_type(8)));
typedef float f32x4 __attribute__((ext_vector_type(4)));
typedef unsigned u32x4 __attribute__((ext_vector_type(4)));
constexpr int BM = 256, BK = 64, HALF = 128, HTB = HALF * BK * 2  , STAGE_BYTES = 8 * HTB, NXCD = 8, WGM = 8;

__host__ __device__ __forceinline__ int lds_byte(int r, int c) { const int st = (r >> 4) * 2 + (c >> 5), rr = r & 15, cc = c & 31, ob = rr * 64 + cc * 2; return st * 1024 + (ob ^ (((ob >> 9) & 1) << 5)); }
__host__ __device__ __forceinline__ void stage_rc(int b, int& R, int& C) { const int st = b / 1024, sb = b % 1024, swz = sb ^ (((sb >> 9) & 1) << 5); R = (st >> 1) * 16 + swz / 64; C = (st & 1) * 32 + (swz % 64) / 2; }
__host__ __device__ __forceinline__ int perm32(int rho) { const int n = rho >> 4, i = rho & 15; return 8 * (i >> 2) + 4 * n + (i & 3); }

struct Unit { int pm, pn, kh; };
struct Gemm { const bf16_t* A; const bf16_t* Bt; int M, N, K, nt; size_t khoff; };

struct StaticOrder {
    int nM, nN, nwg, G, c;
    __host__ __device__ void init(int M, int N, int G_, int c_) { nM = M / BM; nN = N / BM; nwg = nM * nN; G = G_; c = c_; }
    __host__ __device__ bool next(int i, Unit& u) const {
        const long L = (long)i * G + c; if (L >= nwg) return false;
        int wgid = (int)L; { const int q = nwg / NXCD, r = nwg % NXCD, xcd = wgid % NXCD, off = wgid / NXCD; wgid = (xcd < r ? xcd * (q + 1) : r * (q + 1) + (xcd - r) * q) + off; }
        const int nig = WGM * nN, gid = wgid / nig, fm = gid * WGM, gsz = (nM - fm) < WGM ? (nM - fm) : WGM;
        u.pm = fm + ((wgid % nig) % gsz); u.pn = (wgid % nig) / gsz; u.kh = 0; return true;
    }
    __device__ __forceinline__ void a_ready(const Unit&) const {}
    __device__ __forceinline__ void done(const Unit&) const {}
};

typedef float f32x2 __attribute__((ext_vector_type(2)));
typedef __bf16 bf16x2_t __attribute__((ext_vector_type(2)));
__device__ __forceinline__ unsigned cvt_pk_bf16(float lo, float hi) { const f32x2 v = {lo, hi}; return __builtin_bit_cast(unsigned, __builtin_convertvector(v, bf16x2_t)); }
__device__ __forceinline__ float bf2f(unsigned short b) { return __builtin_bit_cast(float, (unsigned)b << 16); }
__device__ __forceinline__ float f_lo(unsigned w) { return __builtin_bit_cast(float, w << 16); }
__device__ __forceinline__ float f_hi(unsigned w) { return __builtin_bit_cast(float, w & 0xffff0000u); }
__device__ __forceinline__ float fsigmoid(float x) { return __builtin_amdgcn_rcpf(1.0f + __expf(-x)); }
__device__ __forceinline__ float fsilu(float x) { return x * fsigmoid(x); }
__device__ __forceinline__ float fgelu(float x) { return x * fsigmoid(1.5957691216057308f * (x + 0.044715f * x * x * x)); }

struct EpiAct {
    static constexpr bool PERM = true, AFTER_DRAIN = false, CARRY = false;
    bf16_t* H; const float* lbl; float* lnp;
    template <int ACT> __device__ __forceinline__ void run(const f32x4 (&acc)[2][2][4][2], const Unit& u, int wr, int wc, int fr, int fq) const {
        const int row0 = u.pm * BM + wr * 64 + fr, col0 = u.pn * BM + wc * 32 + 8 * fq;
        float lb[2][8];
        if (ACT == 3) {
#pragma unroll
            for (int bj = 0; bj < 2; ++bj) { const float* l0 = lbl + (col0 + bj * HALF - 8192); const f32x4 a0 = *(const f32x4*)l0, a1 = *(const f32x4*)(l0 + 4), b0 = *(const f32x4*)(l0 + 2048), b1 = *(const f32x4*)(l0 + 2052);
#pragma unroll
                for (int k = 0; k < 4; ++k) { lb[bj][k] = __builtin_amdgcn_rcpf(1.0f + __expf(b0[k] - a0[k])); lb[bj][4 + k] = __builtin_amdgcn_rcpf(1.0f + __expf(b1[k] - a1[k])); } }
        }
#pragma unroll
        for (int ai = 0; ai < 2; ++ai)
#pragma unroll
            for (int m = 0; m < 4; ++m) { const int row = row0 + ai * HALF + m * 16; bf16_t* rowp = H + (size_t)row * 22528 + col0; float s1 = 0.f, s2 = 0.f;
#pragma unroll
                for (int bj = 0; bj < 2; ++bj) { float v[8];
#pragma unroll
                    for (int k = 0; k < 4; ++k) { v[k] = acc[ai][bj][m][0][k]; v[4 + k] = acc[ai][bj][m][1][k]; }
#pragma unroll
                    for (int k = 0; k < 8; ++k) {
                        if (ACT == 0 || ACT == 1) v[k] = fgelu(v[k]);
                        if (ACT == 2) v[k] = fsilu(v[k]);
                        if (ACT == 3) v[k] = __logf(lb[bj][k] + (1.0f - lb[bj][k]) * fsigmoid(v[k]));
                        if (ACT == 5) v[k] = fsigmoid(v[k]);
                        if (ACT == 1) { s1 += v[k]; s2 += v[k] * v[k]; }
                    }
                    u32x4 w; w.x = cvt_pk_bf16(v[0], v[1]); w.y = cvt_pk_bf16(v[2], v[3]); w.z = cvt_pk_bf16(v[4], v[5]); w.w = cvt_pk_bf16(v[6], v[7]);
                    *(u32x4*)(rowp + bj * HALF) = w; }
                if (ACT == 1) { s1 += __shfl_xor(s1, 16); s1 += __shfl_xor(s1, 32); s2 += __shfl_xor(s2, 16); s2 += __shfl_xor(s2, 32);
                    if (fq == 0) { f32x2 o; o.x = s1; o.y = s2; *(f32x2*)(lnp + (size_t)row * 64 + ((u.pn - 8) * 4 + wc) * 2) = o; } }
            }
    }
    __device__ __forceinline__ void operator()(const f32x4 (&acc)[2][2][4][2], const Unit& u, int wr, int wc, int fr, int fq) const {
        const int pn = u.pn;
        if (pn < 8) run<0>(acc, u, wr, wc, fr, fq);
        else if (pn < 16) run<1>(acc, u, wr, wc, fr, fq);
        else if (pn < 32) run<2>(acc, u, wr, wc, fr, fq);
        else if (pn < 40) run<3>(acc, u, wr, wc, fr, fq);
        else if (pn < 48) run<4>(acc, u, wr, wc, fr, fq);
        else if (pn < 56) run<2>(acc, u, wr, wc, fr, fq);
        else run<5>(acc, u, wr, wc, fr, fq);
    }
};

struct EpiMerge {
    static constexpr bool PERM = true, AFTER_DRAIN = false, CARRY = true;
    const bf16_t* H; bf16_t* O;
    __device__ __forceinline__ void mid(f32x4 (&acc)[2][2][4][2], const Unit& u, int wr, int wc, int fr, int fq) const {
        const int row0 = u.pm * BM + wr * 64 + fr, col0 = u.pn * BM + wc * 32 + 8 * fq;
#pragma unroll
        for (int ai = 0; ai < 2; ++ai)
#pragma unroll
            for (int m = 0; m < 4; ++m) { const bf16_t* gp = H + (size_t)(row0 + ai * HALF + m * 16) * 22528 + 14336 + col0;
#pragma unroll
                for (int bj = 0; bj < 2; ++bj) { const u32x4 a = *(const u32x4*)(gp + bj * HALF), b = *(const u32x4*)(gp + 4096 + bj * HALF);
                    f32x4 r0, r1;
                    r0[0] = f_lo(a.x) * __builtin_amdgcn_rcpf(f_lo(b.x)); r0[1] = f_hi(a.x) * __builtin_amdgcn_rcpf(f_hi(b.x)); r0[2] = f_lo(a.y) * __builtin_amdgcn_rcpf(f_lo(b.y)); r0[3] = f_hi(a.y) * __builtin_amdgcn_rcpf(f_hi(b.y));
                    r1[0] = f_lo(a.z) * __builtin_amdgcn_rcpf(f_lo(b.z)); r1[1] = f_hi(a.z) * __builtin_amdgcn_rcpf(f_hi(b.z)); r1[2] = f_lo(a.w) * __builtin_amdgcn_rcpf(f_lo(b.w)); r1[3] = f_hi(a.w) * __builtin_amdgcn_rcpf(f_hi(b.w));
                    acc[ai][bj][m][0] *= r0; acc[ai][bj][m][1] *= r1; }
                if (m == 3) asm volatile("" ::: "memory"); }
    }
    __device__ __forceinline__ void operator()(f32x4 (&acc)[2][2][4][2], const Unit& u, int wr, int wc, int fr, int fq) const {
        if (u.kh == 0) { mid(acc, u, wr, wc, fr, fq); return; }
        const int row0 = u.pm * BM + wr * 64 + fr, col0 = u.pn * BM + wc * 32 + 8 * fq;
#pragma unroll
        for (int ai = 0; ai < 2; ++ai)
#pragma unroll
            for (int m = 0; m < 4; ++m) { const int row = row0 + ai * HALF + m * 16; const bf16_t* gp = H + (size_t)row * 22528 + 18432 + col0; bf16_t* rowp = O + (size_t)row * 4096 + col0;
#pragma unroll
                for (int bj = 0; bj < 2; ++bj) { const u32x4 b = *(const u32x4*)(gp + bj * HALF); const f32x4 v0 = acc[ai][bj][m][0], v1 = acc[ai][bj][m][1];
                    u32x4 w; w.x = cvt_pk_bf16(v0[0] * f_lo(b.x), v0[1] * f_hi(b.x)); w.y = cvt_pk_bf16(v0[2] * f_lo(b.y), v0[3] * f_hi(b.y));
                    w.z = cvt_pk_bf16(v1[0] * f_lo(b.z), v1[1] * f_hi(b.z)); w.w = cvt_pk_bf16(v1[2] * f_lo(b.w), v1[3] * f_hi(b.w));
                    *(u32x4*)(rowp + bj * HALF) = w; }
                if (m == 3) asm volatile("" ::: "memory"); }
    }
};

struct EpiZ {
    static constexpr bool PERM = true, AFTER_DRAIN = false, CARRY = false;
    bf16_t* Z; float* ssp;
    __device__ __forceinline__ void operator()(const f32x4 (&acc)[2][2][4][2], const Unit& u, int wr, int wc, int fr, int fq) const {
        const int row0 = u.pm * BM + wr * 64 + fr, col0 = u.pn * BM + wc * 32 + 8 * fq;
#pragma unroll
        for (int ai = 0; ai < 2; ++ai)
#pragma unroll
            for (int m = 0; m < 4; ++m) { const int row = row0 + ai * HALF + m * 16; bf16_t* rowp = Z + (size_t)row * 4096 + col0; float ss = 0.f;
#pragma unroll
                for (int bj = 0; bj < 2; ++bj) { const f32x4 v0 = acc[ai][bj][m][0], v1 = acc[ai][bj][m][1];
                    ss += (v0[0] * v0[0] + v0[1] * v0[1]) + (v0[2] * v0[2] + v0[3] * v0[3]) + (v1[0] * v1[0] + v1[1] * v1[1]) + (v1[2] * v1[2] + v1[3] * v1[3]);
                    u32x4 w; w.x = cvt_pk_bf16(v0[0], v0[1]); w.y = cvt_pk_bf16(v0[2], v0[3]); w.z = cvt_pk_bf16(v1[0], v1[1]); w.w = cvt_pk_bf16(v1[2], v1[3]);
                    *(u32x4*)(rowp + bj * HALF) = w; }
                ss += __shfl_xor(ss, 16); ss += __shfl_xor(ss, 32);
                if (fq == 0) ssp[(size_t)row * 64 + u.pn * 4 + wc] = ss; }
    }
};

struct PairOrder : StaticOrder {
    __device__ bool next(int i, Unit& u) const { if (!StaticOrder::next(i >> 1, u)) return false; u.kh = i & 1; return true; }
};

struct RevOrder : StaticOrder {
    __device__ bool next(int i, Unit& u) const { if (!StaticOrder::next(i, u)) return false; u.pn = nN - 1 - u.pn; return true; }
};

template <class Epi, class Sched, bool ALIGN_EPI = false, bool SP2 = false>
__device__ __forceinline__ void gemm_phase(PG8_LAS unsigned char* lds, const Gemm g, const Sched& S, const Epi& E) {
    int tid_o = threadIdx.x; asm volatile("" : "+v"(tid_o));
    const int tid = tid_o, wid = __builtin_amdgcn_readfirstlane(tid >> 6), lane = tid & 63, wr = wid >> 2, wc = wid & 3, fr = lane & 15, fq = lane >> 4;
    const int K = g.K, nt = g.nt;
    unsigned voffA[2], voffB[2];
#pragma unroll
    for (int i = 0; i < 2; ++i) { int R, C; stage_rc(tid * 16 + i * 8192, R, C); const int Rb = Epi::PERM ? ((R & ~31) + perm32(R & 31)) : R;
        voffA[i] = (unsigned)(R * K + C) * 2u; voffB[i] = (unsigned)(Rb * K + C) * 2u; }
    const size_t kstep = (size_t)(BK * 2);
    const size_t hstep = (size_t)HALF * K * 2;
    const size_t tstep = 2 * hstep;
    const unsigned ldsw = (unsigned)wid * 1024u;
    const int aoff = lds_byte(wr * 64 + fr, fq * 8), boff = lds_byte(wc * 32 + fr, fq * 8);
#define PG8_SA(b, h) (((b) * 2 + (h)) * HTB)
#define PG8_SB(b, h) ((4 + (b) * 2 + (h)) * HTB)
#define PG8_STAGE(bufoff, gbase, voff) do { _Pragma("unroll") for (int _i = 0; _i < 2; ++_i) \
        __builtin_amdgcn_global_load_lds((const unsigned*)((const char*)(gbase) + (voff)[_i]), (PG8_LAS unsigned*)(lds + (bufoff) + ldsw + _i * 8192), 16, 0, 0); } while (0)
#define PG8_LDA(dst, b, h) do { _Pragma("unroll") for (int m = 0; m < 4; ++m) _Pragma("unroll") for (int k = 0; k < 2; ++k) dst[m][k] = *(const PG8_LAS bf16x8*)(lds + PG8_SA(b, h) + aoff + m * 2048 + k * 1024); } while (0)
#define PG8_LDB(dst, b, h) do { _Pragma("unroll") for (int n = 0; n < 2; ++n) _Pragma("unroll") for (int k = 0; k < 2; ++k) dst[n][k] = *(const PG8_LAS bf16x8*)(lds + PG8_SB(b, h) + boff + n * 2048 + k * 1024); } while (0)
#define PG8_MMA(ai, bj, At, Bt) do { __builtin_amdgcn_s_setprio(1); _Pragma("unroll") for (int m = 0; m < 4; ++m) _Pragma("unroll") for (int n = 0; n < 2; ++n) _Pragma("unroll") for (int k = 0; k < 2; ++k) \
        acc[ai][bj][m][n] = __builtin_amdgcn_mfma_f32_16x16x32_bf16(Bt[n][k], At[m][k], acc[ai][bj][m][n], 0, 0, 0); __builtin_amdgcn_s_setprio(0); } while (0)
#define PG8_WAIT_V(n) asm volatile("s_waitcnt vmcnt(" #n ")" ::: "memory")
#define PG8_WAIT_L(n) asm volatile("s_waitcnt lgkmcnt(" #n ")" ::: "memory")
#define PG8_BAR __builtin_amdgcn_s_barrier()
#define PG8_SCHED __builtin_amdgcn_sched_barrier(0)
    Unit cur, nxt; int ui = 0;
    if (!S.next(0, cur)) return;
    f32x4 acc[2][2][4][2];
#pragma unroll
    for (int a = 0; a < 2; ++a)
#pragma unroll
        for (int b = 0; b < 2; ++b)
#pragma unroll
            for (int m = 0; m < 4; ++m)
#pragma unroll
                for (int n = 0; n < 2; ++n) acc[a][b][m][n] = (f32x4){0.f, 0.f, 0.f, 0.f};
    bf16x8 At[4][2], B0[2][2], B1[2][2];
    const char* cA = (const char*)g.A + (size_t)cur.pm * tstep + (size_t)cur.kh * g.khoff; const char* cB = (const char*)g.Bt + (size_t)cur.pn * tstep + (size_t)cur.kh * g.khoff;
    S.a_ready(cur);
    if constexpr (SP2) {
        PG8_STAGE(PG8_SB(0, 0), cB, voffB); PG8_STAGE(PG8_SB(0, 1), cB + hstep, voffB); PG8_STAGE(PG8_SA(0, 0), cA, voffA); PG8_STAGE(PG8_SA(0, 1), cA + hstep, voffA);
        if (wr == 1) PG8_BAR;
        PG8_WAIT_V(2); PG8_BAR;
        PG8_STAGE(PG8_SB(1, 0), cB + kstep, voffB); PG8_STAGE(PG8_SA(1, 0), cA + kstep, voffA); PG8_STAGE(PG8_SB(1, 1), cB + hstep + kstep, voffB);
        PG8_WAIT_V(6); PG8_BAR;
    } else {
        PG8_STAGE(PG8_SB(0, 0), cB, voffB); PG8_STAGE(PG8_SA(0, 0), cA, voffA); PG8_STAGE(PG8_SB(0, 1), cB + hstep, voffB); PG8_STAGE(PG8_SA(0, 1), cA + hstep, voffA);
        if (wr == 1) PG8_BAR;
        PG8_WAIT_V(4); PG8_BAR;
        PG8_STAGE(PG8_SB(1, 0), cB + kstep, voffB); PG8_STAGE(PG8_SA(1, 0), cA + kstep, voffA); PG8_STAGE(PG8_SB(1, 1), cB + hstep + kstep, voffB);
        PG8_WAIT_V(6); PG8_BAR;
    }
    for (;;) {
        const bool has_next = S.next(ui + 1, nxt);
        const char* nA = has_next ? (const char*)g.A + (size_t)nxt.pm * tstep + (size_t)nxt.kh * g.khoff : cA; const char* nB = has_next ? (const char*)g.Bt + (size_t)nxt.pn * tstep + (size_t)nxt.kh * g.khoff : cB;
        for (int t = 0; t < nt; t += 2) {
            const bool last = (t == nt - 2);
            const char* a1 = cA + (size_t)(t + 1) * kstep;
            const char* a2 = last ? nA : cA + (size_t)(t + 2) * kstep; const char* b2 = last ? nB : cB + (size_t)(t + 2) * kstep;
            const char* a3 = a2 + kstep; const char* b3 = b2 + kstep;
            if (last && has_next) S.a_ready(nxt);
            if constexpr (SP2) {
            PG8_LDB(B0, 0, 0); PG8_LDB(B1, 0, 1); PG8_SCHED; PG8_LDA(At, 0, 0); PG8_STAGE(PG8_SA(1, 1), a1 + hstep, voffA);
            PG8_WAIT_V(8); PG8_WAIT_L(0); PG8_BAR; PG8_MMA(0, 0, At, B0); PG8_MMA(0, 1, At, B1); PG8_BAR; PG8_SCHED;
            PG8_LDA(At, 0, 1); PG8_STAGE(PG8_SB(0, 0), b2, voffB); PG8_STAGE(PG8_SB(0, 1), b2 + hstep, voffB); PG8_STAGE(PG8_SA(0, 0), a2, voffA);
            PG8_WAIT_V(8); PG8_WAIT_L(0); PG8_BAR; PG8_MMA(1, 0, At, B0); PG8_MMA(1, 1, At, B1); PG8_BAR; PG8_SCHED;
            PG8_LDB(B0, 1, 0); PG8_LDB(B1, 1, 1); PG8_SCHED; PG8_LDA(At, 1, 0); PG8_STAGE(PG8_SA(0, 1), a2 + hstep, voffA);
            PG8_WAIT_V(8); PG8_WAIT_L(0); PG8_BAR; PG8_MMA(0, 0, At, B0); PG8_MMA(0, 1, At, B1); PG8_BAR; PG8_SCHED;
            PG8_LDA(At, 1, 1); PG8_STAGE(PG8_SB(1, 0), b3, voffB); PG8_STAGE(PG8_SB(1, 1), b3 + hstep, voffB); PG8_STAGE(PG8_SA(1, 0), a3, voffA);
            PG8_WAIT_V(8); PG8_WAIT_L(0); PG8_BAR; PG8_MMA(1, 0, At, B0); PG8_MMA(1, 1, At, B1); PG8_BAR; PG8_SCHED;
            } else {
            PG8_LDB(B0, 0, 0); PG8_SCHED; PG8_LDA(At, 0, 0); PG8_STAGE(PG8_SA(1, 1), a1 + hstep, voffA);
            PG8_WAIT_L(8); PG8_BAR; PG8_WAIT_L(0); PG8_MMA(0, 0, At, B0); PG8_BAR; PG8_SCHED;
            PG8_LDB(B1, 0, 1); PG8_STAGE(PG8_SB(0, 0), b2, voffB);
            PG8_BAR; PG8_WAIT_L(0); PG8_MMA(0, 1, At, B1); PG8_BAR;
            PG8_LDA(At, 0, 1); PG8_STAGE(PG8_SA(0, 0), a2, voffA);
            PG8_BAR; PG8_WAIT_L(0); PG8_MMA(1, 0, At, B0); PG8_BAR; PG8_SCHED;
            PG8_STAGE(PG8_SB(0, 1), b2 + hstep, voffB);
            PG8_WAIT_V(6); PG8_BAR; PG8_MMA(1, 1, At, B1); PG8_BAR;
            PG8_LDB(B0, 1, 0); PG8_SCHED; PG8_LDA(At, 1, 0); PG8_STAGE(PG8_SA(0, 1), a2 + hstep, voffA);
            PG8_WAIT_L(8); PG8_BAR; PG8_WAIT_L(0); PG8_MMA(0, 0, At, B0); PG8_BAR; PG8_SCHED;
            PG8_LDB(B1, 1, 1); PG8_STAGE(PG8_SB(1, 0), b3, voffB);
            PG8_BAR; PG8_WAIT_L(0); PG8_MMA(0, 1, At, B1); PG8_BAR;
            PG8_LDA(At, 1, 1); PG8_STAGE(PG8_SA(1, 0), a3, voffA);
            PG8_BAR; PG8_WAIT_L(0); PG8_MMA(1, 0, At, B0); PG8_BAR; PG8_SCHED;
            PG8_STAGE(PG8_SB(1, 1), b3 + hstep, voffB);
            PG8_WAIT_V(6); PG8_BAR; PG8_MMA(1, 1, At, B1); PG8_BAR;
            }
        }
        if constexpr (ALIGN_EPI) { if (wr == 0) PG8_BAR; }
        if constexpr (!Epi::AFTER_DRAIN) { E(acc, cur, wr, wc, fr, fq); S.done(cur); }
        if (!has_next) break;
        if (!(Epi::CARRY && cur.kh == 0)) {
#pragma unroll
        for (int a = 0; a < 2; ++a)
#pragma unroll
            for (int b = 0; b < 2; ++b)
#pragma unroll
                for (int m = 0; m < 4; ++m)
#pragma unroll
                    for (int n = 0; n < 2; ++n) acc[a][b][m][n] = (f32x4){0.f, 0.f, 0.f, 0.f};
        }
        cur = nxt; cA = nA; cB = nB; ++ui;
        if constexpr (ALIGN_EPI) { if (wr == 1) PG8_BAR; }
    }
    PG8_WAIT_V(0);
    if constexpr (!ALIGN_EPI) { if (wr == 0) PG8_BAR; }
    PG8_BAR;
    if constexpr (Epi::AFTER_DRAIN) { E.fused(acc, cur, wr, wc, fr, fq, lds, wid, lane); S.done(cur); }
#undef PG8_SA
#undef PG8_SB
#undef PG8_STAGE
#undef PG8_LDA
#undef PG8_LDB
#undef PG8_MMA
#undef PG8_WAIT_V
#undef PG8_WAIT_L
#undef PG8_BAR
#undef PG8_SCHED
}
}

using pg8::bf16_t; using pg8::bf16x8; using pg8::f32x4; using pg8::u32x4; using pg8::f32x2; using pg8::cvt_pk_bf16; using pg8::bf2f; using pg8::f_lo; using pg8::f_hi;
typedef unsigned u32x2 __attribute__((ext_vector_type(2)));
#define LDS_WAIT() asm volatile("s_waitcnt lgkmcnt(0)" ::: "memory")
#define MFMA16(X, Y, C) __builtin_amdgcn_mfma_f32_16x16x32_bf16((X), (Y), (C), 0, 0, 0)

struct Params {
    const float *xp, *xs, *st0, *lbl, *gpre, *win, *lng, *lnb, *wsp, *bsp, *gon, *wpa, *wpb, *wo, *gpost;
    float* out; unsigned char* ws; int lo, hi;
};

__device__ __forceinline__ float wave_sum(float v) {
#pragma unroll
    for (int o = 1; o < 64; o <<= 1) v += __shfl_xor(v, o);
    return v;
}

__device__ __forceinline__ void p0_transpose_item(const float* W, int N, bf16_t* WT, int ldd, int koff, LAS float* scr, int kb, int nb, int lane) {
    const int k0 = 64 * kb, n0 = 32 * nb;
    float wv[32];
#pragma unroll
    for (int i = 0; i < 32; ++i) wv[i] = __builtin_nontemporal_load(&W[(size_t)(k0 + 2 * i + (lane >> 5)) * N + n0 + (lane & 31)]);
#pragma unroll
    for (int i = 0; i < 32; ++i) scr[(2 * i + (lane >> 5)) * 33 + (lane & 31)] = wv[i];
    LDS_WAIT(); asm volatile("" ::: "memory");
    const int c = lane & 7;
#pragma unroll
    for (int j = 0; j < 4; ++j) { const int n = (lane >> 3) + 8 * j; const LAS float* s = scr + (8 * c) * 33 + n;
        u32x4 o; o.x = cvt_pk_bf16(s[0 * 33], s[1 * 33]); o.y = cvt_pk_bf16(s[2 * 33], s[3 * 33]); o.z = cvt_pk_bf16(s[4 * 33], s[5 * 33]); o.w = cvt_pk_bf16(s[6 * 33], s[7 * 33]);
        *(u32x4*)(WT + (size_t)(n0 + n) * ldd + koff + k0 + 8 * c) = o; }
    LDS_WAIT(); asm volatile("" ::: "memory");
}

__device__ __forceinline__ void phase0(const Params& p, LAS unsigned char* lds) {
    const int tid = threadIdx.x, lane = tid & 63, wid = tid >> 6;
    const int gw = blockIdx.x * 8 + wid, NGW = gridDim.x * 8;
    unsigned char* ws = p.ws;
    bf16_t* WTIN = (bf16_t*)(ws + WS_WTIN); bf16_t* WTAB = (bf16_t*)(ws + WS_WTAB); bf16_t* WTO = (bf16_t*)(ws + WS_WTO);
    bf16_t* XN = (bf16_t*)(ws + WS_XN); bf16_t* YAB = (bf16_t*)(ws + WS_YAB); bf16_t* WSM = (bf16_t*)(ws + WS_WSM);
    LAS float* scr = (LAS float*)(lds + wid * 8448);
    constexpr int I_IN = 64 * 704, I_PA = 32 * 128, I_O = 64 * 128, NIT = I_IN + 2 * I_PA + I_O;
    for (int it = gw; it < NIT; it += NGW) {
        int r = it;
        if (r < I_IN) { p0_transpose_item(p.win, NC, WTIN, DM, 0, scr, r / 704, r % 704, lane); continue; } r -= I_IN;
        if (r < I_PA) { p0_transpose_item(p.wpa, DM, WTAB, DM, 0, scr, r / 128, r % 128, lane); continue; } r -= I_PA;
        if (r < I_PA) { p0_transpose_item(p.wpb, DM, WTAB, DM, 2048, scr, r / 128, r % 128, lane); continue; } r -= I_PA;
        p0_transpose_item(p.wo, DM, WTO, DM, 0, scr, r / 128, r % 128, lane);
    }
    for (int m = gw; m < MP; m += NGW) {
        u32x2* o8 = (u32x2*)(XN + (size_t)m * DM) + lane;
        if (m < MT) {
            const float* xr = (m < TP) ? p.xp + (size_t)m * DM : p.xs + (size_t)(m - TP) * DM;
            const f32x4* x4 = (const f32x4*)xr + lane; const f32x4* g4 = (const f32x4*)p.gpre + lane;
            f32x4 v[16]; float s = 0.f;
#pragma unroll
            for (int j = 0; j < 16; ++j) { v[j] = __builtin_nontemporal_load(&x4[64 * j]); s += (v[j][0] * v[j][0] + v[j][1] * v[j][1]) + (v[j][2] * v[j][2] + v[j][3] * v[j][3]); }
            const float rs = __builtin_amdgcn_rsqf(wave_sum(s) * (1.0f / DM) + EPS);
#pragma unroll
            for (int j = 0; j < 16; ++j) { const f32x4 g = g4[64 * j]; u32x2 w; w.x = cvt_pk_bf16(v[j][0] * rs * g[0], v[j][1] * rs * g[1]); w.y = cvt_pk_bf16(v[j][2] * rs * g[2], v[j][3] * rs * g[3]); o8[64 * j] = w; }
        } else {
            u32x2* y8 = (u32x2*)(YAB + (size_t)m * DM) + lane; u32x2 z; z.x = 0u; z.y = 0u;
#pragma unroll
            for (int j = 0; j < 16; ++j) { o8[64 * j] = z; y8[64 * j] = z; }
        }
    }
    for (int i = blockIdx.x * 512 + tid; i < 16 * 128 * 128; i += gridDim.x * 512) { const int s = i & 127, t = (i >> 7) & 127; WSM[i] = (s <= t) ? (bf16_t)(cvt_pk_bf16(p.wsp[i], 0.f) & 0xffffu) : (bf16_t)0; }
}

__device__ __forceinline__ void hgrn_prep_phase(const Params& p, LAS unsigned char* lds, int first, int stride, int end) {
    int tid_o = threadIdx.x; asm volatile("" : "+v"(tid_o));
    const int tid = tid_o, lane = tid & 63, w = tid >> 6, fr = lane & 15, fq = lane >> 4, d = tid & 127, tq = tid >> 7;
    const int pr = tid >> 4, pc = (tid & 15) * 8;
    u32x4 R[6];
#define PREP_LOAD(item_) do { const int h_ = (item_) & 15, n_ = ((item_) >> 4) & 31, b_ = (item_) >> 9; const bf16_t* g_ = (const bf16_t*)(p.ws + WS_H) + (size_t)(b_ * 2048 + n_ * 64 + pr) * NC + COL_Q + h_ * 128 + pc; \
        R[0] = *(const u32x4*)g_; R[1] = *(const u32x4*)(g_ + (size_t)32 * NC); R[2] = *(const u32x4*)(g_ + (COL_F - COL_Q)); R[3] = *(const u32x4*)(g_ + (size_t)32 * NC + (COL_F - COL_Q)); \
        R[4] = *(const u32x4*)(g_ + (COL_I - COL_Q)); R[5] = *(const u32x4*)(g_ + (size_t)32 * NC + (COL_I - COL_Q)); } while (0)
    if (first < end) PREP_LOAD(first);
    for (int item = first; item < end; item += stride) {
    const int h = item & 15, n = (item >> 4) & 31, b = item >> 9;
    const int t0 = b * 2048 + n * 64;
    unsigned char* ws = p.ws;
    bf16_t* QT0 = (bf16_t*)(ws + WS_QT0); bf16_t* KTT = (bf16_t*)(ws + WS_KTT); bf16_t* ITT = (bf16_t*)(ws + WS_ITT); float* OIN = (float*)(ws + WS_OIN); float* DEC = (float*)(ws + WS_DEC);
    LAS bf16_t* Qm = (LAS bf16_t*)lds;
    LAS bf16_t* Km = Qm + 64 * 136;
    LAS bf16_t* ITs = Km + 64 * 136;
    LAS bf16_t* Att = ITs + 128 * 72;
    LAS float* tot = (LAS float*)(Att + 64 * 72);
    LAS bf16_t* Lq = (LAS bf16_t*)(tot + 512);
    LAS bf16_t* Lf = Lq + 64 * 136; LAS bf16_t* Li = Lf + 64 * 136;
    *(LAS u32x4*)(Lq + pr * 136 + pc) = R[0]; *(LAS u32x4*)(Lq + (pr + 32) * 136 + pc) = R[1]; *(LAS u32x4*)(Lf + pr * 136 + pc) = R[2]; *(LAS u32x4*)(Lf + (pr + 32) * 136 + pc) = R[3];
    *(LAS u32x4*)(Li + pr * 136 + pc) = R[4]; *(LAS u32x4*)(Li + (pr + 32) * 136 + pc) = R[5];
    __syncthreads();
    { const int nx = item + stride; if (nx < end) PREP_LOAD(nx); }
    float lf[16], qv[16]; unsigned iv[16];
#pragma unroll
    for (int j = 0; j < 16; ++j) { qv[j] = bf2f(Lq[(tq * 16 + j) * 136 + d]); lf[j] = bf2f(Lf[(tq * 16 + j) * 136 + d]); iv[j] = Li[(tq * 16 + j) * 136 + d]; }
    float run = 0.f, cs[16];
#pragma unroll
    for (int j = 0; j < 16; ++j) { run += lf[j]; cs[j] = run; }
    tot[tq * 128 + d] = run;
    __syncthreads();
    const float t0v = tot[d], t1v = tot[128 + d], t2v = tot[256 + d], t3v = tot[384 + d];
    const float off = (tq > 0 ? t0v : 0.f) + (tq > 1 ? t1v : 0.f) + (tq > 2 ? t2v : 0.f);
    const float bmid = t0v + t1v, blast = (t0v + t1v) + (t2v + t3v);
    unsigned kl[8], ip[8];
#pragma unroll
    for (int j = 0; j < 16; j += 2) {
        float q0[2], klv[2];
#pragma unroll
        for (int jj = 0; jj < 2; ++jj) { const int J = j + jj; const float bj = off + cs[J]; const float f = __expf(lf[J]); const float k = 1.0f - f;
            q0[jj] = qv[J] * __expf(bj); klv[jj] = k * __expf(blast - bj);
            const float qm = qv[J] * __expf(bj - bmid), km = k * __expf(bmid - bj);
            const unsigned pk = cvt_pk_bf16(qm, km);
            Qm[(tq * 16 + J) * 136 + d] = (bf16_t)(pk & 0xffffu); Km[(tq * 16 + J) * 136 + d] = (bf16_t)(pk >> 16);
            QT0[(size_t)(t0 + tq * 16 + J) * EA + h * 128 + d] = (bf16_t)(cvt_pk_bf16(q0[jj], 0.f) & 0xffffu); }
        kl[j >> 1] = cvt_pk_bf16(klv[0], klv[1]); ip[j >> 1] = iv[j] | (iv[j + 1] << 16);
    }
    { u32x4 a, c2; a.x = kl[0]; a.y = kl[1]; a.z = kl[2]; a.w = kl[3]; c2.x = kl[4]; c2.y = kl[5]; c2.z = kl[6]; c2.w = kl[7];
      u32x4* kp = (u32x4*)(KTT + ((size_t)item * 128 + d) * 64 + tq * 16); kp[0] = a; kp[1] = c2;
      u32x4 e, f2; e.x = ip[0]; e.y = ip[1]; e.z = ip[2]; e.w = ip[3]; f2.x = ip[4]; f2.y = ip[5]; f2.z = ip[6]; f2.w = ip[7];
      u32x4* ipp = (u32x4*)(ITT + ((size_t)item * 128 + d) * 64 + tq * 16); ipp[0] = e; ipp[1] = f2;
      LAS u32x4* il = (LAS u32x4*)(ITs + d * 72 + tq * 16); il[0] = e; il[1] = f2; }
    if (tq == 0) DEC[(size_t)item * 128 + d] = __expf(blast);
    __syncthreads();
    {
        const int tb = w >> 1;
#pragma unroll
        for (int x = 0; x < 2; ++x) { const int sb = (w & 1) * 2 + x; f32x4 acc = {0.f, 0.f, 0.f, 0.f};
            if (sb <= tb) {
#pragma unroll
                for (int ks = 0; ks < 4; ++ks) { const bf16x8 X = *(const LAS bf16x8*)(Km + (sb * 16 + fr) * 136 + ks * 32 + fq * 8), Y = *(const LAS bf16x8*)(Qm + (tb * 16 + fr) * 136 + ks * 32 + fq * 8); acc = MFMA16(X, Y, acc); }
                const int t = tb * 16 + fr, s0 = sb * 16 + fq * 4;
#pragma unroll
                for (int j = 0; j < 4; ++j) acc[j] = (s0 + j <= t) ? acc[j] : 0.f;
            }
            u32x2 o; o.x = cvt_pk_bf16(acc[0], acc[1]); o.y = cvt_pk_bf16(acc[2], acc[3]);
            *(LAS u32x2*)(Att + (tb * 16 + fr) * 72 + sb * 16 + fq * 4) = o; }
    }
    __syncthreads();
    {
        const int eb = w;
#pragma unroll
        for (int tb = 0; tb < 4; ++tb) { f32x4 acc = {0.f, 0.f, 0.f, 0.f};
#pragma unroll
            for (int ks = 0; ks < 2; ++ks) { if (ks * 32 <= tb * 16 + 15) { const bf16x8 X = *(const LAS bf16x8*)(ITs + (eb * 16 + fr) * 72 + ks * 32 + fq * 8), Y = *(const LAS bf16x8*)(Att + (tb * 16 + fr) * 72 + ks * 32 + fq * 8); acc = MFMA16(X, Y, acc); } }
            *(f32x4*)(OIN + (size_t)(t0 + tb * 16 + fr) * EA + h * 128 + eb * 16 + fq * 4) = acc; }
    }
    __syncthreads();
    }
#undef PREP_LOAD
}

__device__ __forceinline__ void hgrn_scan_item(const Params& p, LAS unsigned char* lds, int bh) {
    const int tid = threadIdx.x, lane = tid & 63, w = tid >> 6, fr = lane & 15, fq = lane >> 4;
    const int b = bh >> 4, h = bh & 15;
    unsigned char* ws = p.ws;
    const bf16_t* H = (const bf16_t*)(ws + WS_H); bf16_t* YAB = (bf16_t*)(ws + WS_YAB);
    const bf16_t* QT0 = (const bf16_t*)(ws + WS_QT0); const bf16_t* KTT = (const bf16_t*)(ws + WS_KTT); const bf16_t* ITT = (const bf16_t*)(ws + WS_ITT);
    const float* OIN = (const float*)(ws + WS_OIN); const float* DEC = (const float*)(ws + WS_DEC);
    LAS bf16_t* ST = (LAS bf16_t*)lds;
    LAS float* ssq = (LAS float*)(lds + 128 * 136 * 2);
    f32x4 S[8];
#pragma unroll
    for (int eb = 0; eb < 8; ++eb) S[eb] = (f32x4){0.f, 0.f, 0.f, 0.f};
    const int tb = w & 3, eh = w >> 2;
    const f32x4 gon[4] = { *(const f32x4*)(p.gon + h * 128 + (eh * 4 + 0) * 16 + fq * 4), *(const f32x4*)(p.gon + h * 128 + (eh * 4 + 1) * 16 + fq * 4),
                           *(const f32x4*)(p.gon + h * 128 + (eh * 4 + 2) * 16 + fq * 4), *(const f32x4*)(p.gon + h * 128 + (eh * 4 + 3) * 16 + fq * 4) };
    for (int n = 0; n < 32; ++n) {
        const int itn = (b * 32 + n) * 16 + h, t = b * 2048 + n * 64 + tb * 16 + fr;
#pragma unroll
        for (int eb = 0; eb < 8; ++eb) { u32x2 o; o.x = cvt_pk_bf16(S[eb][0], S[eb][1]); o.y = cvt_pk_bf16(S[eb][2], S[eb][3]); *(LAS u32x2*)(ST + (eb * 16 + fr) * 136 + w * 16 + fq * 4) = o; }
        __syncthreads();
        bf16x8 Yq[4];
#pragma unroll
        for (int ks = 0; ks < 4; ++ks) Yq[ks] = *(const bf16x8*)(QT0 + (size_t)t * EA + h * 128 + ks * 32 + fq * 8);
        f32x4 o[4]; float ss = 0.f;
#pragma unroll
        for (int el = 0; el < 4; ++el) { f32x4 acc = *(const f32x4*)(OIN + (size_t)t * EA + h * 128 + (eh * 4 + el) * 16 + fq * 4);
#pragma unroll
            for (int ks = 0; ks < 4; ++ks) { const bf16x8 X = *(const LAS bf16x8*)(ST + ((eh * 4 + el) * 16 + fr) * 136 + ks * 32 + fq * 8); acc = MFMA16(X, Yq[ks], acc); }
            o[el] = acc; ss += (acc[0] * acc[0] + acc[1] * acc[1]) + (acc[2] * acc[2] + acc[3] * acc[3]); }
        ss += __shfl_xor(ss, 16); ss += __shfl_xor(ss, 32);
        if (fq == 0) ssq[eh * 64 + tb * 16 + fr] = ss;
        __syncthreads();
        const float rs = __builtin_amdgcn_rsqf((ssq[tb * 16 + fr] + ssq[64 + tb * 16 + fr]) * (1.0f / 128.0f) + EPS);
#pragma unroll
        for (int el = 0; el < 4; ++el) { const int col = h * 128 + (eh * 4 + el) * 16 + fq * 4; const u32x2 zb = *(const u32x2*)(H + (size_t)t * NC + COL_ZB + col);
            u32x2 y; y.x = cvt_pk_bf16(o[el][0] * rs * gon[el][0] * f_lo(zb.x), o[el][1] * rs * gon[el][1] * f_hi(zb.x)); y.y = cvt_pk_bf16(o[el][2] * rs * gon[el][2] * f_lo(zb.y), o[el][3] * rs * gon[el][3] * f_hi(zb.y));
            *(u32x2*)(YAB + (size_t)t * DM + 2048 + col) = y; }
        const f32x4 dec = *(const f32x4*)(DEC + (size_t)itn * 128 + w * 16 + fq * 4);
        const bf16x8 Xk0 = *(const bf16x8*)(KTT + ((size_t)itn * 128 + w * 16 + fr) * 64 + fq * 8), Xk1 = *(const bf16x8*)(KTT + ((size_t)itn * 128 + w * 16 + fr) * 64 + 32 + fq * 8);
#pragma unroll
        for (int eb = 0; eb < 8; ++eb) { const bf16_t* ip = ITT + ((size_t)itn * 128 + eb * 16 + fr) * 64 + fq * 8; const bf16x8 Y0 = *(const bf16x8*)ip, Y1 = *(const bf16x8*)(ip + 32);
            f32x4 a = S[eb] * dec; a = MFMA16(Xk0, Y0, a); a = MFMA16(Xk1, Y1, a); S[eb] = a; }
    }
    float* sp = p.out + O_SP + (size_t)bh * 128 * 128;
#pragma unroll
    for (int eb = 0; eb < 8; ++eb)
#pragma unroll
        for (int j = 0; j < 4; ++j) sp[(size_t)(w * 16 + fq * 4 + j) * 128 + eb * 16 + fr] = S[eb][j];
    __syncthreads();
}

__device__ __forceinline__ void hgrn_state_item(const Params& p, int it) {
    const int tid = threadIdx.x, lane = tid & 63, w = tid >> 6, fr = lane & 15, fq = lane >> 4;
    const int bh = it >> 1, eh = it & 1, b = bh >> 4, h = bh & 15;
    unsigned char* ws = p.ws;
    const bf16_t* KTT = (const bf16_t*)(ws + WS_KTT); const bf16_t* ITT = (const bf16_t*)(ws + WS_ITT); const float* DEC = (const float*)(ws + WS_DEC);
    bf16_t* SN = (bf16_t*)(ws + WS_SN);
    f32x4 S[4];
#pragma unroll
    for (int eb = 0; eb < 4; ++eb) S[eb] = (f32x4){0.f, 0.f, 0.f, 0.f};
    bf16x8 Xk0, Xk1, Y0[4], Y1[4]; f32x4 dec;
    {   const size_t itn = (size_t)(b * 32) * 16 + h;
        dec = *(const f32x4*)(DEC + itn * 128 + w * 16 + fq * 4);
        Xk0 = *(const bf16x8*)(KTT + (itn * 128 + w * 16 + fr) * 64 + fq * 8); Xk1 = *(const bf16x8*)(KTT + (itn * 128 + w * 16 + fr) * 64 + 32 + fq * 8);
#pragma unroll
        for (int eb = 0; eb < 4; ++eb) { const bf16_t* ip = ITT + (itn * 128 + (eh * 4 + eb) * 16 + fr) * 64 + fq * 8; Y0[eb] = *(const bf16x8*)ip; Y1[eb] = *(const bf16x8*)(ip + 32); } }
    for (int n = 0; n < 32; ++n) {
        const size_t itn = (size_t)(b * 32 + n) * 16 + h;
        const int nn = (n < 31) ? n + 1 : 31; const size_t itx = (size_t)(b * 32 + nn) * 16 + h;
        const f32x4 ndec = *(const f32x4*)(DEC + itx * 128 + w * 16 + fq * 4);
        const bf16x8 nXk0 = *(const bf16x8*)(KTT + (itx * 128 + w * 16 + fr) * 64 + fq * 8), nXk1 = *(const bf16x8*)(KTT + (itx * 128 + w * 16 + fr) * 64 + 32 + fq * 8);
        bf16x8 nY0[4], nY1[4];
#pragma unroll
        for (int eb = 0; eb < 4; ++eb) { const bf16_t* ip = ITT + (itx * 128 + (eh * 4 + eb) * 16 + fr) * 64 + fq * 8; nY0[eb] = *(const bf16x8*)ip; nY1[eb] = *(const bf16x8*)(ip + 32); }
#pragma unroll
        for (int eb = 0; eb < 4; ++eb) { u32x2 o; o.x = cvt_pk_bf16(S[eb][0], S[eb][1]); o.y = cvt_pk_bf16(S[eb][2], S[eb][3]); *(u32x2*)(SN + (itn * 128 + (eh * 4 + eb) * 16 + fr) * 128 + w * 16 + fq * 4) = o; }
#pragma unroll
        for (int eb = 0; eb < 4; ++eb) { f32x4 a = S[eb] * dec; a = MFMA16(Xk0, Y0[eb], a); a = MFMA16(Xk1, Y1[eb], a); S[eb] = a; }
        dec = ndec; Xk0 = nXk0; Xk1 = nXk1;
#pragma unroll
        for (int eb = 0; eb < 4; ++eb) { Y0[eb] = nY0[eb]; Y1[eb] = nY1[eb]; }
    }
    float* sp = p.out + O_SP + (size_t)bh * 128 * 128;
#pragma unroll
    for (int eb = 0; eb < 4; ++eb)
#pragma unroll
        for (int j = 0; j < 4; ++j) sp[(size_t)(w * 16 + fq * 4 + j) * 128 + (eh * 4 + eb) * 16 + fr] = S[eb][j];
}

__device__ __forceinline__ void hgrn_out_waveitem(const Params& p, int wi) {
    const int lane = threadIdx.x & 63, fr = lane & 15, fq = lane >> 4;
    const int tb = wi & 3, item = wi >> 2, h = item & 15, n = (item >> 4) & 31, b = item >> 9;
    unsigned char* ws = p.ws;
    const bf16_t* H = (const bf16_t*)(ws + WS_H); bf16_t* YAB = (bf16_t*)(ws + WS_YAB);
    const bf16_t* QT0 = (const bf16_t*)(ws + WS_QT0); const float* OIN = (const float*)(ws + WS_OIN); const bf16_t* SN = (const bf16_t*)(ws + WS_SN);
    const int t = b * 2048 + n * 64 + tb * 16 + fr;
    bf16x8 Yq[4];
#pragma unroll
    for (int ks = 0; ks < 4; ++ks) Yq[ks] = *(const bf16x8*)(QT0 + (size_t)t * EA + h * 128 + ks * 32 + fq * 8);
    f32x4 o[8]; float ss = 0.f;
#pragma unroll
    for (int eb = 0; eb < 8; ++eb) { f32x4 acc = *(const f32x4*)(OIN + (size_t)t * EA + h * 128 + eb * 16 + fq * 4);
        if (n > 0) {
#pragma unroll
            for (int ks = 0; ks < 4; ++ks) { const bf16x8 X = *(const bf16x8*)(SN + ((size_t)item * 128 + eb * 16 + fr) * 128 + ks * 32 + fq * 8); acc = MFMA16(X, Yq[ks], acc); } }
        o[eb] = acc; ss += (acc[0] * acc[0] + acc[1] * acc[1]) + (acc[2] * acc[2] + acc[3] * acc[3]); }
    ss += __shfl_xor(ss, 16); ss += __shfl_xor(ss, 32);
    const float rs = __builtin_amdgcn_rsqf(ss * (1.0f / 128.0f) + EPS);
#pragma unroll
    for (int eb = 0; eb < 8; ++eb) { const int col = h * 128 + eb * 16 + fq * 4; const u32x2 zb = *(const u32x2*)(H + (size_t)t * NC + COL_ZB + col); const f32x4 g = *(const f32x4*)(p.gon + col);
        u32x2 y; y.x = cvt_pk_bf16(o[eb][0] * rs * g[0] * f_lo(zb.x), o[eb][1] * rs * g[1] * f_hi(zb.x)); y.y = cvt_pk_bf16(o[eb][2] * rs * g[2] * f_lo(zb.y), o[eb][3] * rs * g[3] * f_hi(zb.y));
        *(u32x2*)(YAB + (size_t)t * DM + 2048 + col) = y; }
}

__device__ __forceinline__ void amix_ticket(const Params& p, LAS unsigned char* lds, int item0, int cnt) {
    int tid_o = threadIdx.x; asm volatile("" : "+v"(tid_o));
    const int tid = tid_o, lane = tid & 63, w = tid >> 6, fr = lane & 15, fq = lane >> 4;
    unsigned char* ws = p.ws;
    const bf16_t* H = (const bf16_t*)(ws + WS_H); bf16_t* YAB = (bf16_t*)(ws + WS_YAB); const bf16_t* WSM = (const bf16_t*)(ws + WS_WSM); const float* LNP = (const float*)(ws + WS_LNP);
    LAS bf16_t* VT = (LAS bf16_t*)lds;
    LAS float* stats = (LAS float*)(lds + 128 * 136 * 2);
    const int sr = tid >> 2, sq = tid & 3;
    f32x4 P[4]; u32x4 V[4];
#define AMIX_LOAD(item_) do { const int g_ = (item_) & 15, n_ = ((item_) >> 4) & 15, b_ = (item_) >> 8, t0_ = b_ * 2048 + n_ * 128; \
        const f32x4* lp_ = (const f32x4*)(LNP + (size_t)(t0_ + sr) * 64 + sq * 16); P[0] = lp_[0]; P[1] = lp_[1]; P[2] = lp_[2]; P[3] = lp_[3]; \
        _Pragma("unroll") for (int i = 0; i < 4; ++i) { const int id_ = tid + 512 * i; V[i] = *(const u32x4*)(H + (size_t)(t0_ + (id_ & 127)) * NC + COL_V + g_ * 128 + (id_ >> 7) * 8); } } while (0)
    AMIX_LOAD(item0);
    for (int ii = 0; ii < cnt; ++ii) {
        const int item = item0 + ii, g = item & 15, n = (item >> 4) & 15, b = item >> 8, t0 = b * 2048 + n * 128;
        const int tb = w, nks = (tb >> 1) + 1, t = t0 + tb * 16 + fr;
        u32x2 uu[8], zz[8];
#pragma unroll
        for (int cb = 0; cb < 8; ++cb) { const int col = g * 128 + cb * 16 + fq * 4; uu[cb] = *(const u32x2*)(H + (size_t)t * NC + COL_U + col); zz[cb] = *(const u32x2*)(H + (size_t)t * NC + COL_ZA + col); }
        { float s1 = (P[0][0] + P[0][2]) + (P[1][0] + P[1][2]) + (P[2][0] + P[2][2]) + (P[3][0] + P[3][2]), s2 = (P[0][1] + P[0][3]) + (P[1][1] + P[1][3]) + (P[2][1] + P[2][3]) + (P[3][1] + P[3][3]);
          s1 += __shfl_xor(s1, 1); s1 += __shfl_xor(s1, 2); s2 += __shfl_xor(s2, 1); s2 += __shfl_xor(s2, 2);
          if (sq == 0) { const float mean = s1 * (1.0f / 2048.0f), var = s2 * (1.0f / 2048.0f) - mean * mean; stats[sr * 2] = mean; stats[sr * 2 + 1] = __builtin_amdgcn_rsqf(var + EPS); } }
        __syncthreads();
#pragma unroll
        for (int i = 0; i < 4; ++i) { const int id = tid + 512 * i, r = id & 127, cc = id >> 7; const u32x4 v = V[i];
            const float mean = stats[r * 2], rstd = stats[r * 2 + 1];
            const f32x4 g0 = *(const f32x4*)(p.lng + g * 128 + cc * 8), g1 = *(const f32x4*)(p.lng + g * 128 + cc * 8 + 4), b0 = *(const f32x4*)(p.lnb + g * 128 + cc * 8), b1 = *(const f32x4*)(p.lnb + g * 128 + cc * 8 + 4);
            float vn[8];
            vn[0] = (f_lo(v.x) - mean) * rstd * g0[0] + b0[0]; vn[1] = (f_hi(v.x) - mean) * rstd * g0[1] + b0[1]; vn[2] = (f_lo(v.y) - mean) * rstd * g0[2] + b0[2]; vn[3] = (f_hi(v.y) - mean) * rstd * g0[3] + b0[3];
            vn[4] = (f_lo(v.z) - mean) * rstd * g1[0] + b1[0]; vn[5] = (f_hi(v.z) - mean) * rstd * g1[1] + b1[1]; vn[6] = (f_lo(v.w) - mean) * rstd * g1[2] + b1[2]; vn[7] = (f_hi(v.w) - mean) * rstd * g1[3] + b1[3];
            if (n == 15) { float* vp = p.out + O_VP + ((size_t)(b * 128 + r)) * EA + g * 128 + cc * 8; *(f32x4*)vp = (f32x4){vn[0], vn[1], vn[2], vn[3]}; *(f32x4*)(vp + 4) = (f32x4){vn[4], vn[5], vn[6], vn[7]}; }
#pragma unroll
            for (int k = 0; k < 8; k += 2) { const unsigned pk = cvt_pk_bf16(vn[k], vn[k + 1]); VT[(cc * 8 + k) * 136 + r] = (bf16_t)(pk & 0xffffu); VT[(cc * 8 + k + 1) * 136 + r] = (bf16_t)(pk >> 16); }
        }
        if (ii + 1 < cnt) AMIX_LOAD(item + 1);
        __syncthreads();
        {
            bf16x8 Yw[4];
#pragma unroll
            for (int ks = 0; ks < 4; ++ks) { if (ks < nks) Yw[ks] = *(const bf16x8*)(WSM + ((size_t)(g * 128 + tb * 16 + fr)) * 128 + ks * 32 + fq * 8); else Yw[ks] = (bf16x8){0, 0, 0, 0, 0, 0, 0, 0}; }
            const float bs = p.bsp[g * 128 + tb * 16 + fr];
#pragma unroll
            for (int cb = 0; cb < 8; ++cb) { f32x4 acc = {0.f, 0.f, 0.f, 0.f};
#pragma unroll
                for (int ks = 0; ks < 4; ++ks) { if (ks < nks) { const bf16x8 X = *(const LAS bf16x8*)(VT + (cb * 16 + fr) * 136 + ks * 32 + fq * 8); acc = MFMA16(X, Yw[ks], acc); } }
                const int col = g * 128 + cb * 16 + fq * 4; const u32x2 u = uu[cb], za = zz[cb];
                u32x2 y; y.x = cvt_pk_bf16(f_lo(u.x) * (acc[0] + bs) * f_lo(za.x), f_hi(u.x) * (acc[1] + bs) * f_hi(za.x)); y.y = cvt_pk_bf16(f_lo(u.y) * (acc[2] + bs) * f_lo(za.y), f_hi(u.y) * (acc[3] + bs) * f_hi(za.y));
                *(u32x2*)(YAB + (size_t)t * DM + col) = y; }
        }
        __syncthreads();
    }
#undef AMIX_LOAD
}

__device__ __forceinline__ void hgrn_sample_item(const Params& p, LAS unsigned char* lds, int item) {
    const int tid = threadIdx.x, lane = tid & 63, w = tid >> 6;
    const int bs = item >> 4, h = item & 15, row = TP + bs, e4 = tid & 31, dg = tid >> 5;
    unsigned char* ws = p.ws;
    const bf16_t* H = (const bf16_t*)(ws + WS_H); bf16_t* YAB = (bf16_t*)(ws + WS_YAB);
    LAS float* red = (LAS float*)lds;
    LAS float* ssw = red + 16 * 128;
    const bf16_t* hr = H + (size_t)row * NC + h * 128;
    const u32x2 ii = *(const u32x2*)(hr + COL_I + e4 * 4);
    const f32x4 i4 = {f_lo(ii.x), f_hi(ii.x), f_lo(ii.y), f_hi(ii.y)};
    const u32x4 q8 = *(const u32x4*)(hr + COL_Q + dg * 8), l8 = *(const u32x4*)(hr + COL_F + dg * 8);
    const float qv[8] = {f_lo(q8.x), f_hi(q8.x), f_lo(q8.y), f_hi(q8.y), f_lo(q8.z), f_hi(q8.z), f_lo(q8.w), f_hi(q8.w)};
    const float lv[8] = {f_lo(l8.x), f_hi(l8.x), f_lo(l8.y), f_hi(l8.y), f_lo(l8.z), f_hi(l8.z), f_lo(l8.w), f_hi(l8.w)};
    const size_t sbase = ((size_t)item * 128 + dg * 8) * 128 + e4 * 4;
    const f32x4* s0 = (const f32x4*)(p.st0 + sbase); f32x4* s1 = (f32x4*)(p.out + O_SS + sbase);
    f32x4 po = {0.f, 0.f, 0.f, 0.f};
#pragma unroll
    for (int j = 0; j < 8; ++j) { const float f = __expf(lv[j]), k = 1.0f - f; const f32x4 sn = __builtin_nontemporal_load(&s0[j * 32]) * f + i4 * k; __builtin_nontemporal_store(sn, &s1[j * 32]); po += sn * qv[j]; }
    *(LAS f32x4*)(red + dg * 128 + e4 * 4) = po;
    __syncthreads();
    float o = 0.f;
    if (tid < 128) {
#pragma unroll
        for (int k = 0; k < 16; ++k) o += red[k * 128 + tid];
        const float s = wave_sum(o * o);
        if (lane == 0) ssw[w] = s;
    }
    __syncthreads();
    if (tid < 128) { const float rs = __builtin_amdgcn_rsqf((ssw[0] + ssw[1]) * (1.0f / 128.0f) + EPS);
        const float y = o * rs * p.gon[h * 128 + tid] * bf2f(hr[COL_ZB + tid]);
        YAB[(size_t)row * DM + 2048 + h * 128 + tid] = (bf16_t)(cvt_pk_bf16(y, 0.f) & 0xffffu); }
    __syncthreads();
}

__device__ __forceinline__ void amix_sample_item(const Params& p, int bs) {
    const int tid = threadIdx.x, row = TP + bs, c0 = tid * 4, g = c0 >> 7;
    unsigned char* ws = p.ws;
    const bf16_t* H = (const bf16_t*)(ws + WS_H); bf16_t* YAB = (bf16_t*)(ws + WS_YAB); const float* LNP = (const float*)(ws + WS_LNPS);
    const f32x4 lv = *((const f32x4*)(LNP + (size_t)bs * 256) + (tid & 63));
    const float s1 = wave_sum(lv[0] + lv[2]), s2 = wave_sum(lv[1] + lv[3]);
    const float mean = s1 * (1.0f / 2048.0f), rstd = __builtin_amdgcn_rsqf(s2 * (1.0f / 2048.0f) - mean * mean + EPS);
    const bf16_t* hr = H + (size_t)row * NC + c0;
    const u32x2 v = *(const u32x2*)(hr + COL_V), u = *(const u32x2*)(hr + COL_U), za = *(const u32x2*)(hr + COL_ZA);
    const f32x4 lg = *(const f32x4*)(p.lng + c0), lb = *(const f32x4*)(p.lnb + c0);
    f32x4 vn; vn[0] = (f_lo(v.x) - mean) * rstd * lg[0] + lb[0]; vn[1] = (f_hi(v.x) - mean) * rstd * lg[1] + lb[1]; vn[2] = (f_lo(v.y) - mean) * rstd * lg[2] + lb[2]; vn[3] = (f_hi(v.y) - mean) * rstd * lg[3] + lb[3];
    *(f32x4*)(p.out + O_VS + (size_t)bs * EA + c0) = vn;
    const float w00 = p.wsp[(size_t)g * 128 * 128], b0 = p.bsp[g * 128];
    u32x2 y; y.x = cvt_pk_bf16(f_lo(u.x) * (w00 * vn[0] + b0) * f_lo(za.x), f_hi(u.x) * (w00 * vn[1] + b0) * f_hi(za.x)); y.y = cvt_pk_bf16(f_lo(u.y) * (w00 * vn[2] + b0) * f_lo(za.y), f_hi(u.y) * (w00 * vn[3] + b0) * f_hi(za.y));
    *(u32x2*)(YAB + (size_t)row * DM + c0) = y;
}

template <int MODE> __device__ __forceinline__ void skinny_gemm(const Params& p, LAS unsigned char* lds, int g0, int gstride) {
    int tid0 = threadIdx.x; asm volatile("" : "+v"(tid0));
    const int tid = tid0, lane = tid & 63, w = tid >> 6, fr = lane & 15, fq = lane >> 4;
    unsigned char* ws = p.ws;
    const bf16_t* A = (const bf16_t*)(ws + (MODE == 1 ? WS_XN : MODE == 2 ? WS_YAB : WS_MRG)) + (size_t)TP * DM;
    const bf16_t* Bt = (const bf16_t*)(ws + (MODE == 1 ? WS_WTIN : MODE == 2 ? WS_WTAB : WS_WTO));
    bf16_t* H = (bf16_t*)(ws + WS_H);
    constexpr int NG = (MODE == 1 ? NC : DM) / 128, AP = 264;
    LAS bf16_t* As = (LAS bf16_t*)lds;
    const int sr = tid >> 5, sc = (tid & 31) * 8;
    const int wu = __builtin_amdgcn_readfirstlane(w);
    unsigned aoff[8];
#pragma unroll
    for (int i = 0; i < 8; ++i) aoff[i] = (unsigned)(((sr + 16 * i) * DM + sc) * 2);
    const unsigned boff = (unsigned)((fr * DM + fq * 8) * 2);
    for (int g = g0; g < NG; g += gstride) {
        const int n0 = g * 128 + wu * 16, col = n0 + 4 * fq;
        const char* ab = (const char*)A; const char* bb = (const char*)Bt + (size_t)n0 * DM * 2;
        f32x4 acc[8];
#pragma unroll
        for (int mb = 0; mb < 8; ++mb) acc[mb] = (f32x4){0.f, 0.f, 0.f, 0.f};
        u32x4 ar[8]; bf16x8 bc[8];
#pragma unroll
        for (int i = 0; i < 8; ++i) ar[i] = *(const u32x4*)(ab + aoff[i]);
#pragma unroll
        for (int ks = 0; ks < 8; ++ks) bc[ks] = *(const bf16x8*)(bb + boff + ks * 64);
#pragma unroll
        for (int i = 0; i < 8; ++i) *(LAS u32x4*)(As + (sr + 16 * i) * AP + sc) = ar[i];
        __syncthreads();
        for (int kc = 0; kc < 16; ++kc) {
            const int kn = (kc < 15) ? kc + 1 : 15;
#pragma unroll
            for (int i = 0; i < 8; ++i) ar[i] = *(const u32x4*)(ab + kn * 512 + aoff[i]);
#pragma unroll
            for (int ks = 0; ks < 8; ++ks) {
#pragma unroll
                for (int mb = 0; mb < 8; ++mb) { const bf16x8 Y = *(const LAS bf16x8*)(As + (mb * 16 + fr) * AP + ks * 32 + fq * 8); acc[mb] = MFMA16(bc[ks], Y, acc[mb]); }
                bc[ks] = *(const bf16x8*)(bb + kn * 512 + boff + ks * 64);
                __builtin_amdgcn_sched_barrier(0);
            }
            if (MODE == 2 && kc == 7) {
#pragma unroll
                for (int mb = 0; mb < 8; ++mb) { const int row = TP + mb * 16 + fr; const u32x2 ga = *(const u32x2*)(H + (size_t)row * NC + COL_GA + col), gb = *(const u32x2*)(H + (size_t)row * NC + COL_GB + col);
                    acc[mb][0] *= f_lo(ga.x) * __builtin_amdgcn_rcpf(f_lo(gb.x)); acc[mb][1] *= f_hi(ga.x) * __builtin_amdgcn_rcpf(f_hi(gb.x)); acc[mb][2] *= f_lo(ga.y) * __builtin_amdgcn_rcpf(f_lo(gb.y)); acc[mb][3] *= f_hi(ga.y) * __builtin_amdgcn_rcpf(f_hi(gb.y)); if (mb & 1) asm volatile("" ::: "memory"); }
            }
            __syncthreads();
#pragma unroll
            for (int i = 0; i < 8; ++i) *(LAS u32x4*)(As + (sr + 16 * i) * AP + sc) = ar[i];
            __syncthreads();
        }
        if (MODE == 1) {
            const int type = n0 < 2048 ? 0 : n0 < 4096 ? 1 : n0 < 8192 ? 2 : n0 < 10240 ? 3 : n0 < 12288 ? 4 : n0 < 14336 ? 2 : 5;
            float lb[4] = {0.f, 0.f, 0.f, 0.f};
            if (type == 3) { const f32x4 l0 = *(const f32x4*)(p.lbl + col - 8192), l1 = *(const f32x4*)(p.lbl + 2048 + col - 8192);
#pragma unroll
                for (int j = 0; j < 4; ++j) lb[j] = __builtin_amdgcn_rcpf(1.0f + __expf(l1[j] - l0[j])); }
            float* LNPS = (float*)(ws + WS_LNPS);
#pragma unroll
            for (int mb = 0; mb < 8; ++mb) { const int row = TP + mb * 16 + fr; float v[4]; float s1 = 0.f, s2 = 0.f;
#pragma unroll
                for (int j = 0; j < 4; ++j) { float x = acc[mb][j];
                    if (type <= 1) x = pg8::fgelu(x); else if (type == 2) x = pg8::fsilu(x); else if (type == 3) x = __logf(lb[j] + (1.0f - lb[j]) * pg8::fsigmoid(x)); else if (type == 5) x = pg8::fsigmoid(x);
                    v[j] = x; s1 += x; s2 += x * x; }
                u32x2 o; o.x = cvt_pk_bf16(v[0], v[1]); o.y = cvt_pk_bf16(v[2], v[3]); *(u32x2*)(H + (size_t)row * NC + col) = o;
                if (type == 1) { s1 += __shfl_xor(s1, 16); s1 += __shfl_xor(s1, 32); s2 += __shfl_xor(s2, 16); s2 += __shfl_xor(s2, 32);
                    if (fq == 0) { f32x2 q; q.x = s1; q.y = s2; *(f32x2*)(LNPS + (size_t)(row - TP) * 256 + ((n0 - 2048) >> 4) * 2) = q; } } }
        } else if (MODE == 2) {
            bf16_t* MRG = (bf16_t*)(ws + WS_MRG);
#pragma unroll
            for (int mb = 0; mb < 8; ++mb) { const int row = TP + mb * 16 + fr; const u32x2 gb = *(const u32x2*)(H + (size_t)row * NC + COL_GB + col);
                u32x2 o; o.x = cvt_pk_bf16(acc[mb][0] * f_lo(gb.x), acc[mb][1] * f_hi(gb.x)); o.y = cvt_pk_bf16(acc[mb][2] * f_lo(gb.y), acc[mb][3] * f_hi(gb.y)); *(u32x2*)(MRG + (size_t)row * DM + col) = o; }
        } else {
            bf16_t* Z = (bf16_t*)(ws + WS_Z); float* SSPS = (float*)(ws + WS_SSPS);
#pragma unroll
            for (int mb = 0; mb < 8; ++mb) { const int row = TP + mb * 16 + fr; const f32x4 v = acc[mb];
                u32x2 o; o.x = cvt_pk_bf16(v[0], v[1]); o.y = cvt_pk_bf16(v[2], v[3]); *(u32x2*)(Z + (size_t)row * DM + col) = o;
                float ss = (v[0] * v[0] + v[1] * v[1]) + (v[2] * v[2] + v[3] * v[3]); ss += __shfl_xor(ss, 16); ss += __shfl_xor(ss, 32);
                if (fq == 0) SSPS[(size_t)(row - TP) * 256 + (n0 >> 4)] = ss; }
        }
        __syncthreads();
    }
}

__device__ __forceinline__ void phase_final(const Params& p, int m0, int m1, int wg, int nwg) {
    int tid_o = threadIdx.x; asm volatile("" : "+v"(tid_o));
    const int tid = tid_o, lane = tid & 63, wid = tid >> 6;
    const int gw = wg * 8 + wid, NGW = nwg * 8;
    const bf16_t* Z = (const bf16_t*)(p.ws + WS_Z); const float* SSP = (const float*)(p.ws + WS_SSP);
    for (int m = m0 + gw; m < m1; m += NGW) {
        float sq; if (m < TP) sq = SSP[(size_t)m * 64 + lane]; else { const f32x4 q = *((const f32x4*)((const float*)(p.ws + WS_SSPS) + (size_t)(m - TP) * 256) + lane); sq = (q[0] + q[1]) + (q[2] + q[3]); }
        const float rs = __builtin_amdgcn_rsqf(wave_sum(sq) * (1.0f / DM) + EPS);
        const float* xr = (m < TP) ? p.xp + (size_t)m * DM : p.xs + (size_t)(m - TP) * DM;
        float* yr = p.out + (size_t)m * DM;
        const f32x4* x4 = (const f32x4*)xr + lane; const f32x4* g4 = (const f32x4*)p.gpost + lane; const u32x2* z8 = (const u32x2*)(Z + (size_t)m * DM) + lane; f32x4* y4 = (f32x4*)yr + lane;
#pragma unroll
        for (int j = 0; j < 16; ++j) { const f32x4 x = __builtin_nontemporal_load(&x4[64 * j]), g = g4[64 * j]; const u32x2 z = __builtin_nontemporal_load(&z8[64 * j]);
            f32x4 y; y[0] = x[0] + f_lo(z.x) * rs * g[0]; y[1] = x[1] + f_hi(z.x) * rs * g[1]; y[2] = x[2] + f_lo(z.y) * rs * g[2]; y[3] = x[3] + f_hi(z.y) * rs * g[3]; __builtin_nontemporal_store(y, &y4[64 * j]); }
    }
}

constexpr int NPH = 9;
__global__ void __launch_bounds__(512, 2) mega(Params p) {
    extern __shared__ __attribute__((aligned(16))) unsigned char lds_raw[];
    LAS unsigned char* lds = (LAS unsigned char*)lds_raw;
    cg::grid_group grid = cg::this_grid();
    const int lo = p.lo, hi = p.hi, G = gridDim.x, bid = blockIdx.x;
    unsigned char* ws = p.ws;
    if (threadIdx.x < 64) ((LAS unsigned*)(lds + LDS_STAGE))[threadIdx.x] = 0u;
    __syncthreads();
    XcdBarrier bar = xcd_barrier_post((unsigned*)(ws + 16384), (volatile LAS unsigned*)(lds + LDS_STAGE));
    if (hi - lo > 1) grid.sync();
#define IN(k) (lo <= (k) && (k) < hi)
#define GSYNC() xcd_barrier(bar)
#define SEAM(k) do { if (IN(k) && IN((k) + 1)) GSYNC(); } while (0)
#define REPS(k) (1 + ((MK_REP >> (k)) & 1))
    for (int rep = 0; rep < REPS(0); ++rep) { if (rep) GSYNC(); if (IN(0)) phase0(p, lds); }
    SEAM(0);
    for (int rep = 0; rep < REPS(1); ++rep) { if (rep) GSYNC();
        if (IN(1)) {
            pg8::Gemm g{(const bf16_t*)(ws + WS_XN), (const bf16_t*)(ws + WS_WTIN), TP, NC, DM, DM / 64, 0}; pg8::StaticOrder S; S.init(TP, NC, G, bid);
            pg8::EpiAct E{(bf16_t*)(ws + WS_H), p.lbl, (float*)(ws + WS_LNP)};
            pg8::gemm_phase<pg8::EpiAct, pg8::StaticOrder, true, true>(lds, g, S, E);
        } }
    SEAM(1);
    for (int rep = 0; rep < REPS(2); ++rep) { if (rep) GSYNC();
        if (IN(2)) {
            if (G == 256) {
                if (bid < 176) { for (int r2 = 0; r2 < 1 + MK_SK; ++r2) skinny_gemm<1>(p, lds, bid, 176); hgrn_prep_phase(p, lds, bid, 176, 704); }
                else hgrn_prep_phase(p, lds, 704 + (bid - 176), 80, 2048);
            } else { skinny_gemm<1>(p, lds, bid, G); hgrn_prep_phase(p, lds, bid, G, 2048); }
        } }
    SEAM(2);
    for (int rep = 0; rep < REPS(3); ++rep) { if (rep) GSYNC();
        if (IN(3)) {
            constexpr int T_SC = 128, T_AM = 256, T_HS = 256, T_AS = 8, T_TOT = T_SC + T_AM + T_HS + T_AS;
            unsigned* ctr = (unsigned*)ws + 64 * (1 + rep); LAS int* slot = (LAS int*)(lds + LDS_STAGE + 64);
            int it = bid;
            while (it < T_TOT) {
                int nxt = 0; if (threadIdx.x == 0) nxt = G + (int)atomicAdd(ctr, 1u);
                if (it < T_SC) { for (int r2 = 0; r2 < 1 + (MK_SUB & 1); ++r2) hgrn_state_item(p, it); }
                else if (it < T_SC + T_AM) amix_ticket(p, lds, (it - T_SC) * 4, 4);
                else if (it < T_SC + T_AM + T_HS) { for (int k = 0; k < 8; ++k) hgrn_sample_item(p, lds, (it - T_SC - T_AM) * 8 + k); }
                else { for (int k = 0; k < 16; ++k) amix_sample_item(p, (it - T_SC - T_AM - T_HS) * 16 + k); }
                if (threadIdx.x == 0) *slot = nxt;
                __syncthreads(); it = *slot; __syncthreads();
            }
        } }
    SEAM(3);
    for (int rep = 0; rep < REPS(4); ++rep) { if (rep) GSYNC();
        if (IN(4)) {
            const int nsk = (G > 64) ? 32 : 0;
            if (bid >= G - nsk) { for (int r2 = 0; r2 < 1 + MK_SK; ++r2) skinny_gemm<2>(p, lds, bid - (G - nsk), nsk); }
            else { for (int wi = bid * 8 + (int)(threadIdx.x >> 6); wi < 8192; wi += (G - nsk) * 8) hgrn_out_waveitem(p, wi); }
            if (nsk == 0) skinny_gemm<2>(p, lds, bid, G);
        } }
    SEAM(4);
    for (int rep = 0; rep < REPS(5); ++rep) { if (rep) GSYNC();
        if (IN(5)) {
            pg8::Gemm g{(const bf16_t*)(ws + WS_YAB), (const bf16_t*)(ws + WS_WTAB), TP, DM, DM, 32, (size_t)2048 * 2}; pg8::PairOrder S; S.init(TP, DM, G, bid);
            pg8::EpiMerge E{(const bf16_t*)(ws + WS_H), (bf16_t*)(ws + WS_MRG)};
            pg8::gemm_phase<pg8::EpiMerge, pg8::PairOrder, true, true>(lds, g, S, E);
        } }
    SEAM(5);
    for (int rep = 0; rep < REPS(6); ++rep) { if (rep) GSYNC();
        if (IN(6)) {
            pg8::Gemm g{(const bf16_t*)(ws + WS_MRG), (const bf16_t*)(ws + WS_WTO), TP, DM, DM, DM / 64, 0}; pg8::StaticOrder S; S.init(TP, DM, G, bid);
            pg8::EpiZ E{(bf16_t*)(ws + WS_Z), (float*)(ws + WS_SSP)};
            pg8::gemm_phase<pg8::EpiZ, pg8::StaticOrder, true, true>(lds, g, S, E);
        } }
    SEAM(6);
    for (int rep = 0; rep < REPS(7); ++rep) { if (rep) GSYNC();
        if (IN(7)) {
            const int nsk = (G > 64) ? 32 : 0;
            if (bid >= G - nsk) { for (int r2 = 0; r2 < 1 + MK_SK; ++r2) skinny_gemm<3>(p, lds, bid - (G - nsk), nsk); }
            else phase_final(p, 0, TP, bid, G - nsk);
            if (nsk == 0) skinny_gemm<3>(p, lds, bid, G);
        } }
    SEAM(7);
    if (IN(8)) phase_final(p, TP, MT, bid, G);
    for (int x = 0; x < MK_XSYNC; ++x) GSYNC();
#undef IN
#undef SEAM
#undef GSYNC
#undef REPS
}

extern "C" void kernel_launch(void* const* d_in, const int* in_sizes, int n_in, void* d_out, int out_size, void* d_ws, size_t ws_size, hipStream_t stream) {
    static int grid = 0;
    if (grid == 0) {
        if (n_in != 15 || (size_t)out_size != O_END || ws_size < WS_END) { fprintf(stderr, "kernel_launch: unexpected shapes: n_in %d out %d ws %zu (need %zu)\n", n_in, out_size, ws_size, (size_t)WS_END); grid = -1; return; }
        int dev = 0, cus = 0, per_cu = 0;
        if (hipGetDevice(&dev) != hipSuccess || hipDeviceGetAttribute(&cus, hipDeviceAttributeMultiprocessorCount, dev) != hipSuccess) { fprintf(stderr, "kernel_launch: device query failed\n"); grid = -1; return; }
        if (hipFuncSetAttribute((const void*)mega, hipFuncAttributeMaxDynamicSharedMemorySize, LDS_BYTES) != hipSuccess) { fprintf(stderr, "kernel_launch: hipFuncSetAttribute failed\n"); grid = -1; return; }
        if (hipOccupancyMaxActiveBlocksPerMultiprocessor(&per_cu, (const void*)mega, 512, LDS_BYTES) != hipSuccess || per_cu < 1) { fprintf(stderr, "kernel_launch: occupancy query says %d\n", per_cu); per_cu = 1; }
        (void)hipGetLastError();
        grid = cus * per_cu;
        fprintf(stderr, "kernel_launch: grid %d (cus %d x %d)\n", grid, cus, per_cu);
    }
    if (grid < 0) return;
    (void)hipMemsetAsync(d_ws, 0, WS_CTLB, stream);
    Params p{};
    p.xp = (const float*)d_in[0]; p.xs = (const float*)d_in[1]; p.st0 = (const float*)d_in[2]; p.lbl = (const float*)d_in[3]; p.gpre = (const float*)d_in[4]; p.win = (const float*)d_in[5];
    p.lng = (const float*)d_in[6]; p.lnb = (const float*)d_in[7]; p.wsp = (const float*)d_in[8]; p.bsp = (const float*)d_in[9]; p.gon = (const float*)d_in[10]; p.wpa = (const float*)d_in[11];
    p.wpb = (const float*)d_in[12]; p.wo = (const float*)d_in[13]; p.gpost = (const float*)d_in[14];
    p.out = (float*)d_out; p.ws = (unsigned char*)d_ws;
#if MK_MULTI
    for (int ph = 0; ph < NPH; ++ph) { p.lo = ph; p.hi = ph + 1; hipLaunchKernelGGL(mega, dim3(grid), dim3(512), LDS_BYTES, stream, p); }
#else
    p.lo = 0; p.hi = NPH;
    void* args[] = {&p};
    hipError_t e = hipLaunchCooperativeKernel((const void*)mega, dim3(grid), dim3(512), args, LDS_BYTES, stream);
    if (e != hipSuccess) fprintf(stderr, "kernel_launch: cooperative launch failed: %s (grid %d)\n", hipGetErrorString(e), grid);
#endif
}
```
